# Optimizing an MI355X kernel written in HIP

```python
import jax, jax.numpy as jnp
from jax import lax
import numpy as np

D_MODEL = 1024
BATCH = 16
SEQ = 256
DEPTH = 2
DEC_BATCH = 4
DEC_SEQ = 2048
PAST_LEN = 512

GRID_W = 64
HEAD_DIM = 64
A_HEADS = 8
A_KV = 2
WINDOW = 128
B_HEADS = 4
B_DIM = 128
C_HEADS = 4
C_DK = 128
C_DV = 128
D_HEADS = 8
D_KV = 2
D_FF = 2816
Q_BLOCK = 128
MLSTM_CHUNK = 64
HGRN_CHUNK = 32
ROPE_THETA = 10000.0
N_EVEN = (DEPTH + 1) // 2
N_ODD = DEPTH // 2
ALPHA = (2 * DEPTH) ** 0.25
BETA = (8 * DEPTH) ** -0.25
EVEN_SIZES = (A_HEADS * HEAD_DIM, A_KV * HEAD_DIM, A_KV * HEAD_DIM,
              B_HEADS * B_DIM, B_HEADS * B_DIM, B_HEADS * B_DIM, 4 * B_HEADS, B_HEADS * B_DIM)
ODD_SIZES = (C_HEADS * C_DK, C_HEADS * C_DK, C_HEADS * C_DK, C_HEADS * C_DV, C_HEADS * C_DV,
             D_HEADS * HEAD_DIM, D_KV * HEAD_DIM, D_KV * HEAD_DIM)
EVEN_OUT = A_HEADS * HEAD_DIM + B_HEADS * B_DIM
ODD_OUT = C_HEADS * C_DV + D_HEADS * HEAD_DIM
NEG_INF = -1e30
F32 = jnp.float32

kernel_name = 'hybrid_diffusion_prefix_step'


def _split(p, sizes):
    return jnp.split(p, np.cumsum(sizes)[:-1].tolist(), axis=-1)


def _flip(t):
    return jnp.flip(t, axis=1)


def _layernorm(x, g, b, eps=1e-5):
    xf = x.astype(F32)
    mu = jnp.mean(xf, -1, keepdims=True)
    xc = xf - mu
    var = jnp.mean(xc * xc, -1, keepdims=True)
    return (xc * lax.rsqrt(var + eps) * g.astype(F32) + b.astype(F32)).astype(x.dtype)


def _rms(x, g, eps=1e-6):
    xf = x.astype(F32)
    return (xf * lax.rsqrt(jnp.mean(xf * xf, -1, keepdims=True) + eps) * g.astype(F32)).astype(x.dtype)


def _modulation(cvec, w, b):
    return (jax.nn.silu(cvec) @ w + b).reshape(cvec.shape[0], 9, D_MODEL)


def _mod_parts(mod, j):
    return mod[:, 3 * j][:, None], mod[:, 3 * j + 1][:, None], mod[:, 3 * j + 2][:, None]


def _ffn_sublayer(x, mod, j, g, b, w1, w3, w2):
    shift, scale, gate = _mod_parts(mod, j)
    h = x * (1 + scale) + shift
    y = (jax.nn.silu(h @ w1) * (h @ w3)) @ w2
    return _layernorm(ALPHA * x + 0.5 * gate * y, g, b)


def _axial_rope(x):
    L = x.shape[1]
    rows = L // GRID_W
    row = jnp.repeat(jnp.arange(rows), GRID_W)
    col = jnp.arange(L) % GRID_W
    half = x.shape[-1] // 2
    nf = half // 2
    inv = ROPE_THETA ** (-jnp.arange(nf, dtype=F32) / nf)
    shp = (L,) + (1,) * (x.ndim - 3) + (nf,)

    def rot(xh, pos):
        ang = pos.astype(F32)[:, None] * inv[None]
        cos = jnp.cos(ang).reshape(shp).astype(x.dtype)
        sin = jnp.sin(ang).reshape(shp).astype(x.dtype)
        x1, x2 = xh[..., :nf], xh[..., nf:]
        return jnp.concatenate([x1 * cos - x2 * sin, x1 * sin + x2 * cos], -1)

    return jnp.concatenate([rot(x[..., :half], row), rot(x[..., half:], col)], -1)


def _to_blocks(x, size):
    b, L = x.shape[:2]
    return jnp.moveaxis(x.reshape((b, L // size, size) + x.shape[2:]), 1, 0)


def _from_blocks(x):
    n, b, size = x.shape[:3]
    return jnp.moveaxis(x, 0, 1).reshape((b, n * size) + x.shape[3:])


def _attend(q, k, v, mask, sink):
    s = jnp.einsum('bqhgd,bkhd->bhgqk', q, k).astype(F32) * (q.shape[-1] ** -0.5)
    if mask is not None:
        s = jnp.where(mask, s, NEG_INF)
    if sink is not None:
        sk = jnp.broadcast_to(sink.astype(F32)[None, :, :, None, None], s.shape[:-1] + (1,))
        s = jnp.concatenate([s, sk], axis=-1)
    p = jax.nn.softmax(s, axis=-1)
    if sink is not None:
        p = p[..., :-1]
    return jnp.einsum('bhgqk,bkhd->bqhgd', p.astype(v.dtype), v)


def _dense_attention(q, k, v, sink):
    out = lax.map(lambda qq: _attend(qq, k, v, None, sink), _to_blocks(q, Q_BLOCK))
    return _from_blocks(out)


def _banded_attention(q, k, v, k_ctx, v_ctx, sink):
    L = q.shape[1]
    span = Q_BLOCK + 2 * WINDOW
    pad = ((0, 0), (WINDOW, WINDOW), (0, 0), (0, 0))
    kp, vp = jnp.pad(k, pad), jnp.pad(v, pad)
    rel = jnp.arange(span)[None, :] - WINDOW - jnp.arange(Q_BLOCK)[:, None]
    band = jnp.abs(rel) <= WINDOW
    ctx_mask = jnp.ones((Q_BLOCK, k_ctx.shape[1]), bool)
    kc, vc = k_ctx.astype(k.dtype), v_ctx.astype(v.dtype)

    def block(args):
        qq, j = args
        start = j * Q_BLOCK
        kk = lax.dynamic_slice_in_dim(kp, start, span, axis=1)
        vv = lax.dynamic_slice_in_dim(vp, start, span, axis=1)
        kpos = start - WINDOW + jnp.arange(span)
        valid = band & ((kpos >= 0) & (kpos < L))[None, :]
        mask = jnp.concatenate([valid, ctx_mask], axis=1)
        return _attend(qq, jnp.concatenate([kk, kc], 1), jnp.concatenate([vv, vc], 1), mask, sink)

    out = lax.map(block, (_to_blocks(q, Q_BLOCK), jnp.arange(L // Q_BLOCK)))
    return _from_blocks(out)


def _mlstm_scan(q, k, v, log_i, log_f, state):
    T = MLSTM_CHUNK
    causal = jnp.tril(jnp.ones((T, T), bool))[None, :, :, None]

    def step(carry, xs):
        C, n, m = carry
        qc, kc, vc, ic, fc = xs
        bc = jnp.cumsum(fc, axis=1)
        dmat = jnp.where(causal, bc[:, :, None] - bc[:, None] + ic[:, None], -jnp.inf)
        inter = bc + m[:, None]
        m_t = jnp.maximum(inter, jnp.max(dmat, axis=2))
        w = jnp.exp(dmat - m_t[:, :, None]) * jnp.einsum('bthd,bshd->btsh', qc, kc)
        a = jnp.exp(inter - m_t)
        num = a[..., None] * jnp.einsum('bthd,bhde->bthe', qc, C) + jnp.einsum('btsh,bshe->bthe', w, vc)
        den = a * jnp.einsum('bthd,bhd->bth', qc, n) + jnp.sum(w, axis=2)
        h = num / jnp.maximum(jnp.abs(den), jnp.exp(-m_t))[..., None]
        b_tot = bc[:, -1]
        g = b_tot[:, None] - bc + ic
        m_new = jnp.maximum(b_tot + m, jnp.max(g, axis=1))
        ws = jnp.exp(g - m_new[:, None])
        decay = jnp.exp(b_tot + m - m_new)
        C_new = decay[..., None, None] * C + jnp.einsum('bsh,bshd,bshe->bhde', ws, kc, vc)
        n_new = decay[..., None] * n + jnp.einsum('bsh,bshd->bhd', ws, kc)
        return (C_new, n_new, m_new), h

    xs = tuple(_to_blocks(t.astype(F32), T) for t in (q, k, v, log_i, log_f))
    state = tuple(s.astype(F32) for s in state)
    final, hs = lax.scan(step, state, xs)
    return _from_blocks(hs), final


def _hgrn2_scan(q, k, v, log_f, S):
    T = HGRN_CHUNK
    causal = jnp.tril(jnp.ones((T, T), bool))[None, :, :, None, None]

    def step(S, xs):
        qc, kc, vc, fc = xs
        A = jnp.cumsum(fc, axis=1)
        decay = jnp.exp(jnp.where(causal, A[:, :, None] - A[:, None], -jnp.inf))
        att = jnp.einsum('bthd,btshd,bshd->btsh', qc, decay, kc)
        o = jnp.einsum('bthd,bhde->bthe', qc * jnp.exp(A), S) + jnp.einsum('btsh,bshe->bthe', att, vc)
        A_tot = A[:, -1]
        S_new = jnp.exp(A_tot)[..., None] * S + jnp.einsum('bshd,bshe->bhde', kc * jnp.exp(A_tot[:, None] - A), vc)
        return S_new, o

    xs = tuple(_to_blocks(t.astype(F32), T) for t in (q, k, v, log_f))
    final, os_ = lax.scan(step, S.astype(F32), xs)
    return _from_blocks(os_), final


def _even_mixer(h, w_in, w_out, sink, gate_bias, norm_g, ctx):
    bsz, L, _ = h.shape
    aq, ak, av, bq, bk, bv, bg, bo = _split(h @ w_in, EVEN_SIZES)
    aq = aq.reshape(bsz, L, A_KV, A_HEADS // A_KV, HEAD_DIM)
    ak = ak.reshape(bsz, L, A_KV, HEAD_DIM)
    av = av.reshape(bsz, L, A_KV, HEAD_DIM)
    bq = bq.reshape(bsz, L, B_HEADS, B_DIM)
    bk = bk.reshape(bsz, L, B_HEADS, B_DIM) * (B_DIM ** -0.5)
    bv = bv.reshape(bsz, L, B_HEADS, B_DIM)
    gates = bg.reshape(bsz, L, 4, B_HEADS).astype(F32) + gate_bias.astype(F32)
    if ctx is None:
        zero = (jnp.zeros((bsz, B_HEADS, B_DIM, B_DIM), F32), jnp.zeros((bsz, B_HEADS, B_DIM), F32),
                jnp.zeros((bsz, B_HEADS), F32))
        st_f, st_b = zero, zero
        ya = _dense_attention(aq, ak, av, sink)
    else:
        k_ctx, v_ctx, C0, n0, m0 = ctx
        st_f = (C0[:, 0], n0[:, 0], m0[:, 0])
        st_b = (C0[:, 1], n0[:, 1], m0[:, 1])
        ya = _banded_attention(_axial_rope(aq), _axial_rope(ak), av, k_ctx, v_ctx, sink)
    hf, (Cf, nf, mf) = _mlstm_scan(bq, bk, bv, gates[:, :, 0], jax.nn.log_sigmoid(gates[:, :, 1]), st_f)
    hb, (Cb, nb, mb) = _mlstm_scan(_flip(bq), _flip(bk), _flip(bv), _flip(gates[:, :, 2]),
                                   _flip(jax.nn.log_sigmoid(gates[:, :, 3])), st_b)
    yb = jax.nn.sigmoid(bo.reshape(bsz, L, B_HEADS, B_DIM).astype(F32)) * _rms(hf + _flip(hb), norm_g)
    y = jnp.concatenate([ya.reshape(bsz, L, -1), yb.reshape(bsz, L, -1).astype(ya.dtype)], -1) @ w_out
    if ctx is None:
        return y, (ak, av, jnp.stack([Cf, Cb], 1), jnp.stack([nf, nb], 1), jnp.stack([mf, mb], 1))
    return y, None


def _odd_mixer(h, w_in, w_out, lb, norm_g, q_norm, k_norm, ctx):
    bsz, L, _ = h.shape
    cq, cf_f, cf_b, ci, cg, dq, dk, dv = _split(h @ w_in, ODD_SIZES)
    q = jax.nn.silu(cq.astype(F32)).reshape(bsz, L, C_HEADS, C_DK)
    v = ci.astype(F32).reshape(bsz, L, C_HEADS, C_DV)
    lbh = lb.reshape(C_HEADS, C_DK)

    def hgrn_gates(fp):
        f = lbh + (1.0 - lbh) * jax.nn.sigmoid(fp.astype(F32).reshape(bsz, L, C_HEADS, C_DK))
        return jnp.log(f), 1.0 - f

    lf_f, k_f = hgrn_gates(cf_f)
    lf_b, k_b = hgrn_gates(cf_b)
    dq = _rms(dq.reshape(bsz, L, D_KV, D_HEADS // D_KV, HEAD_DIM), q_norm)
    dk = _rms(dk.reshape(bsz, L, D_KV, HEAD_DIM), k_norm)
    dv = dv.reshape(bsz, L, D_KV, HEAD_DIM)
    if ctx is None:
        s0 = jnp.zeros((bsz, C_HEADS, C_DK, C_DV), F32)
        S_f0, S_b0 = s0, s0
    else:
        k_ctx, v_ctx, S0 = ctx
        S_f0, S_b0 = S0[:, 0], S0[:, 1]
    of, S_f = _hgrn2_scan(q, k_f, v, lf_f, S_f0)
    ob, S_b = _hgrn2_scan(_flip(q), _flip(k_b), _flip(v), _flip(lf_b), S_b0)
    yc = _rms(of + _flip(ob), norm_g) * jax.nn.silu(cg.astype(F32)).reshape(bsz, L, C_HEADS, C_DV)
    if ctx is None:
        yd = _dense_attention(dq, dk, dv, None)
        new = (dk, dv, jnp.stack([S_f, S_b], 1))
    else:
        keys = jnp.concatenate([_axial_rope(dk), k_ctx.astype(dk.dtype)], 1)
        vals = jnp.concatenate([dv, v_ctx.astype(dv.dtype)], 1)
        yd = _dense_attention(_axial_rope(dq), keys, vals, None)
        new = None
    y = jnp.concatenate([yc.reshape(bsz, L, -1).astype(yd.dtype), yd.reshape(bsz, L, -1)], -1) @ w_out
    return y, new


def setup_inputs(seed: int = 0) -> dict:
    key = jax.random.key(seed)
    ks = iter(jax.random.split(key, 32))

    def nrm(shape, scale=1.0):
        return scale * jax.random.normal(next(ks), shape, F32)

    fgate_base = jnp.array([0.0, 1.0, 0.0, 1.0], F32)[:, None] * jnp.linspace(3.0, 6.0, B_HEADS)[None]
    return {
        'x_prompt': nrm((BATCH, SEQ, D_MODEL)),
        'x_sample': nrm((DEC_BATCH, DEC_SEQ, D_MODEL)),
        'c': nrm((DEC_BATCH, D_MODEL)),
        'cache_a_k': nrm((DEC_BATCH, N_EVEN, PAST_LEN, A_KV, HEAD_DIM)),
        'cache_a_v': nrm((DEC_BATCH, N_EVEN, PAST_LEN, A_KV, HEAD_DIM)),
        'state_b_C': nrm((DEC_BATCH, N_EVEN, 2, B_HEADS, B_DIM, B_DIM), 0.1),
        'state_b_n': nrm((DEC_BATCH, N_EVEN, 2, B_HEADS, B_DIM), 0.1),
        'state_b_m': nrm((DEC_BATCH, N_EVEN, 2, B_HEADS)),
        'state_c_S': nrm((DEC_BATCH, N_ODD, 2, C_HEADS, C_DK, C_DV), 0.5),
        'cache_d_k': nrm((DEC_BATCH, N_ODD, PAST_LEN, D_KV, HEAD_DIM)),
        'cache_d_v': nrm((DEC_BATCH, N_ODD, PAST_LEN, D_KV, HEAD_DIM)),
        'c_ctx': nrm((D_MODEL,)),
        'ada_w': nrm((DEPTH, D_MODEL, 9 * D_MODEL), 0.5 * D_MODEL ** -0.5),
        'ada_b': nrm((DEPTH, 9 * D_MODEL), 0.01),
        'ln_g': 1.0 + nrm((DEPTH, 3, D_MODEL), 0.02),
        'ln_b': nrm((DEPTH, 3, D_MODEL), 0.02),
        'ffn_w1': nrm((DEPTH, 2, D_MODEL, D_FF), D_MODEL ** -0.5),
        'ffn_w3': nrm((DEPTH, 2, D_MODEL, D_FF), D_MODEL ** -0.5),
        'ffn_w2': nrm((DEPTH, 2, D_FF, D_MODEL), BETA * D_FF ** -0.5),
        'w_in_even': nrm((N_EVEN, D_MODEL, sum(EVEN_SIZES)), D_MODEL ** -0.5),
        'w_out_even': nrm((N_EVEN, EVEN_OUT, D_MODEL), BETA * EVEN_OUT ** -0.5),
        'a_sink': nrm((N_EVEN, A_KV, A_HEADS // A_KV), 0.5),
        'b_gate_bias': fgate_base + nrm((N_EVEN, 4, B_HEADS), 0.1),
        'b_norm_g': 1.0 + nrm((N_EVEN, B_HEADS, B_DIM), 0.02),
        'w_in_odd': nrm((N_ODD, D_MODEL, sum(ODD_SIZES)), D_MODEL ** -0.5),
        'w_out_odd': nrm((N_ODD, ODD_OUT, D_MODEL), BETA * ODD_OUT ** -0.5),
        'c_lb_logits': nrm((DEPTH, C_HEADS * C_DK)),
        'c_norm_g': 1.0 + nrm((N_ODD, C_HEADS, C_DV), 0.02),
        'd_q_norm': 1.0 + nrm((N_ODD, HEAD_DIM), 0.02),
        'd_k_norm': 1.0 + nrm((N_ODD, HEAD_DIM), 0.02),
    }


def reference(x_prompt, x_sample, c, cache_a_k, cache_a_v, state_b_C, state_b_n, state_b_m, state_c_S,
              cache_d_k, cache_d_v, c_ctx, ada_w, ada_b, ln_g, ln_b, ffn_w1, ffn_w3, ffn_w2,
              w_in_even, w_out_even, a_sink, b_gate_bias, b_norm_g, w_in_odd, w_out_odd,
              c_lb_logits, c_norm_g, d_q_norm, d_k_norm):
    lb_sm = jax.nn.softmax(c_lb_logits.astype(F32), axis=0)
    lower_bounds = jnp.cumsum(lb_sm, axis=0) - lb_sm[0]
    xp, xs = x_prompt, x_sample
    a_k_l, a_v_l, b_C_l, b_n_l, b_m_l, c_S_l, d_k_l, d_v_l = [], [], [], [], [], [], [], []
    for l in range(DEPTH):
        mod_p = _modulation(c_ctx[None], ada_w[l], ada_b[l])
        mod_s = _modulation(c, ada_w[l], ada_b[l])
        xp = _ffn_sublayer(xp, mod_p, 0, ln_g[l, 0], ln_b[l, 0], ffn_w1[l, 0], ffn_w3[l, 0], ffn_w2[l, 0])
        xs = _ffn_sublayer(xs, mod_s, 0, ln_g[l, 0], ln_b[l, 0], ffn_w1[l, 0], ffn_w3[l, 0], ffn_w2[l, 0])
        sh_p, sc_p, gt_p = _mod_parts(mod_p, 1)
        sh_s, sc_s, gt_s = _mod_parts(mod_s, 1)
        hp = xp * (1 + sc_p) + sh_p
        hs = xs * (1 + sc_s) + sh_s
        i = l // 2
        if l % 2 == 0:
            yp, (ak, av, bC, bn, bm) = _even_mixer(hp, w_in_even[i], w_out_even[i], a_sink[i], b_gate_bias[i],
                                                   b_norm_g[i], None)
            ys, _ = _even_mixer(hs, w_in_even[i], w_out_even[i], a_sink[i], b_gate_bias[i], b_norm_g[i],
                                (cache_a_k[:, i], cache_a_v[:, i], state_b_C[:, i], state_b_n[:, i],
                                 state_b_m[:, i]))
            a_k_l.append(ak)
            a_v_l.append(av)
            b_C_l.append(bC)
            b_n_l.append(bn)
            b_m_l.append(bm)
        else:
            yp, (dk, dv, cS) = _odd_mixer(hp, w_in_odd[i], w_out_odd[i], lower_bounds[l], c_norm_g[i],
                                          d_q_norm[i], d_k_norm[i], None)
            ys, _ = _odd_mixer(hs, w_in_odd[i], w_out_odd[i], lower_bounds[l], c_norm_g[i], d_q_norm[i],
                               d_k_norm[i], (cache_d_k[:, i], cache_d_v[:, i], state_c_S[:, i]))
            d_k_l.append(dk)
            d_v_l.append(dv)
            c_S_l.append(cS)
        xp = _layernorm(ALPHA * xp + gt_p * yp, ln_g[l, 1], ln_b[l, 1])
        xs = _layernorm(ALPHA * xs + gt_s * ys, ln_g[l, 1], ln_b[l, 1])
        xp = _ffn_sublayer(xp, mod_p, 2, ln_g[l, 2], ln_b[l, 2], ffn_w1[l, 1], ffn_w3[l, 1], ffn_w2[l, 1])
        xs = _ffn_sublayer(xs, mod_s, 2, ln_g[l, 2], ln_b[l, 2], ffn_w1[l, 1], ffn_w3[l, 1], ffn_w2[l, 1])
    return (xp, xs, jnp.stack(a_k_l, 1), jnp.stack(a_v_l, 1), jnp.stack(b_C_l, 1), jnp.stack(b_n_l, 1),
            jnp.stack(b_m_l, 1), jnp.stack(c_S_l, 1), jnp.stack(d_k_l, 1), jnp.stack(d_v_l, 1))
```

```cpp
#define MULTI_LAUNCH 0
#include <hip/hip_runtime.h>
#include <hip/hip_cooperative_groups.h>
#include <cstdint>
#include <cstring>
#include <cstdio>
namespace cg = cooperative_groups;

typedef unsigned short bf16_t;
typedef short s16x8 __attribute__((ext_vector_type(8)));
typedef short s16x4 __attribute__((ext_vector_type(4)));
typedef float f32x4 __attribute__((ext_vector_type(4)));
typedef float f32x16 __attribute__((ext_vector_type(16)));
typedef unsigned u32x4 __attribute__((ext_vector_type(4)));

#define NT 12288
#define NPR 4096
#define DM 1024
#define DFF 2816
#define LDPE 2944
#define LDPO 3328
#define ALPHA_F 1.4142135623730951f
#define LOG2E 1.4426950408889634f
#define LDS_BYTES 77824

struct ConvJob { const float* src; bf16_t* dst; int K, N, Npad, mode, tile0, pad0; };

struct Params {
  const float *x_prompt, *x_sample, *c, *cache_a_k, *cache_a_v, *state_b_C, *state_b_n, *state_b_m, *state_c_S,
      *cache_d_k, *cache_d_v, *c_ctx, *ada_w, *ada_b, *ln_g, *ln_b, *ffn_w1, *ffn_w3, *ffn_w2, *w_in_even,
      *w_out_even, *a_sink, *b_gate_bias, *b_norm_g, *w_in_odd, *w_out_odd, *c_lb_logits, *c_norm_g, *d_q_norm,
      *d_k_norm;
  float* out;
  bf16_t *Wt13p[4], *Wt2p[4], *WtInE, *WtInO, *WtOutE, *WtOutO;
  bf16_t *HQ, *HK0, *HK1, *HKt; float* EV;
  float* MOD;
  bf16_t* Hb;
  bf16_t* R1;
  float* Z;
  bf16_t *Qb, *Kb, *Vt, *Kc, *Vct;
  float *DEN, *CL;
  ConvJob jobs[16];
  int njobs, total_conv_tiles;
  float* SAVE;
  unsigned* bar;
};

__device__ __forceinline__ int otid() { int t = threadIdx.x; asm volatile("" : "+v"(t)); return t; }
__device__ __forceinline__ int obid() { int t = blockIdx.x; asm volatile("" : "+s"(t)); return t; }
__device__ __forceinline__ u32x4 gload16(const void* ptr) {
  u32x4 r;
  asm volatile("global_load_dwordx4 %0, %1, off" : "=v"(r) : "v"(ptr) : "memory");
  return r;
}
__device__ __forceinline__ unsigned gload2(const void* ptr) {
  unsigned r;
  asm volatile("global_load_ushort %0, %1, off" : "=v"(r) : "v"(ptr) : "memory");
  return r;
}
__device__ __forceinline__ void vm_wait4(u32x4& a, u32x4& b, u32x4& c, u32x4& d) {
  asm volatile("s_waitcnt vmcnt(0)" : "+v"(a), "+v"(b), "+v"(c), "+v"(d) : : "memory");
}
__device__ __forceinline__ void vm_wait2(u32x4& a, u32x4& b) {
  asm volatile("s_waitcnt vmcnt(0)" : "+v"(a), "+v"(b) : : "memory");
}
__device__ __forceinline__ f32x4 mfma16_safe(s16x8 a, s16x8 b, f32x4 c) {
  asm volatile("s_nop 4\n\tv_mfma_f32_16x16x32_bf16 %0, %1, %2, %0\n\ts_nop 7\n\ts_nop 7" : "+v"(c) : "v"(a), "v"(b));
  return c;
}
__device__ __forceinline__ float bf2f(bf16_t v) { return __uint_as_float(((unsigned)v) << 16); }
__device__ __forceinline__ bf16_t f2bf(float f) {
  unsigned u = __float_as_uint(f);
  u += 0x7fffu + ((u >> 16) & 1u);
  return (bf16_t)(u >> 16);
}
__device__ __forceinline__ unsigned pk2(float a, float b) { return (unsigned)f2bf(a) | ((unsigned)f2bf(b) << 16); }
__device__ __forceinline__ float wave_sum(float v) {
#pragma unroll
  for (int o = 32; o > 0; o >>= 1) v += __shfl_xor(v, o);
  return v;
}
__device__ __forceinline__ int mod_index(int row) { return row < NPR ? 0 : 1 + ((row - NPR) >> 11); }
__device__ __forceinline__ const float* modp(const Params& p, int l, int mi, int part) {
  return p.MOD + ((size_t)((l * 5 + mi) * 9 + part)) * DM;
}
__device__ __forceinline__ float sigmoidf_(float x) { return 1.f / (1.f + __expf(-x)); }

__device__ void conv_tile(const ConvJob& jb, int t, char* smem) {
  float* sT = (float*)smem;
  const int nkt = jb.K >> 6;
  const int kt = t % nkt, nt = t / nkt;
  const int k0 = kt * 64, n0 = nt * 64;
  const int tid = otid();
#pragma unroll
  for (int i = 0; i < 4; ++i) {
    const int r = (tid >> 4) + 16 * i, c4 = (tid & 15) * 4, n = n0 + c4;
    float4 v = make_float4(0.f, 0.f, 0.f, 0.f);
    if (n < jb.N) v = *(const float4*)(jb.src + (size_t)(k0 + r) * jb.N + n);
    sT[r * 65 + c4 + 0] = v.x; sT[r * 65 + c4 + 1] = v.y; sT[r * 65 + c4 + 2] = v.z; sT[r * 65 + c4 + 3] = v.w;
  }
  __syncthreads();
#pragma unroll
  for (int i = 0; i < 2; ++i) {
    const int id = tid + i * 256, nl = id >> 3, ch = id & 7;
    const int n = n0 + nl;
    int drow = n;
    if (jb.mode == 1) drow = (n >> 5) * 64 + (n & 31);
    else if (jb.mode == 2) drow = (n >> 5) * 64 + 32 + (n & 31);
    uint4 w;
    w.x = pk2(sT[(ch * 8 + 0) * 65 + nl], sT[(ch * 8 + 1) * 65 + nl]);
    w.y = pk2(sT[(ch * 8 + 2) * 65 + nl], sT[(ch * 8 + 3) * 65 + nl]);
    w.z = pk2(sT[(ch * 8 + 4) * 65 + nl], sT[(ch * 8 + 5) * 65 + nl]);
    w.w = pk2(sT[(ch * 8 + 6) * 65 + nl], sT[(ch * 8 + 7) * 65 + nl]);
    if (n < jb.Npad) *(uint4*)(jb.dst + (size_t)drow * jb.K + k0 + ch * 8) = w;
  }
  __syncthreads();
}

__device__ void mod_item(const Params& p, int item, char* smem) {
  float* sv = (float*)smem;
  float4* red = (float4*)(smem + 20480);
  const int l = item / 36, cgp = item % 36, tid = otid();
  for (int idx = tid; idx < 5120; idx += 256) {
    const int n = idx >> 10, k = idx & 1023;
    const float v = (n == 0) ? p.c_ctx[k] : p.c[(n - 1) * 1024 + k];
    sv[idx] = v * sigmoidf_(v);
  }
  __syncthreads();
  const int kq = tid >> 6, cl = tid & 63, col = cgp * 256 + cl * 4;
  const float* W = p.ada_w + (size_t)l * 1024 * 9216 + col;
  float4 acc[5];
#pragma unroll
  for (int n = 0; n < 5; ++n) acc[n] = make_float4(0.f, 0.f, 0.f, 0.f);
  for (int kb = 0; kb < 256; kb += 8) {
    float4 w[8];
#pragma unroll
    for (int u = 0; u < 8; ++u) w[u] = *(const float4*)(W + (size_t)(kq * 256 + kb + u) * 9216);
#pragma unroll
    for (int u = 0; u < 8; ++u) {
#pragma unroll
      for (int n = 0; n < 5; ++n) {
        const float s = sv[n * 1024 + kq * 256 + kb + u];
        acc[n].x += s * w[u].x; acc[n].y += s * w[u].y; acc[n].z += s * w[u].z; acc[n].w += s * w[u].w;
      }
    }
  }
#pragma unroll
  for (int n = 0; n < 5; ++n) red[(kq * 5 + n) * 64 + cl] = acc[n];
  __syncthreads();
  for (int idx = tid; idx < 320; idx += 256) {
    const int n = idx >> 6, c2 = idx & 63;
    float4 s = red[(0 * 5 + n) * 64 + c2];
#pragma unroll
    for (int q = 1; q < 4; ++q) {
      const float4 t = red[(q * 5 + n) * 64 + c2];
      s.x += t.x; s.y += t.y; s.z += t.z; s.w += t.w;
    }
    const int cc = cgp * 256 + c2 * 4;
    const float4 b = *(const float4*)(p.ada_b + (size_t)l * 9216 + cc);
    s.x += b.x; s.y += b.y; s.z += b.z; s.w += b.w;
    *(float4*)(p.MOD + (size_t)(l * 5 + n) * 9216 + cc) = s;
  }
  __syncthreads();
}

__device__ void modulate_input_phase(const Params& p) {
  const int tid_ = otid(); const int lane = tid_ & 63, w = tid_ >> 6;
  for (int row = obid() * 4 + w; row < NT; row += gridDim.x * 4) {
    const float* xr = row < NPR ? p.x_prompt + (size_t)row * DM : p.x_sample + (size_t)(row - NPR) * DM;
    const int mi = mod_index(row);
    const float* sh = modp(p, 0, mi, 0);
    const float* sc = modp(p, 0, mi, 1);
#pragma unroll
    for (int i = 0; i < 4; ++i) {
      const int c = lane * 4 + 256 * i;
      const float4 x = *(const float4*)(xr + c);
      const float4 s = *(const float4*)(sc + c);
      const float4 h = *(const float4*)(sh + c);
      uint2 o;
      o.x = pk2(x.x * (1.f + s.x) + h.x, x.y * (1.f + s.y) + h.y);
      o.y = pk2(x.z * (1.f + s.z) + h.z, x.w * (1.f + s.w) + h.w);
      *(uint2*)(p.Hb + (size_t)row * DM + c) = o;
    }
  }
}

__device__ void ln_phase(const Params& p, const float* g, const float* b, bool write_h, int nl, int nj) {
  const int tid_ = otid(); const int lane = tid_ & 63, w = tid_ >> 6;
  float* X = p.out;
  float4 gg[4], bb[4];
#pragma unroll
  for (int i = 0; i < 4; ++i) { gg[i] = *(const float4*)(g + lane * 4 + 256 * i); bb[i] = *(const float4*)(b + lane * 4 + 256 * i); }
  for (int row0 = (obid() * 4 + w) * 2; row0 < NT; row0 += gridDim.x * 8) {
    float4 v[2][4], s4[4], h4[4];
#pragma unroll
    for (int r = 0; r < 2; ++r)
#pragma unroll
      for (int i = 0; i < 4; ++i) v[r][i] = *(const float4*)(p.Z + (size_t)(row0 + r) * DM + lane * 4 + 256 * i);
    const int mi = mod_index(row0);
    const float* sh = modp(p, nl, mi, 3 * nj);
    const float* sc = modp(p, nl, mi, 3 * nj + 1);
    if (write_h) {
#pragma unroll
      for (int i = 0; i < 4; ++i) { s4[i] = *(const float4*)(sc + lane * 4 + 256 * i); h4[i] = *(const float4*)(sh + lane * 4 + 256 * i); }
    }
    float s0 = 0.f, s1 = 0.f;
#pragma unroll
    for (int i = 0; i < 4; ++i) {
      s0 += (v[0][i].x + v[0][i].y) + (v[0][i].z + v[0][i].w);
      s1 += (v[1][i].x + v[1][i].y) + (v[1][i].z + v[1][i].w);
    }
#pragma unroll
    for (int o = 32; o > 0; o >>= 1) { s0 += __shfl_xor(s0, o); s1 += __shfl_xor(s1, o); }
    const float mu0 = s0 * (1.f / 1024.f), mu1 = s1 * (1.f / 1024.f);
    float q0 = 0.f, q1 = 0.f;
#pragma unroll
    for (int i = 0; i < 4; ++i) {
      v[0][i].x -= mu0; v[0][i].y -= mu0; v[0][i].z -= mu0; v[0][i].w -= mu0;
      v[1][i].x -= mu1; v[1][i].y -= mu1; v[1][i].z -= mu1; v[1][i].w -= mu1;
      q0 += (v[0][i].x * v[0][i].x + v[0][i].y * v[0][i].y) + (v[0][i].z * v[0][i].z + v[0][i].w * v[0][i].w);
      q1 += (v[1][i].x * v[1][i].x + v[1][i].y * v[1][i].y) + (v[1][i].z * v[1][i].z + v[1][i].w * v[1][i].w);
    }
#pragma unroll
    for (int o = 32; o > 0; o >>= 1) { q0 += __shfl_xor(q0, o); q1 += __shfl_xor(q1, o); }
    const float rs[2] = {rsqrtf(q0 * (1.f / 1024.f) + 1e-5f), rsqrtf(q1 * (1.f / 1024.f) + 1e-5f)};
#pragma unroll
    for (int r = 0; r < 2; ++r)
#pragma unroll
      for (int i = 0; i < 4; ++i) {
        const int c = lane * 4 + 256 * i;
        float4 y;
        y.x = v[r][i].x * rs[r] * gg[i].x + bb[i].x; y.y = v[r][i].y * rs[r] * gg[i].y + bb[i].y;
        y.z = v[r][i].z * rs[r] * gg[i].z + bb[i].z; y.w = v[r][i].w * rs[r] * gg[i].w + bb[i].w;
        *(float4*)(X + (size_t)(row0 + r) * DM + c) = y;
        if (write_h) {
          uint2 o;
          o.x = pk2(y.x * (1.f + s4[i].x) + h4[i].x, y.y * (1.f + s4[i].y) + h4[i].y);
          o.y = pk2(y.z * (1.f + s4[i].z) + h4[i].z, y.w * (1.f + s4[i].w) + h4[i].w);
          *(uint2*)(p.Hb + (size_t)(row0 + r) * DM + c) = o;
        }
      }
  }
}

__device__ __forceinline__ void stage_acc(const f32x16 (&acc)[2][2], float* sA, int wr, int wc, int lane) {
#pragma unroll
  for (int mi = 0; mi < 2; ++mi)
#pragma unroll
    for (int ni = 0; ni < 2; ++ni)
#pragma unroll
      for (int r = 0; r < 16; ++r) {
        const int row = wr * 64 + mi * 32 + (r & 3) + 8 * (r >> 2) + 4 * (lane >> 5), col = wc * 64 + ni * 32 + (lane & 31);
        sA[row * 132 + col] = acc[mi][ni][r];
      }
}
struct EpiSwiglu {
  bf16_t* G;
  __device__ __forceinline__ void operator()(const f32x16 (&acc)[2][2], char* smem, int row0, int col0, int wr, int wc, int lane, int tid) const {
    float* sA = (float*)smem;
#pragma unroll
    for (int mi = 0; mi < 2; ++mi)
#pragma unroll
      for (int r = 0; r < 16; ++r) {
        const int row = wr * 64 + mi * 32 + (r & 3) + 8 * (r >> 2) + 4 * (lane >> 5);
        const float a = acc[mi][0][r], bb = acc[mi][1][r];
        sA[row * 68 + wc * 32 + (lane & 31)] = a * sigmoidf_(a) * bb;
      }
    __syncthreads();
    const int n0 = (col0 >> 7) * 64;
#pragma unroll
    for (int i = 0; i < 4; ++i) {
      const int idx = tid + i * 256, row = idx >> 3, c8 = (idx & 7) * 8;
      const float4 v0 = *(const float4*)(sA + row * 68 + c8), v1 = *(const float4*)(sA + row * 68 + c8 + 4);
      uint4 o; o.x = pk2(v0.x, v0.y); o.y = pk2(v0.z, v0.w); o.z = pk2(v1.x, v1.y); o.w = pk2(v1.z, v1.w);
      *(uint4*)(G + (size_t)(row0 + row) * DFF + n0 + c8) = o;
    }
    __syncthreads();
  }
};
template <int NI>
struct EpiResid {
  float* Z; const float* r0; const float* r1; const float* gate_base; float gs;
  __device__ __forceinline__ void operator()(const f32x16 (&acc)[2][NI], char* smem, int row0, int col0, int wr, int wc, int lane, int tid) const {
    float* sA = (float*)smem;
    stage_acc(acc, sA, wr, wc, lane);
    __syncthreads();
    const float* gate = gate_base + (size_t)mod_index(row0) * 9 * DM;
    const float* rbase = (row0 < NPR) ? r0 : r1 - (size_t)NPR * DM;
    const int c4 = (tid & 31) * 4;
    float4 gv = *(const float4*)(gate + col0 + c4);
    gv.x *= gs; gv.y *= gs; gv.z *= gs; gv.w *= gs;
#pragma unroll
    for (int i = 0; i < 16; ++i) {
      const int row = (tid >> 5) + i * 8;
      const float4 a = *(const float4*)(sA + row * 132 + c4);
      const size_t o = (size_t)(row0 + row) * DM + col0 + c4;
      const float4 x = *(const float4*)(rbase + o);
      float4 z;
      z.x = ALPHA_F * x.x + gv.x * a.x; z.y = ALPHA_F * x.y + gv.y * a.y; z.z = ALPHA_F * x.z + gv.z * a.z; z.w = ALPHA_F * x.w + gv.w * a.w;
      *(float4*)(Z + o) = z;
    }
    __syncthreads();
  }
};
struct EpiStoreBf16 {
  bf16_t* P; int ld;
  __device__ __forceinline__ void operator()(const f32x16 (&acc)[2][2], char* smem, int row0, int col0, int wr, int wc, int lane, int tid) const {
    float* sA = (float*)smem;
    stage_acc(acc, sA, wr, wc, lane);
    __syncthreads();
#pragma unroll
    for (int i = 0; i < 8; ++i) {
      const int idx = tid + i * 256, row = idx >> 4, c8 = (idx & 15) * 8;
      const float4 v0 = *(const float4*)(sA + row * 132 + c8), v1 = *(const float4*)(sA + row * 132 + c8 + 4);
      uint4 o; o.x = pk2(v0.x, v0.y); o.y = pk2(v0.z, v0.w); o.z = pk2(v1.x, v1.y); o.w = pk2(v1.z, v1.w);
      *(uint4*)(P + (size_t)(row0 + row) * ld + col0 + c8) = o;
    }
    __syncthreads();
  }
};

#define LAS __attribute__((address_space(3)))
template <int NI, class Epi>
__device__ __forceinline__ void gemm_tile(const bf16_t* __restrict__ A, int lda, const bf16_t* __restrict__ Bt, int ldb,
                                          int K, int row0, int col0, const Epi& epi, char* smem) {
  static_assert(NI == 2, "LDS-DMA tile is 128 x 128");
  constexpr int STAGE_B = 32768;
  const int tid = otid(), lane = tid & 63, w = tid >> 6, wr = w >> 1, wc = w & 1, h = lane >> 5;
  LAS char* lds = (LAS char*)smem;
  const int lrow = lane >> 3;
  const int c0 = (lane & 7) ^ (lane >> 4), c1 = (lane & 7) ^ (4 + (lane >> 4));
  const bf16_t* Ag[4];
  const bf16_t* Bg[4];
#pragma unroll
  for (int i = 0; i < 4; ++i) {
    const int row = (w * 4 + i) * 8 + lrow, c = (i & 1) ? c1 : c0;
    Ag[i] = A + (size_t)(row0 + row) * lda + c * 8;
    Bg[i] = Bt + (size_t)(col0 + row) * ldb + c * 8;
  }
#define GEMM_STAGE(buf_, k0_)                                                                                              \
  {                                                                                                                        \
    _Pragma("unroll") for (int i = 0; i < 4; ++i) {                                                                        \
      __builtin_amdgcn_global_load_lds((const __attribute__((address_space(1))) unsigned*)(Ag[i] + (k0_)),                 \
                                       (LAS unsigned*)(lds + (buf_) * STAGE_B + (w * 4 + i) * 1024), 16, 0, 0);            \
      __builtin_amdgcn_global_load_lds((const __attribute__((address_space(1))) unsigned*)(Bg[i] + (k0_)),                 \
                                       (LAS unsigned*)(lds + (buf_) * STAGE_B + 16384 + (w * 4 + i) * 1024), 16, 0, 0);    \
    }                                                                                                                      \
  }
  f32x16 acc[2][NI];
#pragma unroll
  for (int mi = 0; mi < 2; ++mi)
#pragma unroll
    for (int ni = 0; ni < NI; ++ni)
#pragma unroll
      for (int r = 0; r < 16; ++r) acc[mi][ni][r] = 0.f;
  const int nk = K >> 6;
  GEMM_STAGE(0, 0);
  __syncthreads();
  const int sw = ((lane & 31) >> 1) & 7;
  const int aoff = (wr * 64 + (lane & 31)) * 128;
  const int boff = 16384 + (wc * 64 + (lane & 31)) * 128;
  for (int kt = 0; kt < nk; ++kt) {
    const int cur = kt & 1;
    if (kt + 1 < nk) GEMM_STAGE(cur ^ 1, (kt + 1) * 64);
    LAS const char* sc = lds + cur * STAGE_B;
#pragma unroll
    for (int kk = 0; kk < 4; ++kk) {
      const int co = ((kk * 2 + h) ^ sw) * 16;
      s16x8 af[2], bfr[NI];
#pragma unroll
      for (int mi = 0; mi < 2; ++mi) af[mi] = *(LAS const s16x8*)(sc + aoff + mi * 4096 + co);
#pragma unroll
      for (int ni = 0; ni < NI; ++ni) bfr[ni] = *(LAS const s16x8*)(sc + boff + ni * 4096 + co);
#pragma unroll
      for (int mi = 0; mi < 2; ++mi)
#pragma unroll
        for (int ni = 0; ni < NI; ++ni)
          acc[mi][ni] = __builtin_amdgcn_mfma_f32_32x32x16_bf16(af[mi], bfr[ni], acc[mi][ni], 0, 0, 0);
    }
    __syncthreads();
  }
#undef GEMM_STAGE
  epi(acc, smem, row0, col0, wr, wc, lane, tid);
}

template <int NI, class Epi>
__device__ void gemm_phase(const bf16_t* A, int lda, const bf16_t* Bt, int ldb, int N, int K, const Epi& epi, char* smem) {
  constexpr int BN = NI * 64;
  const int nMt = NT / 128, nNt = N / BN, T = nMt * nNt;
  for (int t = obid(); t < T; t += gridDim.x) {
    const int s = (t & 7) * (T >> 3) + (t >> 3);
    const int grp = s / (8 * nNt), r = s % (8 * nNt);
    const int mt = grp * 8 + (r & 7), nt = r >> 3;
    gemm_tile<NI, Epi>(A, lda, Bt, ldb, K, mt * 128, nt * BN, epi, smem);
  }
}

__device__ void prep_vectors(const Params& p, int odd) {
  const int tid_ = otid(); const int lane = tid_ & 63, w = tid_ >> 6;
  const bf16_t* P = p.R1;
  const int ldp = odd ? LDPO : LDPE;
  const int qcol = odd ? 2560 : 0, kcol = odd ? 3072 : 512;
  float* outk = p.out + (size_t)NT * DM + (odd ? (size_t)(524288 * 2 + 2097152 + 16384 + 128 + 2097152) : 0);
  const float qn = odd ? p.d_q_norm[lane] : 1.f, kn = odd ? p.d_k_norm[lane] : 1.f;
  const int i16 = lane & 15;
  const float inv = exp2f(-(float)i16 * (13.287712379549449f / 16.f));
  for (int row = obid() * 4 + w; row < NT; row += gridDim.x * 4) {
    const bf16_t* pr_ = P + (size_t)row * ldp;
    float v[10];
#pragma unroll
    for (int hv = 0; hv < 8; ++hv) v[hv] = bf2f(pr_[qcol + hv * 64 + lane]);
#pragma unroll
    for (int hv = 0; hv < 2; ++hv) v[8 + hv] = bf2f(pr_[kcol + hv * 64 + lane]);
    if (odd) {
#pragma unroll
      for (int hv = 0; hv < 10; ++hv) {
        const float ms = wave_sum(v[hv] * v[hv]) * (1.f / 64.f);
        v[hv] = v[hv] * rsqrtf(ms + 1e-6f) * (hv < 8 ? qn : kn);
      }
    }
    if (row < NPR) {
      outk[(size_t)row * 128 + lane] = v[8];
      outk[(size_t)row * 128 + 64 + lane] = v[9];
    } else {
      const int t = (row - NPR) & 2047;
      const float pos = (lane < 32) ? (float)(t >> 6) : (float)(t & 63);
      const float ang = pos * inv;
      const float cs = __cosf(ang), sn = __sinf(ang);
#pragma unroll
      for (int hv = 0; hv < 10; ++hv) {
        const float pr = __shfl_xor(v[hv], 16);
        v[hv] = ((lane & 16) == 0) ? (v[hv] * cs - pr * sn) : (pr * sn + v[hv] * cs);
      }
    }
#pragma unroll
    for (int hv = 0; hv < 8; ++hv) p.Qb[(size_t)row * 512 + hv * 64 + lane] = f2bf(v[hv] * (0.125f * LOG2E));
#pragma unroll
    for (int hv = 0; hv < 2; ++hv) p.Kb[(size_t)row * 128 + hv * 64 + lane] = f2bf(v[8 + hv]);
  }
}

__device__ void prep_v(const Params& p, int odd, char* smem) {
  bf16_t* sT = (bf16_t*)smem;
  const bf16_t* P = p.R1;
  const int ldp = odd ? LDPO : LDPE;
  const int vcol = odd ? 3200 : 640;
  const float* cv = odd ? p.cache_d_v : p.cache_a_v;
  const float* ck = odd ? p.cache_d_k : p.cache_a_k;
  float* outv = p.out + (size_t)NT * DM + (odd ? (size_t)(524288 * 2 + 2097152 + 16384 + 128 + 2097152 + 524288) : (size_t)524288);
  const int tid = otid();
  const int nitems = 192 * 2 + 64 + 64;
  for (int it = obid(); it < nitems; it += gridDim.x) {
    if (it < 448) {
      bf16_t* dst; int dstride;
      if (it < 384) {
        const int tb = it >> 1, kv = it & 1, row0 = tb * 64;
#pragma unroll
        for (int i = 0; i < 16; ++i) {
          const int r = (tid >> 6) + 4 * i, d = tid & 63;
          const bf16_t raw = P[(size_t)(row0 + r) * ldp + vcol + kv * 64 + d];
          sT[d * 72 + r] = raw;
          if (row0 < NPR) outv[(size_t)(row0 + r) * 128 + kv * 64 + d] = bf2f(raw);
        }
        if (row0 < NPR) { const int b = row0 >> 8, pos0 = row0 & 255; dst = p.Vt + (size_t)((b * 2 + kv) * 64) * 256 + pos0; dstride = 256; }
        else { const int rr = row0 - NPR, b = rr >> 11, pos0 = rr & 2047; dst = p.Vt + 524288 + (size_t)((b * 2 + kv) * 64) * 2048 + pos0; dstride = 2048; }
      } else {
        const int j = it - 384, b = j >> 4, kv = (j >> 3) & 1, kb = j & 7;
#pragma unroll
        for (int i = 0; i < 16; ++i) {
          const int r = (tid >> 6) + 4 * i, d = tid & 63;
          sT[d * 72 + r] = f2bf(cv[((size_t)(b * 512 + kb * 64 + r) * 2 + kv) * 64 + d]);
        }
        dst = p.Vct + (size_t)((b * 2 + kv) * 64) * 512 + kb * 64; dstride = 512;
      }
      __syncthreads();
#pragma unroll
      for (int i = 0; i < 2; ++i) {
        const int id = tid + i * 256, d = id >> 3, ch = id & 7;
        *(uint4*)(dst + (size_t)d * dstride + ch * 8) = *(const uint4*)(sT + d * 72 + ch * 8);
      }
      __syncthreads();
    } else {
      const int j = it - 448;
#pragma unroll
      for (int i = 0; i < 16; ++i) {
        const int idx = j * 4096 + i * 256 + tid;
        p.Kc[idx] = f2bf(ck[idx]);
      }
    }
  }
}

__device__ void attn_item(const Params& p, int odd, int item, char* smem) {
  bf16_t* Ks = (bf16_t*)smem;
  bf16_t* Vs = Ks + 64 * 72;
  const int tid = otid(), lane = tid & 63, g = tid >> 6, ql = lane & 31, h = lane >> 5;
  int b, kv, qb, L, seq_row0; bool sample;
  if (item < 512) { sample = true; b = item >> 7; kv = (item >> 6) & 1; qb = item & 63; L = 2048; seq_row0 = NPR + b * 2048; }
  else { const int it = item - 512; sample = false; b = it >> 4; kv = (it >> 3) & 1; qb = it & 7; L = 256; seq_row0 = b * 256; }
  const int t0 = qb * 32, q_row0 = seq_row0 + t0;
  const bf16_t* vbase = sample ? p.Vt + 524288 + (size_t)((b * 2 + kv) * 64) * 2048 : p.Vt + (size_t)((b * 2 + kv) * 64) * 256;
  const bf16_t* kbase = p.Kb + (size_t)seq_row0 * 128 + kv * 64;
  const bf16_t* kcb = p.Kc + (size_t)b * 512 * 128 + kv * 64;
  const bf16_t* vcb = p.Vct + (size_t)((b * 2 + kv) * 64) * 512;
  const bool band = sample && !odd;
  int lo = 0, hi = L >> 6;
  if (band) { lo = (t0 - 128) < 0 ? 0 : ((t0 - 128) >> 6); hi = (t0 + 160 + 63) >> 6; if (hi > 32) hi = 32; }
  const int nloc = hi - lo, ntiles = nloc + (sample ? 8 : 0);
  const int hq = kv * 4 + g;
  s16x8 qf[4];
#pragma unroll
  for (int kk = 0; kk < 4; ++kk) qf[kk] = *(const s16x8*)(p.Qb + (size_t)(q_row0 + ql) * 512 + hq * 64 + kk * 16 + h * 8);
  float m = -1e30f, lsum = 0.f;
  if (!odd) { m = p.a_sink[kv * 4 + g] * LOG2E; lsum = (h == 0) ? 1.f : 0.f; }
  f32x16 o0, o1;
#pragma unroll
  for (int r = 0; r < 16; ++r) { o0[r] = 0.f; o1[r] = 0.f; }
  u32x4 kr0, kr1, vr0, vr1;
  const int lr = tid >> 3, lch = tid & 7;
#define ATT_GL(ti_)                                                                                   \
  {                                                                                                   \
    const int ti__ = (ti_);                                                                           \
    const bf16_t* kp_; const bf16_t* vp_; size_t vst_;                                                \
    if (ti__ < nloc) { const int kt_ = lo + ti__; kp_ = kbase + (size_t)(kt_ * 64 + lr) * 128 + lch * 8; vp_ = vbase + (size_t)lr * L + kt_ * 64 + lch * 8; vst_ = (size_t)L; } \
    else { const int c_ = ti__ - nloc; kp_ = kcb + (size_t)(c_ * 64 + lr) * 128 + lch * 8; vp_ = vcb + (size_t)lr * 512 + c_ * 64 + lch * 8; vst_ = 512; } \
    kr0 = gload16(kp_); kr1 = gload16(kp_ + 32 * 128);                                                \
    vr0 = gload16(vp_); vr1 = gload16(vp_ + 32 * vst_);                                               \
  }
  ATT_GL(0);
  for (int ti = 0; ti < ntiles; ++ti) {
    vm_wait4(kr0, kr1, vr0, vr1);
    *(u32x4*)(Ks + lr * 72 + lch * 8) = kr0;
    *(u32x4*)(Ks + (lr + 32) * 72 + lch * 8) = kr1;
    *(u32x4*)(Vs + lr * 72 + lch * 8) = vr0;
    *(u32x4*)(Vs + (lr + 32) * 72 + lch * 8) = vr1;
    __syncthreads();
    if (ti + 1 < ntiles) ATT_GL(ti + 1);
    __builtin_amdgcn_sched_barrier(0);
    f32x16 s0, s1;
#pragma unroll
    for (int r = 0; r < 16; ++r) { s0[r] = 0.f; s1[r] = 0.f; }
#pragma unroll
    for (int kk = 0; kk < 4; ++kk) {
      const s16x8 a0 = *(const s16x8*)(Ks + ql * 72 + kk * 16 + h * 8);
      const s16x8 a1 = *(const s16x8*)(Ks + (32 + ql) * 72 + kk * 16 + h * 8);
      s0 = __builtin_amdgcn_mfma_f32_32x32x16_bf16(a0, qf[kk], s0, 0, 0, 0);
      s1 = __builtin_amdgcn_mfma_f32_32x32x16_bf16(a1, qf[kk], s1, 0, 0, 0);
    }
    if (band && ti < nloc) {
      const int kbase_pos = (lo + ti) * 64 + 4 * h - (t0 + ql);
#pragma unroll
      for (int r = 0; r < 16; ++r) {
        const int dlt = kbase_pos + (r & 3) + 8 * (r >> 2);
        if (dlt > 128 || dlt < -128) s0[r] = -1e30f;
        const int dl2 = dlt + 32;
        if (dl2 > 128 || dl2 < -128) s1[r] = -1e30f;
      }
    }
    float mx = -1e30f;
#pragma unroll
    for (int r = 0; r < 16; ++r) mx = fmaxf(mx, fmaxf(s0[r], s1[r]));
    mx = fmaxf(mx, __shfl_xor(mx, 32));
    const float mnew = fmaxf(m, mx);
    const float alpha = __builtin_amdgcn_exp2f(m - mnew);
    m = mnew;
    float ps = 0.f;
#pragma unroll
    for (int r = 0; r < 16; ++r) {
      s0[r] = __builtin_amdgcn_exp2f(s0[r] - mnew);
      s1[r] = __builtin_amdgcn_exp2f(s1[r] - mnew);
      ps += s0[r] + s1[r];
    }
    lsum = lsum * alpha + ps;
#pragma unroll
    for (int r = 0; r < 16; ++r) { o0[r] *= alpha; o1[r] *= alpha; }
#pragma unroll
    for (int ks = 0; ks < 4; ++ks) {
      const int kbk = ks >> 1, sp = ks & 1;
      s16x8 pf;
#pragma unroll
      for (int j = 0; j < 8; ++j) pf[j] = (short)f2bf(kbk == 0 ? s0[8 * sp + j] : s1[8 * sp + j]);
      const int keyoff = kbk * 32 + 16 * sp + 4 * h;
#pragma unroll
      for (int db = 0; db < 2; ++db) {
        const bf16_t* vp = Vs + (db * 32 + ql) * 72 + keyoff;
        const s16x4 lo4 = *(const s16x4*)(vp);
        const s16x4 hi4 = *(const s16x4*)(vp + 8);
        s16x8 vf;
        vf[0] = lo4[0]; vf[1] = lo4[1]; vf[2] = lo4[2]; vf[3] = lo4[3];
        vf[4] = hi4[0]; vf[5] = hi4[1]; vf[6] = hi4[2]; vf[7] = hi4[3];
        if (db == 0) o0 = __builtin_amdgcn_mfma_f32_32x32x16_bf16(vf, pf, o0, 0, 0, 0);
        else o1 = __builtin_amdgcn_mfma_f32_32x32x16_bf16(vf, pf, o1, 0, 0, 0);
      }
    }
    __syncthreads();
  }
  const float ltot = lsum + __shfl_xor(lsum, 32);
  const float inv = 1.f / ltot;
  bf16_t* cat = p.Hb + (size_t)(q_row0 + ql) * DM + (odd ? 512 : 0) + hq * 64;
#pragma unroll
  for (int rg = 0; rg < 4; ++rg) {
    uint2 w0, w1;
    w0.x = pk2(o0[rg * 4 + 0] * inv, o0[rg * 4 + 1] * inv); w0.y = pk2(o0[rg * 4 + 2] * inv, o0[rg * 4 + 3] * inv);
    w1.x = pk2(o1[rg * 4 + 0] * inv, o1[rg * 4 + 1] * inv); w1.y = pk2(o1[rg * 4 + 2] * inv, o1[rg * 4 + 3] * inv);
    *(uint2*)(cat + 8 * rg + 4 * h) = w0;
    *(uint2*)(cat + 32 + 8 * rg + 4 * h) = w1;
  }
}

__device__ void mlstm_item(const Params& p, int item, char* smem) {
  bf16_t* sQ = (bf16_t*)smem;
  bf16_t* sK = sQ + 64 * 136;
  bf16_t* sKt = sK + 64 * 136;
  bf16_t* sVt = sKt + 128 * 72;
  bf16_t* sW = sVt + 32 * 72;
  bf16_t* sCt = sW + 64 * 72;
  float* sU = (float*)(sCt + 32 * 136);
  float* sM = sU + 64;
  float* sA = sM + 64;
  float* sWs = sA + 64;
  float* sCl = sWs + 64;
  float* sMisc = sCl + 64;
  const bf16_t* P = p.R1;
  const int ldp = LDPE;
  const float kscale = 0.08838834764831845f;
  const int tid = otid(), lane = tid & 63, w = tid >> 6, l15 = lane & 15, kg = lane >> 4;
  bool sample; int b, head, dir, slice, L, seq_row0;
  if (item < 160) { sample = true; const int s5 = item / 5; slice = item % 5; b = s5 >> 3; head = (s5 >> 1) & 3; dir = s5 & 1; L = 2048; seq_row0 = NPR + b * 2048; }
  else { const int it = item - 160; sample = false; const int s5 = it / 5; slice = it % 5; b = s5 >> 3; head = (s5 >> 1) & 3; dir = s5 & 1; L = 256; seq_row0 = b * 256; }
  const bool nsl = (slice == 4);
  const int nch = L >> 6;
  float m = 0.f;
  f32x4 cacc[2][2];
#pragma unroll
  for (int rb = 0; rb < 2; ++rb)
#pragma unroll
    for (int nb = 0; nb < 2; ++nb)
#pragma unroll
      for (int r = 0; r < 4; ++r) cacc[rb][nb][r] = 0.f;
  if (sample) {
    const size_t sidx = (size_t)((b * 2 + dir) * 4 + head);
    m = p.state_b_m[sidx];
#pragma unroll
    for (int rb = 0; rb < 2; ++rb)
#pragma unroll
      for (int nb = 0; nb < 2; ++nb)
#pragma unroll
        for (int r = 0; r < 4; ++r) {
          const int d = 32 * w + rb * 16 + 4 * kg + r, e = nb * 16 + l15;
          float v;
          if (!nsl) v = p.state_b_C[(sidx * 128 + d) * 128 + slice * 32 + e];
          else v = (e == 0) ? p.state_b_n[sidx * 128 + d] : 0.f;
          cacc[rb][nb][r] = v;
        }
  }
#pragma unroll
  for (int rb = 0; rb < 2; ++rb)
#pragma unroll
    for (int nb = 0; nb < 2; ++nb) {
      uint2 o; o.x = pk2(cacc[rb][nb][0], cacc[rb][nb][1]); o.y = pk2(cacc[rb][nb][2], cacc[rb][nb][3]);
      *(uint2*)(sCt + (nb * 16 + l15) * 136 + 32 * w + rb * 16 + 4 * kg) = o;
    }
  const float bias_i = p.b_gate_bias[(2 * dir) * 4 + head], bias_f = p.b_gate_bias[(2 * dir + 1) * 4 + head];
  float* NUM = p.Z + (size_t)dir * NT * 512;
  u32x4 pq[4], pk[4], pv;
  unsigned pgi, pgf;
#define ML_ISSUE(cc_)                                                                                         \
  {                                                                                                           \
    const int c__ = (cc_);                                                                                    \
    {                                                                                                         \
      const int pos_ = dir ? (L - 1 - (c__ * 64 + lane)) : (c__ * 64 + lane);                                 \
      const bf16_t* gp_ = P + (size_t)(seq_row0 + pos_) * ldp + 2304;                                         \
      pgi = gload2(gp_ + (2 * dir) * 4 + head);                                                               \
      pgf = gload2(gp_ + (2 * dir + 1) * 4 + head);                                                           \
    }                                                                                                         \
    _Pragma("unroll") for (int i = 0; i < 4; ++i) {                                                           \
      const int r_ = tid & 63, ch_ = (tid >> 6) + 4 * i;                                                      \
      const int pos_ = dir ? (L - 1 - (c__ * 64 + r_)) : (c__ * 64 + r_);                                     \
      const bf16_t* rp_ = P + (size_t)(seq_row0 + pos_) * ldp + head * 128 + ch_ * 8;                         \
      pq[i] = gload16(rp_ + 768);                                                                             \
      pk[i] = gload16(rp_ + 1280);                                                                            \
    }                                                                                                         \
    if (!nsl) {                                                                                               \
      const int r_ = tid & 63, ch_ = tid >> 6;                                                                \
      const int pos_ = dir ? (L - 1 - (c__ * 64 + r_)) : (c__ * 64 + r_);                                     \
      pv = gload16(P + (size_t)(seq_row0 + pos_) * ldp + 1792 + head * 128 + slice * 32 + ch_ * 8);          \
    }                                                                                                         \
  }
  pv = (u32x4){0u, 0u, 0u, 0u};
  ML_ISSUE(0);
  for (int c = 0; c < nch; ++c) {
    asm volatile("s_waitcnt vmcnt(0)" : "+v"(pgi), "+v"(pgf), "+v"(pq[0]), "+v"(pq[1]), "+v"(pq[2]), "+v"(pq[3]), "+v"(pk[0]), "+v"(pk[1]), "+v"(pk[2]), "+v"(pk[3]), "+v"(pv) : : "memory");
    {
      const float ig = bf2f((bf16_t)pgi) + bias_i;
      const float fr = bf2f((bf16_t)pgf) + bias_f;
      const float lf = fminf(fr, 0.f) - __logf(1.f + __expf(-fabsf(fr)));
      float bc = lf;
#pragma unroll
      for (int o = 1; o < 64; o <<= 1) { const float y = __shfl_up(bc, o); if (lane >= o) bc += y; }
      const float u = ig - bc;
      float pm = u;
#pragma unroll
      for (int o = 1; o < 64; o <<= 1) { const float y = __shfl_up(pm, o); if (lane >= o) pm = fmaxf(pm, y); }
      const float M = fmaxf(m, pm);
      const float Mlast = __shfl(M, 63), bclast = __shfl(bc, 63);
      if (w == 0) {
        sU[lane] = u; sM[lane] = M; sA[lane] = __expf(m - M);
        sWs[lane] = __expf(u - Mlast) * kscale;
        sCl[lane] = __expf(-(bc + M));
        if (lane == 0) { sMisc[0] = bclast + Mlast; sMisc[1] = __expf(m - Mlast); }
      }
    }
    __syncthreads();
#pragma unroll
    for (int i = 0; i < 4; ++i) {
      const int r = tid & 63, ch = (tid >> 6) + 4 * i;
      *(u32x4*)(sQ + r * 136 + ch * 8) = pq[i];
      *(u32x4*)(sK + r * 136 + ch * 8) = pk[i];
      const float ws = sWs[r];
#pragma unroll
      for (int j = 0; j < 4; ++j) {
        sKt[(ch * 8 + 2 * j) * 72 + r] = f2bf(bf2f((bf16_t)(pk[i][j] & 0xffffu)) * ws);
        sKt[(ch * 8 + 2 * j + 1) * 72 + r] = f2bf(bf2f((bf16_t)(pk[i][j] >> 16)) * ws);
      }
    }
    {
      const int r = tid & 63, ch = tid >> 6;
      if (!nsl) {
#pragma unroll
        for (int j = 0; j < 4; ++j) {
          sVt[(ch * 8 + 2 * j) * 72 + r] = (bf16_t)(pv[j] & 0xffffu);
          sVt[(ch * 8 + 2 * j + 1) * 72 + r] = (bf16_t)(pv[j] >> 16);
        }
      } else {
#pragma unroll
        for (int j = 0; j < 8; ++j) sVt[(ch * 8 + j) * 72 + r] = (ch == 0 && j == 0) ? (bf16_t)0x3F80 : (bf16_t)0;
      }
    }
    __builtin_amdgcn_sched_barrier(0);
    if (c + 1 < nch) ML_ISSUE(c + 1);
    __builtin_amdgcn_sched_barrier(0);
    __syncthreads();
    {
      const int wr = w >> 1, wc = w & 1, h = lane >> 5, l31 = lane & 31;
      f32x16 sacc;
#pragma unroll
      for (int r = 0; r < 16; ++r) sacc[r] = 0.f;
      if (!(wr == 0 && wc == 1)) {
#pragma unroll
        for (int kk = 0; kk < 8; ++kk) {
          const s16x8 a = *(const s16x8*)(sQ + (wr * 32 + l31) * 136 + kk * 16 + h * 8);
          const s16x8 bb = *(const s16x8*)(sK + (wc * 32 + l31) * 136 + kk * 16 + h * 8);
          sacc = __builtin_amdgcn_mfma_f32_32x32x16_bf16(a, bb, sacc, 0, 0, 0);
        }
      }
      const int s = wc * 32 + l31;
      const float us = sU[s];
#pragma unroll
      for (int r = 0; r < 16; ++r) {
        const int t = wr * 32 + (r & 3) + 8 * (r >> 2) + 4 * h;
        const float wv = (s <= t) ? __expf(us - sM[t]) * sacc[r] * kscale : 0.f;
        sW[t * 72 + s] = f2bf(wv);
      }
    }
    __syncthreads();
    {
      f32x4 a1[2], a2[2];
#pragma unroll
      for (int nb = 0; nb < 2; ++nb)
#pragma unroll
        for (int r = 0; r < 4; ++r) { a1[nb][r] = 0.f; a2[nb][r] = 0.f; }
#pragma unroll
      for (int kk = 0; kk < 4; ++kk) {
        const s16x8 a = *(const s16x8*)(sQ + (16 * w + l15) * 136 + kk * 32 + kg * 8);
#pragma unroll
        for (int nb = 0; nb < 2; ++nb) {
          const s16x8 bb = *(const s16x8*)(sCt + (nb * 16 + l15) * 136 + kk * 32 + kg * 8);
          a1[nb] = mfma16_safe(a, bb, a1[nb]);
        }
      }
#pragma unroll
      for (int kk = 0; kk < 2; ++kk) {
        const s16x8 a = *(const s16x8*)(sW + (16 * w + l15) * 72 + kk * 32 + kg * 8);
#pragma unroll
        for (int nb = 0; nb < 2; ++nb) {
          const s16x8 bb = *(const s16x8*)(sVt + (nb * 16 + l15) * 72 + kk * 32 + kg * 8);
          a2[nb] = mfma16_safe(a, bb, a2[nb]);
        }
      }
#pragma unroll
      for (int r = 0; r < 4; ++r) {
        const int t = 16 * w + 4 * kg + r;
        const int pos = dir ? (L - 1 - (c * 64 + t)) : (c * 64 + t);
        const size_t row = (size_t)(seq_row0 + pos);
        const float at = sA[t];
#pragma unroll
        for (int nb = 0; nb < 2; ++nb) {
          const float val = at * a1[nb][r] + a2[nb][r];
          const int e = nb * 16 + l15;
          if (!nsl) NUM[row * 512 + head * 128 + slice * 32 + e] = val;
          else if (e == 0) { p.DEN[((size_t)dir * NT + row) * 4 + head] = val; p.CL[((size_t)dir * NT + row) * 4 + head] = sCl[t]; }
        }
      }
      const float decay = sMisc[1];
#pragma unroll
      for (int rb = 0; rb < 2; ++rb)
#pragma unroll
        for (int nb = 0; nb < 2; ++nb)
#pragma unroll
          for (int r = 0; r < 4; ++r) cacc[rb][nb][r] *= decay;
#pragma unroll
      for (int kk = 0; kk < 2; ++kk)
#pragma unroll
        for (int rb = 0; rb < 2; ++rb) {
          const s16x8 a = *(const s16x8*)(sKt + (32 * w + rb * 16 + l15) * 72 + kk * 32 + kg * 8);
#pragma unroll
          for (int nb = 0; nb < 2; ++nb) {
            const s16x8 bb = *(const s16x8*)(sVt + (nb * 16 + l15) * 72 + kk * 32 + kg * 8);
            cacc[rb][nb] = mfma16_safe(a, bb, cacc[rb][nb]);
          }
        }
      m = sMisc[0];
    }
    __syncthreads();
#pragma unroll
    for (int rb = 0; rb < 2; ++rb)
#pragma unroll
      for (int nb = 0; nb < 2; ++nb) {
        uint2 o; o.x = pk2(cacc[rb][nb][0], cacc[rb][nb][1]); o.y = pk2(cacc[rb][nb][2], cacc[rb][nb][3]);
        *(uint2*)(sCt + (nb * 16 + l15) * 136 + 32 * w + rb * 16 + 4 * kg) = o;
      }
  }
  if (!sample) {
    float* oC = p.out + (size_t)NT * DM + 524288 * 2;
    float* oN = oC + 2097152;
    float* oM = oN + 16384;
    const size_t sidx = (size_t)((b * 2 + dir) * 4 + head);
#pragma unroll
    for (int rb = 0; rb < 2; ++rb)
#pragma unroll
      for (int nb = 0; nb < 2; ++nb)
#pragma unroll
        for (int r = 0; r < 4; ++r) {
          const int d = 32 * w + rb * 16 + 4 * kg + r, e = nb * 16 + l15;
          if (!nsl) oC[(sidx * 128 + d) * 128 + slice * 32 + e] = cacc[rb][nb][r];
          else if (e == 0) oN[sidx * 128 + d] = cacc[rb][nb][r];
        }
    if (nsl && tid == 0) oM[sidx] = m;
  }
  __syncthreads();
}

__device__ void hgrn_pre(const Params& p, char* smem) {
  float* sTot = (float*)smem;
  const bf16_t* P = p.R1;
  const int ldp = LDPO;
  const int tid = otid(), d = tid & 127, half = tid >> 7;
  for (int it = obid(); it < 3072; it += gridDim.x) {
    const int dir = it / 1536, rem = it % 1536, gc = rem >> 2, head = rem & 3;
    const float lbv = 1.f / (1.f + __expf(p.c_lb_logits[head * 128 + d] - p.c_lb_logits[512 + head * 128 + d]));
    const int fcol = (dir ? 1024 : 512) + head * 128 + d;
    float Al[16], qv[16], kvv[16];
    float run = 0.f;
#pragma unroll
    for (int tt = 0; tt < 16; ++tt) {
      const int t = half * 16 + tt;
      const bf16_t* rp = P + (size_t)(gc * 32 + (dir ? 31 - t : t)) * ldp;
      const float fp = bf2f(rp[fcol]);
      const float cq = bf2f(rp[head * 128 + d]);
      const float f = lbv + (1.f - lbv) * sigmoidf_(fp);
      run += __logf(f);
      Al[tt] = run; kvv[tt] = 1.f - f; qv[tt] = cq * sigmoidf_(cq);
    }
    sTot[half * 128 + d] = run;
    __syncthreads();
    const float tot0 = sTot[d], tot1 = sTot[128 + d];
    const float Atot = tot0 + tot1, off = half ? tot0 : 0.f;
    const size_t base = (size_t)((dir * 384 + gc) * 4 + head) * 4096;
    bf16_t* hk = (dir ? p.HK1 : p.HK0) + (size_t)(gc * 4 + head) * 4096;
    unsigned kt[8];
#pragma unroll
    for (int tt = 0; tt < 16; ++tt) {
      const int t = half * 16 + tt;
      const float A = Al[tt] + off;
      p.HQ[base + t * 128 + d] = f2bf(qv[tt] * __expf(A - tot0));
      const bf16_t kb = f2bf(kvv[tt] * __expf(tot0 - A));
      hk[t * 128 + d] = kb;
      if (tt & 1) kt[tt >> 1] |= ((unsigned)kb << 16); else kt[tt >> 1] = (unsigned)kb;
    }
    {
      u32x4 w0 = {kt[0], kt[1], kt[2], kt[3]}, w1 = {kt[4], kt[5], kt[6], kt[7]};
      *(u32x4*)(p.HKt + base + d * 32 + half * 16) = w0;
      *(u32x4*)(p.HKt + base + d * 32 + half * 16 + 8) = w1;
    }
    if (half == 0) {
      float* ev = p.EV + (size_t)((dir * 384 + gc) * 4 + head) * 384;
      ev[d] = __expf(tot0); ev[128 + d] = __expf(Atot - tot0); ev[256 + d] = __expf(Atot);
    }
    __syncthreads();
  }
}

__device__ void hgrn_item(const Params& p, int item, char* smem) {
  bf16_t* sQt = (bf16_t*)smem;
  bf16_t* sKt_ = sQt + 32 * 136;
  bf16_t* sK2t = sKt_ + 32 * 136;
  bf16_t* sVt = sK2t + 128 * 40;
  bf16_t* sAtt = sVt + 32 * 40;
  bf16_t* sSt = sAtt + 32 * 40;
  const bf16_t* P = p.R1;
  const int ldp = LDPO;
  const int tid = otid(), lane = tid & 63, w = tid >> 6, l15 = lane & 15, kg = lane >> 4;
  bool sample; int b, head, dir, slice, L, seq_row0;
  if (item < 128) { sample = true; const int s4 = item >> 2; slice = item & 3; b = s4 >> 3; head = (s4 >> 1) & 3; dir = s4 & 1; L = 2048; seq_row0 = NPR + b * 2048; }
  else { const int it = item - 128; sample = false; const int s4 = it >> 2; slice = it & 3; b = s4 >> 3; head = (s4 >> 1) & 3; dir = s4 & 1; L = 256; seq_row0 = b * 256; }
  const int nch = L >> 5, gc0 = seq_row0 >> 5;
  const bf16_t* HKd = dir ? p.HK1 : p.HK0;
  f32x4 sacc[2][2];
#pragma unroll
  for (int rb = 0; rb < 2; ++rb)
#pragma unroll
    for (int nb = 0; nb < 2; ++nb)
#pragma unroll
      for (int r = 0; r < 4; ++r) {
        float v = 0.f;
        if (sample) {
          const int dd = 32 * w + rb * 16 + 4 * kg + r, e = nb * 16 + l15;
          v = p.state_c_S[(((size_t)((b * 2 + dir) * 4 + head)) * 128 + dd) * 128 + slice * 32 + e];
        }
        sacc[rb][nb][r] = v;
      }
  float* O = p.Z + (size_t)dir * NT * 512;
  u32x4 rq[2], rk[2], rkt[2], rv, ev[3][2];
  rv = (u32x4){0u, 0u, 0u, 0u};
#define HG_ISSUE(cc_)                                                                                          \
  {                                                                                                            \
    const int gc_ = gc0 + (dir ? nch - 1 - (cc_) : (cc_));                                                     \
    const size_t base_ = (size_t)((dir * 384 + gc_) * 4 + head) * 4096;                                        \
    const size_t kb_ = (size_t)(gc_ * 4 + head) * 4096;                                                        \
    _Pragma("unroll") for (int i = 0; i < 2; ++i) {                                                            \
      const int id_ = tid + i * 256;                                                                           \
      rq[i] = gload16(p.HQ + base_ + id_ * 8);                                                                 \
      rk[i] = gload16(HKd + kb_ + id_ * 8);                                                                    \
      rkt[i] = gload16(p.HKt + base_ + id_ * 8);                                                               \
    }                                                                                                          \
    if (tid < 128) {                                                                                           \
      const int r_ = tid & 31, ch_ = tid >> 5;                                                                 \
      rv = gload16(P + (size_t)(gc_ * 32 + (dir ? 31 - r_ : r_)) * ldp + 1536 + head * 128 + slice * 32 + ch_ * 8); \
    }                                                                                                          \
    const float* evb_ = p.EV + (size_t)((dir * 384 + gc_) * 4 + head) * 384 + 32 * w + 4 * kg;                 \
    _Pragma("unroll") for (int x = 0; x < 3; ++x) {                                                            \
      ev[x][0] = gload16(evb_ + x * 128);                                                                      \
      ev[x][1] = gload16(evb_ + x * 128 + 16);                                                                 \
    }                                                                                                          \
  }
#define HG_WAIT() asm volatile("s_waitcnt vmcnt(0)" : "+v"(rq[0]), "+v"(rq[1]), "+v"(rk[0]), "+v"(rk[1]), "+v"(rkt[0]), "+v"(rkt[1]), "+v"(rv), "+v"(ev[0][0]), "+v"(ev[0][1]), "+v"(ev[1][0]), "+v"(ev[1][1]), "+v"(ev[2][0]), "+v"(ev[2][1]) : : "memory")
  f32x4 curE[2], cure2[2];
#define HG_STAGE()                                                                                             \
  {                                                                                                            \
    _Pragma("unroll") for (int i = 0; i < 2; ++i) {                                                            \
      const int id_ = tid + i * 256;                                                                           \
      *(u32x4*)(sQt + (id_ >> 4) * 136 + (id_ & 15) * 8) = rq[i];                                              \
      *(u32x4*)(sKt_ + (id_ >> 4) * 136 + (id_ & 15) * 8) = rk[i];                                             \
      *(u32x4*)(sK2t + (id_ >> 2) * 40 + (id_ & 3) * 8) = rkt[i];                                              \
    }                                                                                                          \
    if (tid < 128) {                                                                                           \
      const int r_ = tid & 31, ch_ = tid >> 5;                                                                 \
      _Pragma("unroll") for (int j = 0; j < 4; ++j) {                                                          \
        sVt[(ch_ * 8 + 2 * j) * 40 + r_] = (bf16_t)(rv[j] & 0xffffu);                                          \
        sVt[(ch_ * 8 + 2 * j + 1) * 40 + r_] = (bf16_t)(rv[j] >> 16);                                          \
      }                                                                                                        \
    }                                                                                                          \
    _Pragma("unroll") for (int rb = 0; rb < 2; ++rb) {                                                         \
      f32x4 e1_;                                                                                               \
      _Pragma("unroll") for (int r = 0; r < 4; ++r) {                                                          \
        e1_[r] = __uint_as_float(ev[0][rb][r]);                                                                \
        cure2[rb][r] = __uint_as_float(ev[1][rb][r]);                                                          \
        curE[rb][r] = __uint_as_float(ev[2][rb][r]);                                                           \
      }                                                                                                        \
      _Pragma("unroll") for (int nb = 0; nb < 2; ++nb) {                                                       \
        uint2 o_;                                                                                              \
        o_.x = pk2(sacc[rb][nb][0] * e1_[0], sacc[rb][nb][1] * e1_[1]);                                        \
        o_.y = pk2(sacc[rb][nb][2] * e1_[2], sacc[rb][nb][3] * e1_[3]);                                        \
        *(uint2*)(sSt + (nb * 16 + l15) * 136 + 32 * w + rb * 16 + 4 * kg) = o_;                               \
      }                                                                                                        \
    }                                                                                                          \
  }
  HG_ISSUE(0);
  HG_WAIT();
  HG_STAGE();
  __syncthreads();
  const int br = w >> 1, bcn = w & 1;
  for (int c = 0; c < nch; ++c) {
    if (c + 1 < nch) HG_ISSUE(c + 1);
    __builtin_amdgcn_sched_barrier(0);
    {
      f32x4 acc;
#pragma unroll
      for (int r = 0; r < 4; ++r) acc[r] = 0.f;
      if (!(br == 0 && bcn == 1)) {
#pragma unroll
        for (int kk = 0; kk < 4; ++kk) {
          const s16x8 a = *(const s16x8*)(sQt + (br * 16 + l15) * 136 + kk * 32 + kg * 8);
          const s16x8 bb = *(const s16x8*)(sKt_ + (bcn * 16 + l15) * 136 + kk * 32 + kg * 8);
          acc = mfma16_safe(a, bb, acc);
        }
      }
#pragma unroll
      for (int r = 0; r < 4; ++r) {
        const int t = br * 16 + 4 * kg + r, sidx = bcn * 16 + l15;
        sAtt[t * 40 + sidx] = (sidx <= t) ? f2bf(acc[r]) : (bf16_t)0;
      }
    }
    __syncthreads();
    {
      f32x4 oacc;
#pragma unroll
      for (int r = 0; r < 4; ++r) oacc[r] = 0.f;
#pragma unroll
      for (int kk = 0; kk < 4; ++kk) {
        const s16x8 a = *(const s16x8*)(sQt + (br * 16 + l15) * 136 + kk * 32 + kg * 8);
        const s16x8 bb = *(const s16x8*)(sSt + (bcn * 16 + l15) * 136 + kk * 32 + kg * 8);
        oacc = mfma16_safe(a, bb, oacc);
      }
      {
        const s16x8 a = *(const s16x8*)(sAtt + (br * 16 + l15) * 40 + kg * 8);
        const s16x8 bb = *(const s16x8*)(sVt + (bcn * 16 + l15) * 40 + kg * 8);
        oacc = mfma16_safe(a, bb, oacc);
      }
      const int gc = gc0 + (dir ? nch - 1 - c : c);
#pragma unroll
      for (int r = 0; r < 4; ++r) {
        const int t = br * 16 + 4 * kg + r, e = bcn * 16 + l15;
        O[(size_t)(gc * 32 + (dir ? 31 - t : t)) * 512 + head * 128 + slice * 32 + e] = oacc[r];
      }
#pragma unroll
      for (int rb = 0; rb < 2; ++rb) {
        const s16x8 a = *(const s16x8*)(sK2t + (32 * w + rb * 16 + l15) * 40 + kg * 8);
#pragma unroll
        for (int nb = 0; nb < 2; ++nb) {
          const s16x8 bb = *(const s16x8*)(sVt + (nb * 16 + l15) * 40 + kg * 8);
          f32x4 ds;
#pragma unroll
          for (int r = 0; r < 4; ++r) ds[r] = 0.f;
          ds = mfma16_safe(a, bb, ds);
#pragma unroll
          for (int r = 0; r < 4; ++r) sacc[rb][nb][r] = curE[rb][r] * sacc[rb][nb][r] + cure2[rb][r] * ds[r];
        }
      }
    }
    __syncthreads();
    if (c + 1 < nch) {
      HG_WAIT();
      HG_STAGE();
    }
    __syncthreads();
  }
  if (!sample) {
    float* oS = p.out + (size_t)NT * DM + 524288 * 2 + 2097152 + 16384 + 128;
#pragma unroll
    for (int rb = 0; rb < 2; ++rb)
#pragma unroll
      for (int nb = 0; nb < 2; ++nb)
#pragma unroll
        for (int r = 0; r < 4; ++r) {
          const int dd = 32 * w + rb * 16 + 4 * kg + r, e = nb * 16 + l15;
          oS[(((size_t)((b * 2 + dir) * 4 + head)) * 128 + dd) * 128 + slice * 32 + e] = sacc[rb][nb][r];
        }
  }
  __syncthreads();
}

__device__ void combine_phase(const Params& p, int odd) {
  const int tid_ = otid(); const int lane = tid_ & 63, w = tid_ >> 6;
  const bf16_t* P = p.R1;
  const float* N0 = p.Z;
  const float* N1 = p.Z + (size_t)NT * 512;
  const float* gp = odd ? p.c_norm_g : p.b_norm_g;
  float g0[4], g1[4];
#pragma unroll
  for (int hd = 0; hd < 4; ++hd) { g0[hd] = gp[hd * 128 + lane]; g1[hd] = gp[hd * 128 + 64 + lane]; }
  const int ldp = odd ? LDPO : LDPE, gcol = odd ? 2048 : 2320, ocol = odd ? 0 : 512;
  for (int row = obid() * 4 + w; row < NT; row += gridDim.x * 4) {
    float a0[4], a1[4], b0[4], b1[4], gt0[4], gt1[4], i0[4], i1[4];
#pragma unroll
    for (int hd = 0; hd < 4; ++hd) {
      const size_t o = (size_t)row * 512 + hd * 128;
      a0[hd] = N0[o + lane]; a1[hd] = N0[o + 64 + lane]; b0[hd] = N1[o + lane]; b1[hd] = N1[o + 64 + lane];
      gt0[hd] = bf2f(P[(size_t)row * ldp + gcol + hd * 128 + lane]);
      gt1[hd] = bf2f(P[(size_t)row * ldp + gcol + hd * 128 + 64 + lane]);
      i0[hd] = 1.f; i1[hd] = 1.f;
      if (!odd) {
        const float d0 = p.DEN[((size_t)row) * 4 + hd], c0 = p.CL[((size_t)row) * 4 + hd];
        const float d1 = p.DEN[((size_t)NT + row) * 4 + hd], c1 = p.CL[((size_t)NT + row) * 4 + hd];
        i0[hd] = 1.f / fmaxf(fabsf(d0), c0); i1[hd] = 1.f / fmaxf(fabsf(d1), c1);
      }
    }
#pragma unroll
    for (int hd = 0; hd < 4; ++hd) {
      const float h0 = a0[hd] * i0[hd] + b0[hd] * i1[hd];
      const float h1 = a1[hd] * i0[hd] + b1[hd] * i1[hd];
      const float ms = wave_sum(h0 * h0 + h1 * h1) * (1.f / 128.f);
      const float rs = rsqrtf(ms + 1e-6f);
      const float m0 = odd ? gt0[hd] * sigmoidf_(gt0[hd]) : sigmoidf_(gt0[hd]);
      const float m1 = odd ? gt1[hd] * sigmoidf_(gt1[hd]) : sigmoidf_(gt1[hd]);
      p.Hb[(size_t)row * DM + ocol + hd * 128 + lane] = f2bf(m0 * h0 * rs * g0[hd]);
      p.Hb[(size_t)row * DM + ocol + hd * 128 + 64 + lane] = f2bf(m1 * h1 * rs * g1[hd]);
    }
  }
}

__device__ __forceinline__ void my_gsync(unsigned* bar, unsigned& epoch, unsigned nblocks) {
  asm volatile("s_waitcnt vmcnt(0) lgkmcnt(0)" ::: "memory");
  __syncthreads();
  epoch += 1;
  if (threadIdx.x == 0) {
    __builtin_amdgcn_fence(__ATOMIC_RELEASE, "agent");
    asm volatile("s_waitcnt vmcnt(0) lgkmcnt(0)" ::: "memory");
    const unsigned g = blockIdx.x & 31u;
    const unsigned gsize = (nblocks >> 5) + ((g < (nblocks & 31u)) ? 1u : 0u);
    const unsigned old = __hip_atomic_fetch_add(&bar[g * 64], 1u, __ATOMIC_RELAXED, __HIP_MEMORY_SCOPE_AGENT);
    if (old + 1 == epoch * gsize) {
      const unsigned ngroups = nblocks < 32u ? nblocks : 32u;
      const unsigned old2 = __hip_atomic_fetch_add(&bar[32 * 64], 1u, __ATOMIC_RELAXED, __HIP_MEMORY_SCOPE_AGENT);
      if (old2 + 1 == epoch * ngroups) __hip_atomic_store(&bar[33 * 64], epoch, __ATOMIC_RELAXED, __HIP_MEMORY_SCOPE_AGENT);
    }
    while (__hip_atomic_load(&bar[33 * 64], __ATOMIC_RELAXED, __HIP_MEMORY_SCOPE_AGENT) < epoch) __builtin_amdgcn_s_sleep(1);
    __builtin_amdgcn_fence(__ATOMIC_ACQUIRE, "agent");
  }
  __syncthreads();
  __builtin_amdgcn_fence(__ATOMIC_ACQUIRE, "agent");
}
#define XB_XCNT(j) (4096 + 64 * (j))
#define XB_XSUB(j) (5120 + 64 * (j))
#define XB_XGEN(j) (6144 + 64 * (j))
#define XB_TOP 7168
#define XB_TOPGEN 7232
__device__ __forceinline__ unsigned xb_ld(unsigned* q) { return __hip_atomic_load(q, __ATOMIC_RELAXED, __HIP_MEMORY_SCOPE_AGENT); }
__device__ __forceinline__ unsigned xb_add(unsigned* q) { return __hip_atomic_fetch_add(q, 1u, __ATOMIC_RELAXED, __HIP_MEMORY_SCOPE_AGENT); }
__device__ __forceinline__ void xb_st(unsigned* q, unsigned v) { __hip_atomic_store(q, v, __ATOMIC_RELAXED, __HIP_MEMORY_SCOPE_AGENT); }
__device__ __forceinline__ void xsync(unsigned* bar, unsigned& epoch, unsigned xcc, unsigned cntx, unsigned nxcc) {
  asm volatile("s_waitcnt vmcnt(0) lgkmcnt(0)" ::: "memory");
  __syncthreads();
  epoch += 1;
  if (threadIdx.x == 0) {
    const unsigned old = xb_add(&bar[XB_XSUB(xcc)]);
    if (old + 1 == epoch * cntx) {
      __builtin_amdgcn_fence(__ATOMIC_RELEASE, "agent");
      asm volatile("s_waitcnt vmcnt(0) lgkmcnt(0)" ::: "memory");
      const unsigned old2 = xb_add(&bar[XB_TOP]);
      if (old2 + 1 == epoch * nxcc) xb_st(&bar[XB_TOPGEN], epoch);
      else while (xb_ld(&bar[XB_TOPGEN]) < epoch) __builtin_amdgcn_s_sleep(1);
      xb_st(&bar[XB_XGEN(xcc)], epoch);
    } else {
      while (xb_ld(&bar[XB_XGEN(xcc)]) < epoch) __builtin_amdgcn_s_sleep(1);
    }
    __builtin_amdgcn_fence(__ATOMIC_ACQUIRE, "agent");
    asm volatile("s_waitcnt vmcnt(0) lgkmcnt(0)" ::: "memory");
  }
  __syncthreads();
}
#define GSYNC() xsync(p.bar, xepoch, xcc, cntx, nxcc)
__global__ void __launch_bounds__(256, 2) fwd_megakernel(Params p) {
  cg::grid_group grid = cg::this_grid();
  __shared__ __attribute__((aligned(16))) char smem[LDS_BYTES];
  const int G = gridDim.x;
  unsigned epoch = 0, xepoch = 0;
  grid.sync();
  const unsigned xcc = (unsigned)__builtin_amdgcn_s_getreg((3 << 11) | 20) & 0xFu;
  if (threadIdx.x == 0) xb_add(&p.bar[XB_XCNT(xcc)]);
  my_gsync(p.bar, epoch, (unsigned)gridDim.x);
  const unsigned cntx = xb_ld(&p.bar[XB_XCNT(xcc)]);
  unsigned nxcc = 0;
#pragma unroll
  for (int jx = 0; jx < 16; ++jx) nxcc += (xb_ld(&p.bar[XB_XCNT(jx)]) != 0u) ? 1u : 0u;

  {
    const int nmod = 72, b_ = obid();
    if (G > 2 * nmod) {
      if (b_ < nmod) mod_item(p, b_, smem);
      else {
        for (int t = b_ - nmod; t < p.total_conv_tiles; t += G - nmod) {
          int j = 0;
#pragma unroll 1
          for (int q = 1; q < p.njobs; ++q) if (t >= p.jobs[q].tile0) j = q;
          conv_tile(p.jobs[j], t - p.jobs[j].tile0, smem);
        }
      }
    } else {
      for (int it = b_; it < nmod + p.total_conv_tiles; it += G) {
        if (it < nmod) mod_item(p, it, smem);
        else {
          const int t = it - nmod;
          int j = 0;
#pragma unroll 1
          for (int q = 1; q < p.njobs; ++q) if (t >= p.jobs[q].tile0) j = q;
          conv_tile(p.jobs[j], t - p.jobs[j].tile0, smem);
        }
      }
    }
  }
  GSYNC();
  modulate_input_phase(p);
  GSYNC();

#pragma unroll 1
  for (int l = 0; l < 2; ++l) {
    const int odd = l;
#pragma unroll 1
    for (int j = 0; j < 2; ++j) {
      if (j == 1) {
        {
          EpiStoreBf16 epi{p.R1, odd ? LDPO : LDPE};
          gemm_phase<2, EpiStoreBf16>(p.Hb, DM, odd ? p.WtInO : p.WtInE, DM, odd ? LDPO : LDPE, DM, epi, smem);
        }
        GSYNC();
        prep_vectors(p, odd);
        prep_v(p, odd, smem);
        if (odd) hgrn_pre(p, smem);
        GSYNC();
        {
          const int nlong = odd ? 128 : 160, nshort = odd ? 512 : 640, natt = 768;
          const int b_ = obid();
          if (b_ < nlong && G > nlong) {
            if (!odd) mlstm_item(p, b_, smem); else hgrn_item(p, b_, smem);
          } else {
            const int first = (G > nlong) ? b_ - nlong : b_, stride = (G > nlong) ? G - nlong : G;
            const int lo_it = (G > nlong) ? 0 : -nlong;
            for (int it = first + lo_it; it < natt + nshort; it += stride) {
              if (it < 0) { if (!odd) mlstm_item(p, it + nlong, smem); else hgrn_item(p, it + nlong, smem); }
              else if (it < natt) attn_item(p, odd, it, smem);
              else if (!odd) mlstm_item(p, nlong + (it - natt), smem);
              else hgrn_item(p, nlong + (it - natt), smem);
            }
          }
        }
        GSYNC();
        combine_phase(p, odd);
        GSYNC();
        {
          EpiResid<2> epi{p.Z, p.out, p.out + (size_t)NPR * DM, modp(p, l, 0, 5), 1.f};
          gemm_phase<2, EpiResid<2>>(p.Hb, DM, odd ? p.WtOutO : p.WtOutE, DM, DM, DM, epi, smem);
        }
        GSYNC();
        ln_phase(p, p.ln_g + (size_t)(l * 3 + 1) * DM, p.ln_b + (size_t)(l * 3 + 1) * DM, true, l, 2);
        GSYNC();
      }
      const int j2 = j * 2;
      {
        EpiSwiglu epi{p.R1};
        gemm_phase<2, EpiSwiglu>(p.Hb, DM, p.Wt13p[l * 2 + j], DM, 5632, DM, epi, smem);
      }
      GSYNC();
      {
        const bool first = (l == 0 && j == 0);
        EpiResid<2> epi{p.Z, first ? p.x_prompt : p.out, first ? p.x_sample : p.out + (size_t)NPR * DM, modp(p, l, 0, 3 * j2 + 2), 0.5f};
        gemm_phase<2, EpiResid<2>>(p.R1, DFF, p.Wt2p[l * 2 + j], DFF, DM, DFF, epi, smem);
      }
      GSYNC();
      {
        const bool last = (l == 1 && j == 1);
        const int nl = (j == 0) ? l : l + 1, nj = (j == 0) ? 1 : 0;
        ln_phase(p, p.ln_g + (size_t)(l * 3 + j2) * DM, p.ln_b + (size_t)(l * 3 + j2) * DM, !last, last ? 0 : nl, last ? 0 : nj);
      }
      GSYNC();
    }
  }
}


template <int PH>
__global__ void __launch_bounds__(256, 2) k_phase(Params p, int l, int j) {
  __shared__ __attribute__((aligned(16))) char smem[LDS_BYTES];
  const int G = gridDim.x;
  const int odd = l;
  if (PH == 0) {
    const int nmod = 72;
    for (int it = obid(); it < nmod + p.total_conv_tiles; it += G) {
      if (it < nmod) mod_item(p, it, smem);
      else {
        const int t = it - nmod;
        int jj = 0;
#pragma unroll 1
        for (int q = 1; q < p.njobs; ++q) if (t >= p.jobs[q].tile0) jj = q;
        conv_tile(p.jobs[jj], t - p.jobs[jj].tile0, smem);
      }
    }
  } else if (PH == 1) {
    modulate_input_phase(p);
  } else if (PH == 2) {
    EpiStoreBf16 epi{p.R1, odd ? LDPO : LDPE};
    gemm_phase<2, EpiStoreBf16>(p.Hb, DM, odd ? p.WtInO : p.WtInE, DM, odd ? LDPO : LDPE, DM, epi, smem);
  } else if (PH == 3) {
    prep_vectors(p, odd);
    prep_v(p, odd, smem);
    if (odd) hgrn_pre(p, smem);
  } else if (PH == 4) {
    for (int it = obid(); it < 160 + 640 + 768; it += G) {
      if (it < 160) mlstm_item(p, it, smem);
      else if (it < 160 + 768) attn_item(p, 0, it - 160, smem);
      else mlstm_item(p, it - 768, smem);
    }
  } else if (PH == 5) {
    for (int it = obid(); it < 128 + 512 + 768; it += G) {
      if (it < 128) hgrn_item(p, it, smem);
      else if (it < 128 + 768) attn_item(p, 1, it - 128, smem);
      else hgrn_item(p, it - 768, smem);
    }
  } else if (PH == 6) {
    combine_phase(p, odd);
  } else if (PH == 7) {
    EpiResid<1> epi{p.Z, p.out, p.out + (size_t)NPR * DM, modp(p, l, 0, 5), 1.f};
    gemm_phase<1, EpiResid<1>>(p.Hb, DM, odd ? p.WtOutO : p.WtOutE, DM, DM, DM, epi, smem);
  } else if (PH == 8) {
    ln_phase(p, p.ln_g + (size_t)(l * 3 + 1) * DM, p.ln_b + (size_t)(l * 3 + 1) * DM, true, l, 2);
  } else if (PH == 9) {
    EpiSwiglu epi{p.R1};
    gemm_phase<2, EpiSwiglu>(p.Hb, DM, p.Wt13p[l * 2 + j], DM, 5632, DM, epi, smem);
  } else if (PH == 10) {
    const int j2 = j * 2;
    const bool first = (l == 0 && j == 0);
    EpiResid<1> epi{p.Z, first ? p.x_prompt : p.out, first ? p.x_sample : p.out + (size_t)NPR * DM, modp(p, l, 0, 3 * j2 + 2), 0.5f};
    gemm_phase<1, EpiResid<1>>(p.R1, DFF, p.Wt2p[l * 2 + j], DFF, DM, DFF, epi, smem);
  } else if (PH == 13) {
    for (size_t i = (size_t)obid() * 256 + otid(); i < (size_t)8192 * 512; i += (size_t)G * 256) p.SAVE[i] = p.Z[i];
  } else if (PH == 14) {
    bool bad = false;
    for (size_t i = (size_t)obid() * 256 + otid(); i < (size_t)8192 * 512; i += (size_t)G * 256) if (__float_as_uint(p.SAVE[i]) != __float_as_uint(p.Z[i])) bad = true;
    if (bad) { volatile int* q = (volatile int*)p.SAVE; while (q[0] != 0x7fffffff) { __builtin_amdgcn_s_sleep(10); } }
  } else if (PH == 11) {
    const int j2 = j * 2;
    const bool last = (l == 1 && j == 1);
    const int nl = (j == 0) ? l : l + 1, nj = (j == 0) ? 1 : 0;
    ln_phase(p, p.ln_g + (size_t)(l * 3 + j2) * DM, p.ln_b + (size_t)(l * 3 + j2) * DM, !last, last ? 0 : nl, last ? 0 : nj);
  }
}
extern "C" void kernel_launch(void* const* d_in, const int* in_sizes, int n_in, void* d_out, int out_size, void* d_ws,
                              size_t ws_size, hipStream_t stream) {
  static Params p;
  memset(&p, 0, sizeof(p));
  const float** ip = (const float**)&p.x_prompt;
  for (int i = 0; i < 30; ++i) ip[i] = (const float*)d_in[i];
  p.out = (float*)d_out;
  char* ws = (char*)d_ws;
  size_t off = 0;
  auto take = [&](size_t bytes) { char* r = ws + off; off += (bytes + 255) & ~(size_t)255; return r; };
  p.bar = (unsigned*)take(32768);
  char* l0_begin = ws + off;
  p.Wt13p[0] = (bf16_t*)take((size_t)5632 * 1024 * 2);
  p.Wt13p[1] = (bf16_t*)take((size_t)5632 * 1024 * 2);
  p.Wt2p[0] = (bf16_t*)take((size_t)1024 * DFF * 2);
  p.Wt2p[1] = (bf16_t*)take((size_t)1024 * DFF * 2);
  p.WtInE = (bf16_t*)take((size_t)LDPE * 1024 * 2);
  p.WtOutE = (bf16_t*)take((size_t)1024 * 1024 * 2);
  char* l0_end = ws + off;
  p.HQ = (bf16_t*)l0_begin;
  p.EV = (float*)(l0_begin + 25165824);
  p.HK0 = (bf16_t*)(l0_begin + 25165824 + 4718592);
  if (l0_begin + 25165824 + 4718592 + 12582912 > l0_end) fprintf(stderr, "layer-0 weight region too small for the HGRN buffers\n");
  p.Wt13p[2] = (bf16_t*)take((size_t)5632 * 1024 * 2);
  p.Wt13p[3] = (bf16_t*)take((size_t)5632 * 1024 * 2);
  p.Wt2p[2] = (bf16_t*)take((size_t)1024 * DFF * 2);
  p.Wt2p[3] = (bf16_t*)take((size_t)1024 * DFF * 2);
  p.WtInO = (bf16_t*)take((size_t)LDPO * 1024 * 2);
  p.WtOutO = (bf16_t*)take((size_t)1024 * 1024 * 2);
  p.HK1 = (bf16_t*)take((size_t)12582912);
  p.HKt = (bf16_t*)take((size_t)25165824);
  p.MOD = (float*)take((size_t)2 * 5 * 9216 * 4);
  p.Hb = (bf16_t*)take((size_t)NT * DM * 2);
  p.R1 = (bf16_t*)take((size_t)NT * LDPO * 2);
  p.Z = (float*)take((size_t)NT * DM * 4);
  p.Qb = (bf16_t*)take((size_t)NT * 512 * 2);
  p.Kb = (bf16_t*)take((size_t)NT * 128 * 2);
  p.Vt = (bf16_t*)take((size_t)(524288 + 1048576) * 2);
  p.Kc = (bf16_t*)take((size_t)262144 * 2);
  p.Vct = (bf16_t*)take((size_t)262144 * 2);
  p.DEN = (float*)take((size_t)2 * NT * 4 * 4);
  p.CL = (float*)take((size_t)2 * NT * 4 * 4);
  if (off > ws_size) fprintf(stderr, "workspace too small: need %zu have %zu\n", off, ws_size);
  int nj = 0, tiles = 0;
  auto add = [&](const float* src, bf16_t* dst, int K, int N, int Npad, int mode) {
    ConvJob& jb = p.jobs[nj++];
    jb.src = src; jb.dst = dst; jb.K = K; jb.N = N; jb.Npad = Npad; jb.mode = mode; jb.tile0 = tiles; jb.pad0 = 0;
    tiles += (K / 64) * (Npad / 64);
  };
  for (int lj = 0; lj < 4; ++lj) {
    add(p.ffn_w1 + (size_t)lj * 1024 * DFF, p.Wt13p[lj], 1024, DFF, DFF, 1);
    add(p.ffn_w3 + (size_t)lj * 1024 * DFF, p.Wt13p[lj], 1024, DFF, DFF, 2);
    add(p.ffn_w2 + (size_t)lj * DFF * 1024, p.Wt2p[lj], DFF, 1024, 1024, 0);
  }
  add(p.w_in_even, p.WtInE, 1024, 2832, LDPE, 0);
  add(p.w_in_odd, p.WtInO, 1024, LDPO, LDPO, 0);
  add(p.w_out_even, p.WtOutE, 1024, 1024, 1024, 0);
  add(p.w_out_odd, p.WtOutO, 1024, 1024, 1024, 0);
  p.njobs = nj; p.total_conv_tiles = tiles;
  static int grid_blocks = 0;
  if (!grid_blocks) {
    int dev = 0, cus = 0, per_cu = 0;
    hipGetDevice(&dev);
    hipDeviceGetAttribute(&cus, hipDeviceAttributeMultiprocessorCount, dev);
    hipOccupancyMaxActiveBlocksPerMultiprocessor(&per_cu, fwd_megakernel, 256, 0);
    per_cu = 2;
    grid_blocks = cus * per_cu;
  }
  hipMemsetAsync(p.bar, 0, 32768, stream);
#if MULTI_LAUNCH
  const dim3 g(512), b(256);
  k_phase<0><<<g, b, 0, stream>>>(p, 0, 0);
  k_phase<1><<<g, b, 0, stream>>>(p, 0, 0);
  for (int l = 0; l < 2; ++l)
    for (int j = 0; j < 2; ++j) {
      if (j == 1) {
        k_phase<2><<<g, b, 0, stream>>>(p, l, j);
        k_phase<3><<<g, b, 0, stream>>>(p, l, j);
        if (l == 0) k_phase<4><<<g, b, 0, stream>>>(p, l, j); else k_phase<5><<<g, b, 0, stream>>>(p, l, j);
        k_phase<6><<<g, b, 0, stream>>>(p, l, j);
        k_phase<7><<<g, b, 0, stream>>>(p, l, j);
        k_phase<8><<<g, b, 0, stream>>>(p, l, j);
      }
      k_phase<9><<<g, b, 0, stream>>>(p, l, j);
      k_phase<10><<<g, b, 0, stream>>>(p, l, j);
      k_phase<11><<<g, b, 0, stream>>>(p, l, j);
    }
#else
  void* args[] = {&p};
  hipError_t e = hipLaunchCooperativeKernel((void*)fwd_megakernel, dim3(grid_blocks), dim3(256), args, 0, stream);
  if (e != hipSuccess) fprintf(stderr, "cooperative launch failed: %s (grid %d)\n", hipGetErrorString(e), grid_blocks);
#endif
}
```

```cpp
#define MULTI_LAUNCH 0
#include <hip/hip_runtime.h>
#include <hip/hip_cooperative_groups.h>
#include <cstdint>
#include <cstring>
#include <cstdio>
namespace cg = cooperative_groups;

typedef unsigned short bf16_t;
typedef short s16x8 __attribute__((ext_vector_type(8)));
typedef short s16x4 __attribute__((ext_vector_type(4)));
typedef float f32x4 __attribute__((ext_vector_type(4)));
typedef float f32x16 __attribute__((ext_vector_type(16)));
typedef unsigned u32x4 __attribute__((ext_vector_type(4)));

#define NT 12288
#define NPR 4096
#define DM 1024
#define DFF 2816
#define LDPE 2944
#define LDPO 3328
#define ALPHA_F 1.4142135623730951f
#define LOG2E 1.4426950408889634f
#define LDS_BYTES 77824

struct ConvJob { const float* src; bf16_t* dst; int K, N, Npad, mode, tile0, pad0; };

struct Params {
  const float *x_prompt, *x_sample, *c, *cache_a_k, *cache_a_v, *state_b_C, *state_b_n, *state_b_m, *state_c_S,
      *cache_d_k, *cache_d_v, *c_ctx, *ada_w, *ada_b, *ln_g, *ln_b, *ffn_w1, *ffn_w3, *ffn_w2, *w_in_even,
      *w_out_even, *a_sink, *b_gate_bias, *b_norm_g, *w_in_odd, *w_out_odd, *c_lb_logits, *c_norm_g, *d_q_norm,
      *d_k_norm;
  float* out;
  bf16_t *Wt13p[4], *Wt2p[4], *WtInE, *WtInO, *WtOutE, *WtOutO;
  bf16_t *HQ, *HK0, *HK1, *HKt; float* EV;
  float* MOD;
  bf16_t* Hb;
  bf16_t* R1;
  float* Z;
  bf16_t *Qb, *Kb, *Vt, *Kc, *Vct;
  float *DEN, *CL;
  ConvJob jobs[16];
  int njobs, total_conv_tiles;
  float* SAVE;
  unsigned* bar;
};

__device__ __forceinline__ int otid() { int t = threadIdx.x; asm volatile("" : "+v"(t)); return t; }
__device__ __forceinline__ int obid() { int t = blockIdx.x; asm volatile("" : "+s"(t)); return t; }
__device__ __forceinline__ u32x4 gload16(const void* ptr) {
  u32x4 r;
  asm volatile("global_load_dwordx4 %0, %1, off" : "=v"(r) : "v"(ptr) : "memory");
  return r;
}
__device__ __forceinline__ unsigned gload2(const void* ptr) {
  unsigned r;
  asm volatile("global_load_ushort %0, %1, off" : "=v"(r) : "v"(ptr) : "memory");
  return r;
}
__device__ __forceinline__ void vm_wait4(u32x4& a, u32x4& b, u32x4& c, u32x4& d) {
  asm volatile("s_waitcnt vmcnt(0)" : "+v"(a), "+v"(b), "+v"(c), "+v"(d) : : "memory");
}
__device__ __forceinline__ void vm_wait2(u32x4& a, u32x4& b) {
  asm volatile("s_waitcnt vmcnt(0)" : "+v"(a), "+v"(b) : : "memory");
}
__device__ __forceinline__ f32x4 mfma16_safe(s16x8 a, s16x8 b, f32x4 c) {
  asm volatile("s_nop 4\n\tv_mfma_f32_16x16x32_bf16 %0, %1, %2, %0\n\ts_nop 7\n\ts_nop 7" : "+v"(c) : "v"(a), "v"(b));
  return c;
}
__device__ __forceinline__ float bf2f(bf16_t v) { return __uint_as_float(((unsigned)v) << 16); }
__device__ __forceinline__ bf16_t f2bf(float f) {
  unsigned u = __float_as_uint(f);
  u += 0x7fffu + ((u >> 16) & 1u);
  return (bf16_t)(u >> 16);
}
__device__ __forceinline__ unsigned pk2(float a, float b) { return (unsigned)f2bf(a) | ((unsigned)f2bf(b) << 16); }
__device__ __forceinline__ float wave_sum(float v) {
#pragma unroll
  for (int o = 32; o > 0; o >>= 1) v += __shfl_xor(v, o);
  return v;
}
__device__ __forceinline__ int mod_index(int row) { return row < NPR ? 0 : 1 + ((row - NPR) >> 11); }
__device__ __forceinline__ const float* modp(const Params& p, int l, int mi, int part) {
  return p.MOD + ((size_t)((l * 5 + mi) * 9 + part)) * DM;
}
__device__ __forceinline__ float sigmoidf_(float x) { return 1.f / (1.f + __expf(-x)); }

__device__ void conv_tile(const ConvJob& jb, int t, char* smem) {
  float* sT = (float*)smem;
  const int nkt = jb.K >> 6;
  const int kt = t % nkt, nt = t / nkt;
  const int k0 = kt * 64, n0 = nt * 64;
  const int tid = otid();
#pragma unroll
  for (int i = 0; i < 4; ++i) {
    const int r = (tid >> 4) + 16 * i, c4 = (tid & 15) * 4, n = n0 + c4;
    float4 v = make_float4(0.f, 0.f, 0.f, 0.f);
    if (n < jb.N) v = *(const float4*)(jb.src + (size_t)(k0 + r) * jb.N + n);
    sT[r * 65 + c4 + 0] = v.x; sT[r * 65 + c4 + 1] = v.y; sT[r * 65 + c4 + 2] = v.z; sT[r * 65 + c4 + 3] = v.w;
  }
  __syncthreads();
#pragma unroll
  for (int i = 0; i < 2; ++i) {
    const int id = tid + i * 256, nl = id >> 3, ch = id & 7;
    const int n = n0 + nl;
    int drow = n;
    if (jb.mode == 1) drow = (n >> 5) * 64 + (n & 31);
    else if (jb.mode == 2) drow = (n >> 5) * 64 + 32 + (n & 31);
    uint4 w;
    w.x = pk2(sT[(ch * 8 + 0) * 65 + nl], sT[(ch * 8 + 1) * 65 + nl]);
    w.y = pk2(sT[(ch * 8 + 2) * 65 + nl], sT[(ch * 8 + 3) * 65 + nl]);
    w.z = pk2(sT[(ch * 8 + 4) * 65 + nl], sT[(ch * 8 + 5) * 65 + nl]);
    w.w = pk2(sT[(ch * 8 + 6) * 65 + nl], sT[(ch * 8 + 7) * 65 + nl]);
    if (n < jb.Npad) *(uint4*)(jb.dst + (size_t)drow * jb.K + k0 + ch * 8) = w;
  }
  __syncthreads();
}

__device__ void mod_item(const Params& p, int item, char* smem) {
  float* sv = (float*)smem;
  float4* red = (float4*)(smem + 20480);
  const int l = item / 36, cgp = item % 36, tid = otid();
  for (int idx = tid; idx < 5120; idx += 256) {
    const int n = idx >> 10, k = idx & 1023;
    const float v = (n == 0) ? p.c_ctx[k] : p.c[(n - 1) * 1024 + k];
    sv[idx] = v * sigmoidf_(v);
  }
  __syncthreads();
  const int kq = tid >> 6, cl = tid & 63, col = cgp * 256 + cl * 4;
  const float* W = p.ada_w + (size_t)l * 1024 * 9216 + col;
  float4 acc[5];
#pragma unroll
  for (int n = 0; n < 5; ++n) acc[n] = make_float4(0.f, 0.f, 0.f, 0.f);
  for (int kb = 0; kb < 256; kb += 8) {
    float4 w[8];
#pragma unroll
    for (int u = 0; u < 8; ++u) w[u] = *(const float4*)(W + (size_t)(kq * 256 + kb + u) * 9216);
#pragma unroll
    for (int u = 0; u < 8; ++u) {
#pragma unroll
      for (int n = 0; n < 5; ++n) {
        const float s = sv[n * 1024 + kq * 256 + kb + u];
        acc[n].x += s * w[u].x; acc[n].y += s * w[u].y; acc[n].z += s * w[u].z; acc[n].w += s * w[u].w;
      }
    }
  }
#pragma unroll
  for (int n = 0; n < 5; ++n) red[(kq * 5 + n) * 64 + cl] = acc[n];
  __syncthreads();
  for (int idx = tid; idx < 320; idx += 256) {
    const int n = idx >> 6, c2 = idx & 63;
    float4 s = red[(0 * 5 + n) * 64 + c2];
#pragma unroll
    for (int q = 1; q < 4; ++q) {
      const float4 t = red[(q * 5 + n) * 64 + c2];
      s.x += t.x; s.y += t.y; s.z += t.z; s.w += t.w;
    }
    const int cc = cgp * 256 + c2 * 4;
    const float4 b = *(const float4*)(p.ada_b + (size_t)l * 9216 + cc);
    s.x += b.x; s.y += b.y; s.z += b.z; s.w += b.w;
    *(float4*)(p.MOD + (size_t)(l * 5 + n) * 9216 + cc) = s;
  }
  __syncthreads();
}

__device__ void modulate_input_phase(const Params& p) {
  const int tid_ = otid(); const int lane = tid_ & 63, w = tid_ >> 6;
  for (int row = obid() * 4 + w; row < NT; row += gridDim.x * 4) {
    const float* xr = row < NPR ? p.x_prompt + (size_t)row * DM : p.x_sample + (size_t)(row - NPR) * DM;
    const int mi = mod_index(row);
    const float* sh = modp(p, 0, mi, 0);
    const float* sc = modp(p, 0, mi, 1);
#pragma unroll
    for (int i = 0; i < 4; ++i) {
      const int c = lane * 4 + 256 * i;
      const float4 x = *(const float4*)(xr + c);
      const float4 s = *(const float4*)(sc + c);
      const float4 h = *(const float4*)(sh + c);
      uint2 o;
      o.x = pk2(x.x * (1.f + s.x) + h.x, x.y * (1.f + s.y) + h.y);
      o.y = pk2(x.z * (1.f + s.z) + h.z, x.w * (1.f + s.w) + h.w);
      *(uint2*)(p.Hb + (size_t)row * DM + c) = o;
    }
  }
}

__device__ void ln_phase(const Params& p, const float* g, const float* b, bool write_h, int nl, int nj) {
  const int tid_ = otid(); const int lane = tid_ & 63, w = tid_ >> 6;
  float* X = p.out;
  float4 gg[4], bb[4];
#pragma unroll
  for (int i = 0; i < 4; ++i) { gg[i] = *(const float4*)(g + lane * 4 + 256 * i); bb[i] = *(const float4*)(b + lane * 4 + 256 * i); }
  for (int row0 = (obid() * 4 + w) * 2; row0 < NT; row0 += gridDim.x * 8) {
    float4 v[2][4], s4[4], h4[4];
#pragma unroll
    for (int r = 0; r < 2; ++r)
#pragma unroll
      for (int i = 0; i < 4; ++i) v[r][i] = *(const float4*)(p.Z + (size_t)(row0 + r) * DM + lane * 4 + 256 * i);
    const int mi = mod_index(row0);
    const float* sh = modp(p, nl, mi, 3 * nj);
    const float* sc = modp(p, nl, mi, 3 * nj + 1);
    if (write_h) {
#pragma unroll
      for (int i = 0; i < 4; ++i) { s4[i] = *(const float4*)(sc + lane * 4 + 256 * i); h4[i] = *(const float4*)(sh + lane * 4 + 256 * i); }
    }
    float s0 = 0.f, s1 = 0.f;
#pragma unroll
    for (int i = 0; i < 4; ++i) {
      s0 += (v[0][i].x + v[0][i].y) + (v[0][i].z + v[0][i].w);
      s1 += (v[1][i].x + v[1][i].y) + (v[1][i].z + v[1][i].w);
    }
#pragma unroll
    for (int o = 32; o > 0; o >>= 1) { s0 += __shfl_xor(s0, o); s1 += __shfl_xor(s1, o); }
    const float mu0 = s0 * (1.f / 1024.f), mu1 = s1 * (1.f / 1024.f);
    float q0 = 0.f, q1 = 0.f;
#pragma unroll
    for (int i = 0; i < 4; ++i) {
      v[0][i].x -= mu0; v[0][i].y -= mu0; v[0][i].z -= mu0; v[0][i].w -= mu0;
      v[1][i].x -= mu1; v[1][i].y -= mu1; v[1][i].z -= mu1; v[1][i].w -= mu1;
      q0 += (v[0][i].x * v[0][i].x + v[0][i].y * v[0][i].y) + (v[0][i].z * v[0][i].z + v[0][i].w * v[0][i].w);
      q1 += (v[1][i].x * v[1][i].x + v[1][i].y * v[1][i].y) + (v[1][i].z * v[1][i].z + v[1][i].w * v[1][i].w);
    }
#pragma unroll
    for (int o = 32; o > 0; o >>= 1) { q0 += __shfl_xor(q0, o); q1 += __shfl_xor(q1, o); }
    const float rs[2] = {rsqrtf(q0 * (1.f / 1024.f) + 1e-5f), rsqrtf(q1 * (1.f / 1024.f) + 1e-5f)};
#pragma unroll
    for (int r = 0; r < 2; ++r)
#pragma unroll
      for (int i = 0; i < 4; ++i) {
        const int c = lane * 4 + 256 * i;
        float4 y;
        y.x = v[r][i].x * rs[r] * gg[i].x + bb[i].x; y.y = v[r][i].y * rs[r] * gg[i].y + bb[i].y;
        y.z = v[r][i].z * rs[r] * gg[i].z + bb[i].z; y.w = v[r][i].w * rs[r] * gg[i].w + bb[i].w;
        *(float4*)(X + (size_t)(row0 + r) * DM + c) = y;
        if (write_h) {
          uint2 o;
          o.x = pk2(y.x * (1.f + s4[i].x) + h4[i].x, y.y * (1.f + s4[i].y) + h4[i].y);
          o.y = pk2(y.z * (1.f + s4[i].z) + h4[i].z, y.w * (1.f + s4[i].w) + h4[i].w);
          *(uint2*)(p.Hb + (size_t)(row0 + r) * DM + c) = o;
        }
      }
  }
}

__device__ __forceinline__ void stage_acc(const f32x16 (&acc)[2][2], float* sA, int wr, int wc, int lane) {
#pragma unroll
  for (int mi = 0; mi < 2; ++mi)
#pragma unroll
    for (int ni = 0; ni < 2; ++ni)
#pragma unroll
      for (int r = 0; r < 16; ++r) {
        const int row = wr * 64 + mi * 32 + (r & 3) + 8 * (r >> 2) + 4 * (lane >> 5), col = wc * 64 + ni * 32 + (lane & 31);
        sA[row * 132 + col] = acc[mi][ni][r];
      }
}
struct EpiSwiglu {
  bf16_t* G;
  __device__ __forceinline__ void operator()(const f32x16 (&acc)[2][2], char* smem, int row0, int col0, int wr, int wc, int lane, int tid) const {
    float* sA = (float*)smem;
#pragma unroll
    for (int mi = 0; mi < 2; ++mi)
#pragma unroll
      for (int r = 0; r < 16; ++r) {
        const int row = wr * 64 + mi * 32 + (r & 3) + 8 * (r >> 2) + 4 * (lane >> 5);
        const float a = acc[mi][0][r], bb = acc[mi][1][r];
        sA[row * 68 + wc * 32 + (lane & 31)] = a * sigmoidf_(a) * bb;
      }
    __syncthreads();
    const int n0 = (col0 >> 7) * 64;
#pragma unroll
    for (int i = 0; i < 4; ++i) {
      const int idx = tid + i * 256, row = idx >> 3, c8 = (idx & 7) * 8;
      const float4 v0 = *(const float4*)(sA + row * 68 + c8), v1 = *(const float4*)(sA + row * 68 + c8 + 4);
      uint4 o; o.x = pk2(v0.x, v0.y); o.y = pk2(v0.z, v0.w); o.z = pk2(v1.x, v1.y); o.w = pk2(v1.z, v1.w);
      *(uint4*)(G + (size_t)(row0 + row) * DFF + n0 + c8) = o;
    }
    __syncthreads();
  }
};
template <int NI>
struct EpiResid {
  float* Z; const float* r0; const float* r1; const float* gate_base; float gs;
  __device__ __forceinline__ void operator()(const f32x16 (&acc)[2][NI], char* smem, int row0, int col0, int wr, int wc, int lane, int tid) const {
    float* sA = (float*)smem;
    stage_acc(acc, sA, wr, wc, lane);
    __syncthreads();
    const float* gate = gate_base + (size_t)mod_index(row0) * 9 * DM;
    const float* rbase = (row0 < NPR) ? r0 : r1 - (size_t)NPR * DM;
    const int c4 = (tid & 31) * 4;
    float4 gv = *(const float4*)(gate + col0 + c4);
    gv.x *= gs; gv.y *= gs; gv.z *= gs; gv.w *= gs;
#pragma unroll
    for (int i = 0; i < 16; ++i) {
      const int row = (tid >> 5) + i * 8;
      const float4 a = *(const float4*)(sA + row * 132 + c4);
      const size_t o = (size_t)(row0 + row) * DM + col0 + c4;
      const float4 x = *(const float4*)(rbase + o);
      float4 z;
      z.x = ALPHA_F * x.x + gv.x * a.x; z.y = ALPHA_F * x.y + gv.y * a.y; z.z = ALPHA_F * x.z + gv.z * a.z; z.w = ALPHA_F * x.w + gv.w * a.w;
      *(float4*)(Z + o) = z;
    }
    __syncthreads();
  }
};
struct EpiStoreBf16 {
  bf16_t* P; int ld;
  __device__ __forceinline__ void operator()(const f32x16 (&acc)[2][2], char* smem, int row0, int col0, int wr, int wc, int lane, int tid) const {
    float* sA = (float*)smem;
    stage_acc(acc, sA, wr, wc, lane);
    __syncthreads();
#pragma unroll
    for (int i = 0; i < 8; ++i) {
      const int idx = tid + i * 256, row = idx >> 4, c8 = (idx & 15) * 8;
      const float4 v0 = *(const float4*)(sA + row * 132 + c8), v1 = *(const float4*)(sA + row * 132 + c8 + 4);
      uint4 o; o.x = pk2(v0.x, v0.y); o.y = pk2(v0.z, v0.w); o.z = pk2(v1.x, v1.y); o.w = pk2(v1.z, v1.w);
      *(uint4*)(P + (size_t)(row0 + row) * ld + col0 + c8) = o;
    }
    __syncthreads();
  }
};

#define LAS __attribute__((address_space(3)))
template <int NI, class Epi>
__device__ __forceinline__ void gemm_tile(const bf16_t* __restrict__ A, int lda, const bf16_t* __restrict__ Bt, int ldb,
                                          int K, int row0, int col0, const Epi& epi, char* smem) {
  static_assert(NI == 2, "LDS-DMA tile is 128 x 128");
  constexpr int STAGE_B = 32768;
  const int tid = otid(), lane = tid & 63, w = tid >> 6, wr = w >> 1, wc = w & 1, h = lane >> 5;
  LAS char* lds = (LAS char*)smem;
  const int lrow = lane >> 3;
  const int c0 = (lane & 7) ^ (lane >> 4), c1 = (lane & 7) ^ (4 + (lane >> 4));
  const bf16_t* Ag[4];
  const bf16_t* Bg[4];
#pragma unroll
  for (int i = 0; i < 4; ++i) {
    const int row = (w * 4 + i) * 8 + lrow, c = (i & 1) ? c1 : c0;
    Ag[i] = A + (size_t)(row0 + row) * lda + c * 8;
    Bg[i] = Bt + (size_t)(col0 + row) * ldb + c * 8;
  }
#define GEMM_STAGE(buf_, k0_)                                                                                              \
  {                                                                                                                        \
    _Pragma("unroll") for (int i = 0; i < 4; ++i) {                                                                        \
      __builtin_amdgcn_global_load_lds((const __attribute__((address_space(1))) unsigned*)(Ag[i] + (k0_)),                 \
                                       (LAS unsigned*)(lds + (buf_) * STAGE_B + (w * 4 + i) * 1024), 16, 0, 0);            \
      __builtin_amdgcn_global_load_lds((const __attribute__((address_space(1))) unsigned*)(Bg[i] + (k0_)),                 \
                                       (LAS unsigned*)(lds + (buf_) * STAGE_B + 16384 + (w * 4 + i) * 1024), 16, 0, 0);    \
    }                                                                                                                      \
  }
  f32x16 acc[2][NI];
#pragma unroll
  for (int mi = 0; mi < 2; ++mi)
#pragma unroll
    for (int ni = 0; ni < NI; ++ni)
#pragma unroll
      for (int r = 0; r < 16; ++r) acc[mi][ni][r] = 0.f;
  const int nk = K >> 6;
  GEMM_STAGE(0, 0);
  __syncthreads();
  const int sw = ((lane & 31) >> 1) & 7;
  const int aoff = (wr * 64 + (lane & 31)) * 128;
  const int boff = 16384 + (wc * 64 + (lane & 31)) * 128;
  for (int kt = 0; kt < nk; ++kt) {
    const int cur = kt & 1;
    if (kt + 1 < nk) GEMM_STAGE(cur ^ 1, (kt + 1) * 64);
    LAS const char* sc = lds + cur * STAGE_B;
#pragma unroll
    for (int kk = 0; kk < 4; ++kk) {
      const int co = ((kk * 2 + h) ^ sw) * 16;
      s16x8 af[2], bfr[NI];
#pragma unroll
      for (int mi = 0; mi < 2; ++mi) af[mi] = *(LAS const s16x8*)(sc + aoff + mi * 4096 + co);
#pragma unroll
      for (int ni = 0; ni < NI; ++ni) bfr[ni] = *(LAS const s16x8*)(sc + boff + ni * 4096 + co);
#pragma unroll
      for (int mi = 0; mi < 2; ++mi)
#pragma unroll
        for (int ni = 0; ni < NI; ++ni)
          acc[mi][ni] = __builtin_amdgcn_mfma_f32_32x32x16_bf16(af[mi], bfr[ni], acc[mi][ni], 0, 0, 0);
    }
    __syncthreads();
  }
#undef GEMM_STAGE
  epi(acc, smem, row0, col0, wr, wc, lane, tid);
}

template <int NI, class Epi>
__device__ void gemm_phase(const bf16_t* A, int lda, const bf16_t* Bt, int ldb, int N, int K, const Epi& epi, char* smem) {
  constexpr int BN = NI * 64;
  const int nMt = NT / 128, nNt = N / BN, T = nMt * nNt;
  for (int t = obid(); t < T; t += gridDim.x) {
    const int s = (t & 7) * (T >> 3) + (t >> 3);
    const int grp = s / (8 * nNt), r = s % (8 * nNt);
    const int mt = grp * 8 + (r & 7), nt = r >> 3;
    gemm_tile<NI, Epi>(A, lda, Bt, ldb, K, mt * 128, nt * BN, epi, smem);
  }
}

__device__ void prep_vectors(const Params& p, int odd) {
  const int tid_ = otid(); const int lane = tid_ & 63, w = tid_ >> 6;
  const bf16_t* P = p.R1;
  const int ldp = odd ? LDPO : LDPE;
  const int qcol = odd ? 2560 : 0, kcol = odd ? 3072 : 512;
  float* outk = p.out + (size_t)NT * DM + (odd ? (size_t)(524288 * 2 + 2097152 + 16384 + 128 + 2097152) : 0);
  const float qn = odd ? p.d_q_norm[lane] : 1.f, kn = odd ? p.d_k_norm[lane] : 1.f;
  const int i16 = lane & 15;
  const float inv = exp2f(-(float)i16 * (13.287712379549449f / 16.f));
  for (int row = obid() * 4 + w; row < NT; row += gridDim.x * 4) {
    const bf16_t* pr_ = P + (size_t)row * ldp;
    float v[10];
#pragma unroll
    for (int hv = 0; hv < 8; ++hv) v[hv] = bf2f(pr_[qcol + hv * 64 + lane]);
#pragma unroll
    for (int hv = 0; hv < 2; ++hv) v[8 + hv] = bf2f(pr_[kcol + hv * 64 + lane]);
    if (odd) {
#pragma unroll
      for (int hv = 0; hv < 10; ++hv) {
        const float ms = wave_sum(v[hv] * v[hv]) * (1.f / 64.f);
        v[hv] = v[hv] * rsqrtf(ms + 1e-6f) * (hv < 8 ? qn : kn);
      }
    }
    if (row < NPR) {
      outk[(size_t)row * 128 + lane] = v[8];
      outk[(size_t)row * 128 + 64 + lane] = v[9];
    } else {
      const int t = (row - NPR) & 2047;
      const float pos = (lane < 32) ? (float)(t >> 6) : (float)(t & 63);
      const float ang = pos * inv;
      const float cs = __cosf(ang), sn = __sinf(ang);
#pragma unroll
      for (int hv = 0; hv < 10; ++hv) {
        const float pr = __shfl_xor(v[hv], 16);
        v[hv] = ((lane & 16) == 0) ? (v[hv] * cs - pr * sn) : (pr * sn + v[hv] * cs);
      }
    }
#pragma unroll
    for (int hv = 0; hv < 8; ++hv) p.Qb[(size_t)row * 512 + hv * 64 + lane] = f2bf(v[hv] * (0.125f * LOG2E));
#pragma unroll
    for (int hv = 0; hv < 2; ++hv) p.Kb[(size_t)row * 128 + hv * 64 + lane] = f2bf(v[8 + hv]);
  }
}

__device__ void prep_v(const Params& p, int odd, char* smem) {
  bf16_t* sT = (bf16_t*)smem;
  const bf16_t* P = p.R1;
  const int ldp = odd ? LDPO : LDPE;
  const int vcol = odd ? 3200 : 640;
  const float* cv = odd ? p.cache_d_v : p.cache_a_v;
  const float* ck = odd ? p.cache_d_k : p.cache_a_k;
  float* outv = p.out + (size_t)NT * DM + (odd ? (size_t)(524288 * 2 + 2097152 + 16384 + 128 + 2097152 + 524288) : (size_t)524288);
  const int tid = otid();
  const int nitems = 192 * 2 + 64 + 64;
  for (int it = obid(); it < nitems; it += gridDim.x) {
    if (it < 448) {
      bf16_t* dst; int dstride;
      if (it < 384) {
        const int tb = it >> 1, kv = it & 1, row0 = tb * 64;
#pragma unroll
        for (int i = 0; i < 16; ++i) {
          const int r = (tid >> 6) + 4 * i, d = tid & 63;
          const bf16_t raw = P[(size_t)(row0 + r) * ldp + vcol + kv * 64 + d];
          sT[d * 72 + r] = raw;
          if (row0 < NPR) outv[(size_t)(row0 + r) * 128 + kv * 64 + d] = bf2f(raw);
        }
        if (row0 < NPR) { const int b = row0 >> 8, pos0 = row0 & 255; dst = p.Vt + (size_t)((b * 2 + kv) * 64) * 256 + pos0; dstride = 256; }
        else { const int rr = row0 - NPR, b = rr >> 11, pos0 = rr & 2047; dst = p.Vt + 524288 + (size_t)((b * 2 + kv) * 64) * 2048 + pos0; dstride = 2048; }
      } else {
        const int j = it - 384, b = j >> 4, kv = (j >> 3) & 1, kb = j & 7;
#pragma unroll
        for (int i = 0; i < 16; ++i) {
          const int r = (tid >> 6) + 4 * i, d = tid & 63;
          sT[d * 72 + r] = f2bf(cv[((size_t)(b * 512 + kb * 64 + r) * 2 + kv) * 64 + d]);
        }
        dst = p.Vct + (size_t)((b * 2 + kv) * 64) * 512 + kb * 64; dstride = 512;
      }
      __syncthreads();
#pragma unroll
      for (int i = 0; i < 2; ++i) {
        const int id = tid + i * 256, d = id >> 3, ch = id & 7;
        *(uint4*)(dst + (size_t)d * dstride + ch * 8) = *(const uint4*)(sT + d * 72 + ch * 8);
      }
      __syncthreads();
    } else {
      const int j = it - 448;
#pragma unroll
      for (int i = 0; i < 16; ++i) {
        const int idx = j * 4096 + i * 256 + tid;
        p.Kc[idx] = f2bf(ck[idx]);
      }
    }
  }
}

__device__ void attn_item(const Params& p, int odd, int item, char* smem) {
  bf16_t* Ks = (bf16_t*)smem;
  bf16_t* Vs = Ks + 64 * 72;
  const int tid = otid(), lane = tid & 63, g = tid >> 6, ql = lane & 31, h = lane >> 5;
  int b, kv, qb, L, seq_row0; bool sample;
  if (item < 512) { sample = true; b = item >> 7; kv = (item >> 6) & 1; qb = item & 63; L = 2048; seq_row0 = NPR + b * 2048; }
  else { const int it = item - 512; sample = false; b = it >> 4; kv = (it >> 3) & 1; qb = it & 7; L = 256; seq_row0 = b * 256; }
  const int t0 = qb * 32, q_row0 = seq_row0 + t0;
  const bf16_t* vbase = sample ? p.Vt + 524288 + (size_t)((b * 2 + kv) * 64) * 2048 : p.Vt + (size_t)((b * 2 + kv) * 64) * 256;
  const bf16_t* kbase = p.Kb + (size_t)seq_row0 * 128 + kv * 64;
  const bf16_t* kcb = p.Kc + (size_t)b * 512 * 128 + kv * 64;
  const bf16_t* vcb = p.Vct + (size_t)((b * 2 + kv) * 64) * 512;
  const bool band = sample && !odd;
  int lo = 0, hi = L >> 6;
  if (band) { lo = (t0 - 128) < 0 ? 0 : ((t0 - 128) >> 6); hi = (t0 + 160 + 63) >> 6; if (hi > 32) hi = 32; }
  const int nloc = hi - lo, ntiles = nloc + (sample ? 8 : 0);
  const int hq = kv * 4 + g;
  s16x8 qf[4];
#pragma unroll
  for (int kk = 0; kk < 4; ++kk) qf[kk] = *(const s16x8*)(p.Qb + (size_t)(q_row0 + ql) * 512 + hq * 64 + kk * 16 + h * 8);
  float m = -1e30f, lsum = 0.f;
  if (!odd) { m = p.a_sink[kv * 4 + g] * LOG2E; lsum = (h == 0) ? 1.f : 0.f; }
  f32x16 o0, o1;
#pragma unroll
  for (int r = 0; r < 16; ++r) { o0[r] = 0.f; o1[r] = 0.f; }
  u32x4 kr0, kr1, vr0, vr1;
  const int lr = tid >> 3, lch = tid & 7;
#define ATT_GL(ti_)                                                                                   \
  {                                                                                                   \
    const int ti__ = (ti_);                                                                           \
    const bf16_t* kp_; const bf16_t* vp_; size_t vst_;                                                \
    if (ti__ < nloc) { const int kt_ = lo + ti__; kp_ = kbase + (size_t)(kt_ * 64 + lr) * 128 + lch * 8; vp_ = vbase + (size_t)lr * L + kt_ * 64 + lch * 8; vst_ = (size_t)L; } \
    else { const int c_ = ti__ - nloc; kp_ = kcb + (size_t)(c_ * 64 + lr) * 128 + lch * 8; vp_ = vcb + (size_t)lr * 512 + c_ * 64 + lch * 8; vst_ = 512; } \
    kr0 = gload16(kp_); kr1 = gload16(kp_ + 32 * 128);                                                \
    vr0 = gload16(vp_); vr1 = gload16(vp_ + 32 * vst_);                                               \
  }
  ATT_GL(0);
  for (int ti = 0; ti < ntiles; ++ti) {
    vm_wait4(kr0, kr1, vr0, vr1);
    *(u32x4*)(Ks + lr * 72 + lch * 8) = kr0;
    *(u32x4*)(Ks + (lr + 32) * 72 + lch * 8) = kr1;
    *(u32x4*)(Vs + lr * 72 + lch * 8) = vr0;
    *(u32x4*)(Vs + (lr + 32) * 72 + lch * 8) = vr1;
    __syncthreads();
    if (ti + 1 < ntiles) ATT_GL(ti + 1);
    __builtin_amdgcn_sched_barrier(0);
    f32x16 s0, s1;
#pragma unroll
    for (int r = 0; r < 16; ++r) { s0[r] = 0.f; s1[r] = 0.f; }
#pragma unroll
    for (int kk = 0; kk < 4; ++kk) {
      const s16x8 a0 = *(const s16x8*)(Ks + ql * 72 + kk * 16 + h * 8);
      const s16x8 a1 = *(const s16x8*)(Ks + (32 + ql) * 72 + kk * 16 + h * 8);
      s0 = __builtin_amdgcn_mfma_f32_32x32x16_bf16(a0, qf[kk], s0, 0, 0, 0);
      s1 = __builtin_amdgcn_mfma_f32_32x32x16_bf16(a1, qf[kk], s1, 0, 0, 0);
    }
    if (band && ti < nloc) {
      const int kbase_pos = (lo + ti) * 64 + 4 * h - (t0 + ql);
#pragma unroll
      for (int r = 0; r < 16; ++r) {
        const int dlt = kbase_pos + (r & 3) + 8 * (r >> 2);
        if (dlt > 128 || dlt < -128) s0[r] = -1e30f;
        const int dl2 = dlt + 32;
        if (dl2 > 128 || dl2 < -128) s1[r] = -1e30f;
      }
    }
    float mx = -1e30f;
#pragma unroll
    for (int r = 0; r < 16; ++r) mx = fmaxf(mx, fmaxf(s0[r], s1[r]));
    mx = fmaxf(mx, __shfl_xor(mx, 32));
    const float mnew = fmaxf(m, mx);
    const float alpha = __builtin_amdgcn_exp2f(m - mnew);
    m = mnew;
    float ps = 0.f;
#pragma unroll
    for (int r = 0; r < 16; ++r) {
      s0[r] = __builtin_amdgcn_exp2f(s0[r] - mnew);
      s1[r] = __builtin_amdgcn_exp2f(s1[r] - mnew);
      ps += s0[r] + s1[r];
    }
    lsum = lsum * alpha + ps;
#pragma unroll
    for (int r = 0; r < 16; ++r) { o0[r] *= alpha; o1[r] *= alpha; }
#pragma unroll
    for (int ks = 0; ks < 4; ++ks) {
      const int kbk = ks >> 1, sp = ks & 1;
      s16x8 pf;
#pragma unroll
      for (int j = 0; j < 8; ++j) pf[j] = (short)f2bf(kbk == 0 ? s0[8 * sp + j] : s1[8 * sp + j]);
      const int keyoff = kbk * 32 + 16 * sp + 4 * h;
#pragma unroll
      for (int db = 0; db < 2; ++db) {
        const bf16_t* vp = Vs + (db * 32 + ql) * 72 + keyoff;
        const s16x4 lo4 = *(const s16x4*)(vp);
        const s16x4 hi4 = *(const s16x4*)(vp + 8);
        s16x8 vf;
        vf[0] = lo4[0]; vf[1] = lo4[1]; vf[2] = lo4[2]; vf[3] = lo4[3];
        vf[4] = hi4[0]; vf[5] = hi4[1]; vf[6] = hi4[2]; vf[7] = hi4[3];
        if (db == 0) o0 = __builtin_amdgcn_mfma_f32_32x32x16_bf16(vf, pf, o0, 0, 0, 0);
        else o1 = __builtin_amdgcn_mfma_f32_32x32x16_bf16(vf, pf, o1, 0, 0, 0);
      }
    }
    __syncthreads();
  }
  const float ltot = lsum + __shfl_xor(lsum, 32);
  const float inv = 1.f / ltot;
  bf16_t* cat = p.Hb + (size_t)(q_row0 + ql) * DM + (odd ? 512 : 0) + hq * 64;
#pragma unroll
  for (int rg = 0; rg < 4; ++rg) {
    uint2 w0, w1;
    w0.x = pk2(o0[rg * 4 + 0] * inv, o0[rg * 4 + 1] * inv); w0.y = pk2(o0[rg * 4 + 2] * inv, o0[rg * 4 + 3] * inv);
    w1.x = pk2(o1[rg * 4 + 0] * inv, o1[rg * 4 + 1] * inv); w1.y = pk2(o1[rg * 4 + 2] * inv, o1[rg * 4 + 3] * inv);
    *(uint2*)(cat + 8 * rg + 4 * h) = w0;
    *(uint2*)(cat + 32 + 8 * rg + 4 * h) = w1;
  }
}

__device__ void mlstm_item(const Params& p, int item, char* smem) {
  bf16_t* sQ = (bf16_t*)smem;
  bf16_t* sK = sQ + 64 * 136;
  bf16_t* sKt = sK + 64 * 136;
  bf16_t* sVt = sKt + 128 * 72;
  bf16_t* sW = sVt + 32 * 72;
  bf16_t* sCt = sW + 64 * 72;
  float* sU = (float*)(sCt + 32 * 136);
  float* sM = sU + 64;
  float* sA = sM + 64;
  float* sWs = sA + 64;
  float* sCl = sWs + 64;
  float* sMisc = sCl + 64;
  const bf16_t* P = p.R1;
  const int ldp = LDPE;
  const float kscale = 0.08838834764831845f;
  const int tid = otid(), lane = tid & 63, w = tid >> 6, l15 = lane & 15, kg = lane >> 4;
  bool sample; int b, head, dir, slice, L, seq_row0;
  if (item < 160) { sample = true; const int s5 = item / 5; slice = item % 5; b = s5 >> 3; head = (s5 >> 1) & 3; dir = s5 & 1; L = 2048; seq_row0 = NPR + b * 2048; }
  else { const int it = item - 160; sample = false; const int s5 = it / 5; slice = it % 5; b = s5 >> 3; head = (s5 >> 1) & 3; dir = s5 & 1; L = 256; seq_row0 = b * 256; }
  const bool nsl = (slice == 4);
  const int nch = L >> 6;
  float m = 0.f;
  f32x4 cacc[2][2];
#pragma unroll
  for (int rb = 0; rb < 2; ++rb)
#pragma unroll
    for (int nb = 0; nb < 2; ++nb)
#pragma unroll
      for (int r = 0; r < 4; ++r) cacc[rb][nb][r] = 0.f;
  if (sample) {
    const size_t sidx = (size_t)((b * 2 + dir) * 4 + head);
    m = p.state_b_m[sidx];
#pragma unroll
    for (int rb = 0; rb < 2; ++rb)
#pragma unroll
      for (int nb = 0; nb < 2; ++nb)
#pragma unroll
        for (int r = 0; r < 4; ++r) {
          const int d = 32 * w + rb * 16 + 4 * kg + r, e = nb * 16 + l15;
          float v;
          if (!nsl) v = p.state_b_C[(sidx * 128 + d) * 128 + slice * 32 + e];
          else v = (e == 0) ? p.state_b_n[sidx * 128 + d] : 0.f;
          cacc[rb][nb][r] = v;
        }
  }
#pragma unroll
  for (int rb = 0; rb < 2; ++rb)
#pragma unroll
    for (int nb = 0; nb < 2; ++nb) {
      uint2 o; o.x = pk2(cacc[rb][nb][0], cacc[rb][nb][1]); o.y = pk2(cacc[rb][nb][2], cacc[rb][nb][3]);
      *(uint2*)(sCt + (nb * 16 + l15) * 136 + 32 * w + rb * 16 + 4 * kg) = o;
    }
  const float bias_i = p.b_gate_bias[(2 * dir) * 4 + head], bias_f = p.b_gate_bias[(2 * dir + 1) * 4 + head];
  float* NUM = p.Z + (size_t)dir * NT * 512;
  u32x4 pq[4], pk[4], pv;
  unsigned pgi, pgf;
#define ML_ISSUE(cc_)                                                                                         \
  {                                                                                                           \
    const int c__ = (cc_);                                                                                    \
    {                                                                                                         \
      const int pos_ = dir ? (L - 1 - (c__ * 64 + lane)) : (c__ * 64 + lane);                                 \
      const bf16_t* gp_ = P + (size_t)(seq_row0 + pos_) * ldp + 2304;                                         \
      pgi = gload2(gp_ + (2 * dir) * 4 + head);                                                               \
      pgf = gload2(gp_ + (2 * dir + 1) * 4 + head);                                                           \
    }                                                                                                         \
    _Pragma("unroll") for (int i = 0; i < 4; ++i) {                                                           \
      const int r_ = tid & 63, ch_ = (tid >> 6) + 4 * i;                                                      \
      const int pos_ = dir ? (L - 1 - (c__ * 64 + r_)) : (c__ * 64 + r_);                                     \
      const bf16_t* rp_ = P + (size_t)(seq_row0 + pos_) * ldp + head * 128 + ch_ * 8;                         \
      pq[i] = gload16(rp_ + 768);                                                                             \
      pk[i] = gload16(rp_ + 1280);                                                                            \
    }                                                                                                         \
    if (!nsl) {                                                                                               \
      const int r_ = tid & 63, ch_ = tid >> 6;                                                                \
      const int pos_ = dir ? (L - 1 - (c__ * 64 + r_)) : (c__ * 64 + r_);                                     \
      pv = gload16(P + (size_t)(seq_row0 + pos_) * ldp + 1792 + head * 128 + slice * 32 + ch_ * 8);          \
    }                                                                                                         \
  }
  pv = (u32x4){0u, 0u, 0u, 0u};
  ML_ISSUE(0);
  for (int c = 0; c < nch; ++c) {
    asm volatile("s_waitcnt vmcnt(0)" : "+v"(pgi), "+v"(pgf), "+v"(pq[0]), "+v"(pq[1]), "+v"(pq[2]), "+v"(pq[3]), "+v"(pk[0]), "+v"(pk[1]), "+v"(pk[2]), "+v"(pk[3]), "+v"(pv) : : "memory");
    {
      const float ig = bf2f((bf16_t)pgi) + bias_i;
      const float fr = bf2f((bf16_t)pgf) + bias_f;
      const float lf = fminf(fr, 0.f) - __logf(1.f + __expf(-fabsf(fr)));
      float bc = lf;
#pragma unroll
      for (int o = 1; o < 64; o <<= 1) { const float y = __shfl_up(bc, o); if (lane >= o) bc += y; }
      const float u = ig - bc;
      float pm = u;
#pragma unroll
      for (int o = 1; o < 64; o <<= 1) { const float y = __shfl_up(pm, o); if (lane >= o) pm = fmaxf(pm, y); }
      const float M = fmaxf(m, pm);
      const float Mlast = __shfl(M, 63), bclast = __shfl(bc, 63);
      if (w == 0) {
        sU[lane] = u; sM[lane] = M; sA[lane] = __expf(m - M);
        sWs[lane] = __expf(u - Mlast) * kscale;
        sCl[lane] = __expf(-(bc + M));
        if (lane == 0) { sMisc[0] = bclast + Mlast; sMisc[1] = __expf(m - Mlast); }
      }
    }
    __syncthreads();
#pragma unroll
    for (int i = 0; i < 4; ++i) {
      const int r = tid & 63, ch = (tid >> 6) + 4 * i;
      *(u32x4*)(sQ + r * 136 + ch * 8) = pq[i];
      *(u32x4*)(sK + r * 136 + ch * 8) = pk[i];
      const float ws = sWs[r];
#pragma unroll
      for (int j = 0; j < 4; ++j) {
        sKt[(ch * 8 + 2 * j) * 72 + r] = f2bf(bf2f((bf16_t)(pk[i][j] & 0xffffu)) * ws);
        sKt[(ch * 8 + 2 * j + 1) * 72 + r] = f2bf(bf2f((bf16_t)(pk[i][j] >> 16)) * ws);
      }
    }
    {
      const int r = tid & 63, ch = tid >> 6;
      if (!nsl) {
#pragma unroll
        for (int j = 0; j < 4; ++j) {
          sVt[(ch * 8 + 2 * j) * 72 + r] = (bf16_t)(pv[j] & 0xffffu);
          sVt[(ch * 8 + 2 * j + 1) * 72 + r] = (bf16_t)(pv[j] >> 16);
        }
      } else {
#pragma unroll
        for (int j = 0; j < 8; ++j) sVt[(ch * 8 + j) * 72 + r] = (ch == 0 && j == 0) ? (bf16_t)0x3F80 : (bf16_t)0;
      }
    }
    __builtin_amdgcn_sched_barrier(0);
    if (c + 1 < nch) ML_ISSUE(c + 1);
    __builtin_amdgcn_sched_barrier(0);
    __syncthreads();
    {
      const int wr = w >> 1, wc = w & 1, h = lane >> 5, l31 = lane & 31;
      f32x16 sacc;
#pragma unroll
      for (int r = 0; r < 16; ++r) sacc[r] = 0.f;
      if (!(wr == 0 && wc == 1)) {
#pragma unroll
        for (int kk = 0; kk < 8; ++kk) {
          const s16x8 a = *(const s16x8*)(sQ + (wr * 32 + l31) * 136 + kk * 16 + h * 8);
          const s16x8 bb = *(const s16x8*)(sK + (wc * 32 + l31) * 136 + kk * 16 + h * 8);
          sacc = __builtin_amdgcn_mfma_f32_32x32x16_bf16(a, bb, sacc, 0, 0, 0);
        }
      }
      const int s = wc * 32 + l31;
      const float us = sU[s];
#pragma unroll
      for (int r = 0; r < 16; ++r) {
        const int t = wr * 32 + (r & 3) + 8 * (r >> 2) + 4 * h;
        const float wv = (s <= t) ? __expf(us - sM[t]) * sacc[r] * kscale : 0.f;
        sW[t * 72 + s] = f2bf(wv);
      }
    }
    __syncthreads();
    {
      f32x4 a1[2], a2[2];
#pragma unroll
      for (int nb = 0; nb < 2; ++nb)
#pragma unroll
        for (int r = 0; r < 4; ++r) { a1[nb][r] = 0.f; a2[nb][r] = 0.f; }
#pragma unroll
      for (int kk = 0; kk < 4; ++kk) {
        const s16x8 a = *(const s16x8*)(sQ + (16 * w + l15) * 136 + kk * 32 + kg * 8);
#pragma unroll
        for (int nb = 0; nb < 2; ++nb) {
          const s16x8 bb = *(const s16x8*)(sCt + (nb * 16 + l15) * 136 + kk * 32 + kg * 8);
          a1[nb] = mfma16_safe(a, bb, a1[nb]);
        }
      }
#pragma unroll
      for (int kk = 0; kk < 2; ++kk) {
        const s16x8 a = *(const s16x8*)(sW + (16 * w + l15) * 72 + kk * 32 + kg * 8);
#pragma unroll
        for (int nb = 0; nb < 2; ++nb) {
          const s16x8 bb = *(const s16x8*)(sVt + (nb * 16 + l15) * 72 + kk * 32 + kg * 8);
          a2[nb] = mfma16_safe(a, bb, a2[nb]);
        }
      }
#pragma unroll
      for (int r = 0; r < 4; ++r) {
        const int t = 16 * w + 4 * kg + r;
        const int pos = dir ? (L - 1 - (c * 64 + t)) : (c * 64 + t);
        const size_t row = (size_t)(seq_row0 + pos);
        const float at = sA[t];
#pragma unroll
        for (int nb = 0; nb < 2; ++nb) {
          const float val = at * a1[nb][r] + a2[nb][r];
          const int e = nb * 16 + l15;
          if (!nsl) NUM[row * 512 + head * 128 + slice * 32 + e] = val;
          else if (e == 0) { p.DEN[((size_t)dir * NT + row) * 4 + head] = val; p.CL[((size_t)dir * NT + row) * 4 + head] = sCl[t]; }
        }
      }
      const float decay = sMisc[1];
#pragma unroll
      for (int rb = 0; rb < 2; ++rb)
#pragma unroll
        for (int nb = 0; nb < 2; ++nb)
#pragma unroll
          for (int r = 0; r < 4; ++r) cacc[rb][nb][r] *= decay;
#pragma unroll
      for (int kk = 0; kk < 2; ++kk)
#pragma unroll
        for (int rb = 0; rb < 2; ++rb) {
          const s16x8 a = *(const s16x8*)(sKt + (32 * w + rb * 16 + l15) * 72 + kk * 32 + kg * 8);
#pragma unroll
          for (int nb = 0; nb < 2; ++nb) {
            const s16x8 bb = *(const s16x8*)(sVt + (nb * 16 + l15) * 72 + kk * 32 + kg * 8);
            cacc[rb][nb] = mfma16_safe(a, bb, cacc[rb][nb]);
          }
        }
      m = sMisc[0];
    }
    __syncthreads();
#pragma unroll
    for (int rb = 0; rb < 2; ++rb)
#pragma unroll
      for (int nb = 0; nb < 2; ++nb) {
        uint2 o; o.x = pk2(cacc[rb][nb][0], cacc[rb][nb][1]); o.y = pk2(cacc[rb][nb][2], cacc[rb][nb][3]);
        *(uint2*)(sCt + (nb * 16 + l15) * 136 + 32 * w + rb * 16 + 4 * kg) = o;
      }
  }
  if (!sample) {
    float* oC = p.out + (size_t)NT * DM + 524288 * 2;
    float* oN = oC + 2097152;
    float* oM = oN + 16384;
    const size_t sidx = (size_t)((b * 2 + dir) * 4 + head);
#pragma unroll
    for (int rb = 0; rb < 2; ++rb)
#pragma unroll
      for (int nb = 0; nb < 2; ++nb)
#pragma unroll
        for (int r = 0; r < 4; ++r) {
          const int d = 32 * w + rb * 16 + 4 * kg + r, e = nb * 16 + l15;
          if (!nsl) oC[(sidx * 128 + d) * 128 + slice * 32 + e] = cacc[rb][nb][r];
          else if (e == 0) oN[sidx * 128 + d] = cacc[rb][nb][r];
        }
    if (nsl && tid == 0) oM[sidx] = m;
  }
  __syncthreads();
}

__device__ void hgrn_pre(const Params& p, char* smem) {
  float* sTot = (float*)smem;
  const bf16_t* P = p.R1;
  const int ldp = LDPO;
  const int tid = otid(), d = tid & 127, half = tid >> 7;
  for (int it = obid(); it < 3072; it += gridDim.x) {
    const int dir = it / 1536, rem = it % 1536, gc = rem >> 2, head = rem & 3;
    const float lbv = 1.f / (1.f + __expf(p.c_lb_logits[head * 128 + d] - p.c_lb_logits[512 + head * 128 + d]));
    const int fcol = (dir ? 1024 : 512) + head * 128 + d;
    float Al[16], qv[16], kvv[16];
    float run = 0.f;
#pragma unroll
    for (int tt = 0; tt < 16; ++tt) {
      const int t = half * 16 + tt;
      const bf16_t* rp = P + (size_t)(gc * 32 + (dir ? 31 - t : t)) * ldp;
      const float fp = bf2f(rp[fcol]);
      const float cq = bf2f(rp[head * 128 + d]);
      const float f = lbv + (1.f - lbv) * sigmoidf_(fp);
      run += __logf(f);
      Al[tt] = run; kvv[tt] = 1.f - f; qv[tt] = cq * sigmoidf_(cq);
    }
    sTot[half * 128 + d] = run;
    __syncthreads();
    const float tot0 = sTot[d], tot1 = sTot[128 + d];
    const float Atot = tot0 + tot1, off = half ? tot0 : 0.f;
    const size_t base = (size_t)((dir * 384 + gc) * 4 + head) * 4096;
    bf16_t* hk = (dir ? p.HK1 : p.HK0) + (size_t)(gc * 4 + head) * 4096;
    unsigned kt[8];
#pragma unroll
    for (int tt = 0; tt < 16; ++tt) {
      const int t = half * 16 + tt;
      const float A = Al[tt] + off;
      p.HQ[base + t * 128 + d] = f2bf(qv[tt] * __expf(A - tot0));
      const bf16_t kb = f2bf(kvv[tt] * __expf(tot0 - A));
      hk[t * 128 + d] = kb;
      if (tt & 1) kt[tt >> 1] |= ((unsigned)kb << 16); else kt[tt >> 1] = (unsigned)kb;
    }
    {
      u32x4 w0 = {kt[0], kt[1], kt[2], kt[3]}, w1 = {kt[4], kt[5], kt[6], kt[7]};
      *(u32x4*)(p.HKt + base + d * 32 + half * 16) = w0;
      *(u32x4*)(p.HKt + base + d * 32 + half * 16 + 8) = w1;
    }
    if (half == 0) {
      float* ev = p.EV + (size_t)((dir * 384 + gc) * 4 + head) * 384;
      ev[d] = __expf(tot0); ev[128 + d] = __expf(Atot - tot0); ev[256 + d] = __expf(Atot);
    }
    __syncthreads();
  }
}

__device__ void hgrn_item(const Params& p, int item, char* smem) {
  bf16_t* sQt = (bf16_t*)smem;
  bf16_t* sKt_ = sQt + 32 * 136;
  bf16_t* sK2t = sKt_ + 32 * 136;
  bf16_t* sVt = sK2t + 128 * 40;
  bf16_t* sAtt = sVt + 32 * 40;
  bf16_t* sSt = sAtt + 32 * 40;
  const bf16_t* P = p.R1;
  const int ldp = LDPO;
  const int tid = otid(), lane = tid & 63, w = tid >> 6, l15 = lane & 15, kg = lane >> 4;
  bool sample; int b, head, dir, slice, L, seq_row0;
  if (item < 128) { sample = true; const int s4 = item >> 2; slice = item & 3; b = s4 >> 3; head = (s4 >> 1) & 3; dir = s4 & 1; L = 2048; seq_row0 = NPR + b * 2048; }
  else { const int it = item - 128; sample = false; const int s4 = it >> 2; slice = it & 3; b = s4 >> 3; head = (s4 >> 1) & 3; dir = s4 & 1; L = 256; seq_row0 = b * 256; }
  const int nch = L >> 5, gc0 = seq_row0 >> 5;
  const bf16_t* HKd = dir ? p.HK1 : p.HK0;
  f32x4 sacc[2][2];
#pragma unroll
  for (int rb = 0; rb < 2; ++rb)
#pragma unroll
    for (int nb = 0; nb < 2; ++nb)
#pragma unroll
      for (int r = 0; r < 4; ++r) {
        float v = 0.f;
        if (sample) {
          const int dd = 32 * w + rb * 16 + 4 * kg + r, e = nb * 16 + l15;
          v = p.state_c_S[(((size_t)((b * 2 + dir) * 4 + head)) * 128 + dd) * 128 + slice * 32 + e];
        }
        sacc[rb][nb][r] = v;
      }
  float* O = p.Z + (size_t)dir * NT * 512;
  u32x4 rq[2], rk[2], rkt[2], rv, ev[3][2];
  rv = (u32x4){0u, 0u, 0u, 0u};
#define HG_ISSUE(cc_)                                                                                          \
  {                                                                                                            \
    const int gc_ = gc0 + (dir ? nch - 1 - (cc_) : (cc_));                                                     \
    const size_t base_ = (size_t)((dir * 384 + gc_) * 4 + head) * 4096;                                        \
    const size_t kb_ = (size_t)(gc_ * 4 + head) * 4096;                                                        \
    _Pragma("unroll") for (int i = 0; i < 2; ++i) {                                                            \
      const int id_ = tid + i * 256;                                                                           \
      rq[i] = gload16(p.HQ + base_ + id_ * 8);                                                                 \
      rk[i] = gload16(HKd + kb_ + id_ * 8);                                                                    \
      rkt[i] = gload16(p.HKt + base_ + id_ * 8);                                                               \
    }                                                                                                          \
    if (tid < 128) {                                                                                           \
      const int r_ = tid & 31, ch_ = tid >> 5;                                                                 \
      rv = gload16(P + (size_t)(gc_ * 32 + (dir ? 31 - r_ : r_)) * ldp + 1536 + head * 128 + slice * 32 + ch_ * 8); \
    }                                                                                                          \
    const float* evb_ = p.EV + (size_t)((dir * 384 + gc_) * 4 + head) * 384 + 32 * w + 4 * kg;                 \
    _Pragma("unroll") for (int x = 0; x < 3; ++x) {                                                            \
      ev[x][0] = gload16(evb_ + x * 128);                                                                      \
      ev[x][1] = gload16(evb_ + x * 128 + 16);                                                                 \
    }                                                                                                          \
  }
#define HG_WAIT() asm volatile("s_waitcnt vmcnt(0)" : "+v"(rq[0]), "+v"(rq[1]), "+v"(rk[0]), "+v"(rk[1]), "+v"(rkt[0]), "+v"(rkt[1]), "+v"(rv), "+v"(ev[0][0]), "+v"(ev[0][1]), "+v"(ev[1][0]), "+v"(ev[1][1]), "+v"(ev[2][0]), "+v"(ev[2][1]) : : "memory")
  f32x4 curE[2], cure2[2];
#define HG_STAGE()                                                                                             \
  {                                                                                                            \
    _Pragma("unroll") for (int i = 0; i < 2; ++i) {                                                            \
      const int id_ = tid + i * 256;                                                                           \
      *(u32x4*)(sQt + (id_ >> 4) * 136 + (id_ & 15) * 8) = rq[i];                                              \
      *(u32x4*)(sKt_ + (id_ >> 4) * 136 + (id_ & 15) * 8) = rk[i];                                             \
      *(u32x4*)(sK2t + (id_ >> 2) * 40 + (id_ & 3) * 8) = rkt[i];                                              \
    }                                                                                                          \
    if (tid < 128) {                                                                                           \
      const int r_ = tid & 31, ch_ = tid >> 5;                                                                 \
      _Pragma("unroll") for (int j = 0; j < 4; ++j) {                                                          \
        sVt[(ch_ * 8 + 2 * j) * 40 + r_] = (bf16_t)(rv[j] & 0xffffu);                                          \
        sVt[(ch_ * 8 + 2 * j + 1) * 40 + r_] = (bf16_t)(rv[j] >> 16);                                          \
      }                                                                                                        \
    }                                                                                                          \
    _Pragma("unroll") for (int rb = 0; rb < 2; ++rb) {                                                         \
      f32x4 e1_;                                                                                               \
      _Pragma("unroll") for (int r = 0; r < 4; ++r) {                                                          \
        e1_[r] = __uint_as_float(ev[0][rb][r]);                                                                \
        cure2[rb][r] = __uint_as_float(ev[1][rb][r]);                                                          \
        curE[rb][r] = __uint_as_float(ev[2][rb][r]);                                                           \
      }                                                                                                        \
      _Pragma("unroll") for (int nb = 0; nb < 2; ++nb) {                                                       \
        uint2 o_;                                                                                              \
        o_.x = pk2(sacc[rb][nb][0] * e1_[0], sacc[rb][nb][1] * e1_[1]);                                        \
        o_.y = pk2(sacc[rb][nb][2] * e1_[2], sacc[rb][nb][3] * e1_[3]);                                        \
        *(uint2*)(sSt + (nb * 16 + l15) * 136 + 32 * w + rb * 16 + 4 * kg) = o_;                               \
      }                                                                                                        \
    }                                                                                                          \
  }
  HG_ISSUE(0);
  HG_WAIT();
  HG_STAGE();
  __syncthreads();
  const int br = w >> 1, bcn = w & 1;
  for (int c = 0; c < nch; ++c) {
    if (c + 1 < nch) HG_ISSUE(c + 1);
    __builtin_amdgcn_sched_barrier(0);
    {
      f32x4 acc;
#pragma unroll
      for (int r = 0; r < 4; ++r) acc[r] = 0.f;
      if (!(br == 0 && bcn == 1)) {
#pragma unroll
        for (int kk = 0; kk < 4; ++kk) {
          const s16x8 a = *(const s16x8*)(sQt + (br * 16 + l15) * 136 + kk * 32 + kg * 8);
          const s16x8 bb = *(const s16x8*)(sKt_ + (bcn * 16 + l15) * 136 + kk * 32 + kg * 8);
          acc = mfma16_safe(a, bb, acc);
        }
      }
#pragma unroll
      for (int r = 0; r < 4; ++r) {
        const int t = br * 16 + 4 * kg + r, sidx = bcn * 16 + l15;
        sAtt[t * 40 + sidx] = (sidx <= t) ? f2bf(acc[r]) : (bf16_t)0;
      }
    }
    __syncthreads();
    {
      f32x4 oacc;
#pragma unroll
      for (int r = 0; r < 4; ++r) oacc[r] = 0.f;
#pragma unroll
      for (int kk = 0; kk < 4; ++kk) {
        const s16x8 a = *(const s16x8*)(sQt + (br * 16 + l15) * 136 + kk * 32 + kg * 8);
        const s16x8 bb = *(const s16x8*)(sSt + (bcn * 16 + l15) * 136 + kk * 32 + kg * 8);
        oacc = mfma16_safe(a, bb, oacc);
      }
      {
        const s16x8 a = *(const s16x8*)(sAtt + (br * 16 + l15) * 40 + kg * 8);
        const s16x8 bb = *(const s16x8*)(sVt + (bcn * 16 + l15) * 40 + kg * 8);
        oacc = mfma16_safe(a, bb, oacc);
      }
      const int gc = gc0 + (dir ? nch - 1 - c : c);
#pragma unroll
      for (int r = 0; r < 4; ++r) {
        const int t = br * 16 + 4 * kg + r, e = bcn * 16 + l15;
        O[(size_t)(gc * 32 + (dir ? 31 - t : t)) * 512 + head * 128 + slice * 32 + e] = oacc[r];
      }
#pragma unroll
      for (int rb = 0; rb < 2; ++rb) {
        const s16x8 a = *(const s16x8*)(sK2t + (32 * w + rb * 16 + l15) * 40 + kg * 8);
#pragma unroll
        for (int nb = 0; nb < 2; ++nb) {
          const s16x8 bb = *(const s16x8*)(sVt + (nb * 16 + l15) * 40 + kg * 8);
          f32x4 ds;
#pragma unroll
          for (int r = 0; r < 4; ++r) ds[r] = 0.f;
          ds = mfma16_safe(a, bb, ds);
#pragma unroll
          for (int r = 0; r < 4; ++r) sacc[rb][nb][r] = curE[rb][r] * sacc[rb][nb][r] + cure2[rb][r] * ds[r];
        }
      }
    }
    __syncthreads();
    if (c + 1 < nch) {
      HG_WAIT();
      HG_STAGE();
    }
    __syncthreads();
  }
  if (!sample) {
    float* oS = p.out + (size_t)NT * DM + 524288 * 2 + 2097152 + 16384 + 128;
#pragma unroll
    for (int rb = 0; rb < 2; ++rb)
#pragma unroll
      for (int nb = 0; nb < 2; ++nb)
#pragma unroll
        for (int r = 0; r < 4; ++r) {
          const int dd = 32 * w + rb * 16 + 4 * kg + r, e = nb * 16 + l15;
          oS[(((size_t)((b * 2 + dir) * 4 + head)) * 128 + dd) * 128 + slice * 32 + e] = sacc[rb][nb][r];
        }
  }
  __syncthreads();
}

__device__ void combine_phase(const Params& p, int odd) {
  const int tid_ = otid(); const int lane = tid_ & 63, w = tid_ >> 6;
  const bf16_t* P = p.R1;
  const float* N0 = p.Z;
  const float* N1 = p.Z + (size_t)NT * 512;
  const float* gp = odd ? p.c_norm_g : p.b_norm_g;
  float g0[4], g1[4];
#pragma unroll
  for (int hd = 0; hd < 4; ++hd) { g0[hd] = gp[hd * 128 + lane]; g1[hd] = gp[hd * 128 + 64 + lane]; }
  const int ldp = odd ? LDPO : LDPE, gcol = odd ? 2048 : 2320, ocol = odd ? 0 : 512;
  for (int row = obid() * 4 + w; row < NT; row += gridDim.x * 4) {
    float a0[4], a1[4], b0[4], b1[4], gt0[4], gt1[4], i0[4], i1[4];
#pragma unroll
    for (int hd = 0; hd < 4; ++hd) {
      const size_t o = (size_t)row * 512 + hd * 128;
      a0[hd] = N0[o + lane]; a1[hd] = N0[o + 64 + lane]; b0[hd] = N1[o + lane]; b1[hd] = N1[o + 64 + lane];
      gt0[hd] = bf2f(P[(size_t)row * ldp + gcol + hd * 128 + lane]);
      gt1[hd] = bf2f(P[(size_t)row * ldp + gcol + hd * 128 + 64 + lane]);
      i0[hd] = 1.f; i1[hd] = 1.f;
      if (!odd) {
        const float d0 = p.DEN[((size_t)row) * 4 + hd], c0 = p.CL[((size_t)row) * 4 + hd];
        const float d1 = p.DEN[((size_t)NT + row) * 4 + hd], c1 = p.CL[((size_t)NT + row) * 4 + hd];
        i0[hd] = 1.f / fmaxf(fabsf(d0), c0); i1[hd] = 1.f / fmaxf(fabsf(d1), c1);
      }
    }
#pragma unroll
    for (int hd = 0; hd < 4; ++hd) {
      const float h0 = a0[hd] * i0[hd] + b0[hd] * i1[hd];
      const float h1 = a1[hd] * i0[hd] + b1[hd] * i1[hd];
      const float ms = wave_sum(h0 * h0 + h1 * h1) * (1.f / 128.f);
      const float rs = rsqrtf(ms + 1e-6f);
      const float m0 = odd ? gt0[hd] * sigmoidf_(gt0[hd]) : sigmoidf_(gt0[hd]);
      const float m1 = odd ? gt1[hd] * sigmoidf_(gt1[hd]) : sigmoidf_(gt1[hd]);
      p.Hb[(size_t)row * DM + ocol + hd * 128 + lane] = f2bf(m0 * h0 * rs * g0[hd]);
      p.Hb[(size_t)row * DM + ocol + hd * 128 + 64 + lane] = f2bf(m1 * h1 * rs * g1[hd]);
    }
  }
}

__device__ __forceinline__ void my_gsync(unsigned* bar, unsigned& epoch, unsigned nblocks) {
  asm volatile("s_waitcnt vmcnt(0) lgkmcnt(0)" ::: "memory");
  __syncthreads();
  epoch += 1;
  if (threadIdx.x == 0) {
    __builtin_amdgcn_fence(__ATOMIC_RELEASE, "agent");
    asm volatile("s_waitcnt vmcnt(0) lgkmcnt(0)" ::: "memory");
    const unsigned g = blockIdx.x & 31u;
    const unsigned gsize = (nblocks >> 5) + ((g < (nblocks & 31u)) ? 1u : 0u);
    const unsigned old = __hip_atomic_fetch_add(&bar[g * 64], 1u, __ATOMIC_RELAXED, __HIP_MEMORY_SCOPE_AGENT);
    if (old + 1 == epoch * gsize) {
      const unsigned ngroups = nblocks < 32u ? nblocks : 32u;
      const unsigned old2 = __hip_atomic_fetch_add(&bar[32 * 64], 1u, __ATOMIC_RELAXED, __HIP_MEMORY_SCOPE_AGENT);
      if (old2 + 1 == epoch * ngroups) __hip_atomic_store(&bar[33 * 64], epoch, __ATOMIC_RELAXED, __HIP_MEMORY_SCOPE_AGENT);
    }
    while (__hip_atomic_load(&bar[33 * 64], __ATOMIC_RELAXED, __HIP_MEMORY_SCOPE_AGENT) < epoch) __builtin_amdgcn_s_sleep(1);
    __builtin_amdgcn_fence(__ATOMIC_ACQUIRE, "agent");
  }
  __syncthreads();
  __builtin_amdgcn_fence(__ATOMIC_ACQUIRE, "agent");
}
#define XB_XCNT(j) (4096 + 64 * (j))
#define XB_XSUB(j) (5120 + 64 * (j))
#define XB_XGEN(j) (6144 + 64 * (j))
#define XB_TOP 7168
#define XB_TOPGEN 7232
__device__ __forceinline__ unsigned xb_ld(unsigned* q) { return __hip_atomic_load(q, __ATOMIC_RELAXED, __HIP_MEMORY_SCOPE_AGENT); }
__device__ __forceinline__ unsigned xb_add(unsigned* q) { return __hip_atomic_fetch_add(q, 1u, __ATOMIC_RELAXED, __HIP_MEMORY_SCOPE_AGENT); }
__device__ __forceinline__ void xb_st(unsigned* q, unsigned v) { __hip_atomic_store(q, v, __ATOMIC_RELAXED, __HIP_MEMORY_SCOPE_AGENT); }
__device__ __forceinline__ void xsync(unsigned* bar, unsigned& epoch, unsigned xcc, unsigned cntx, unsigned nxcc) {
  asm volatile("s_waitcnt vmcnt(0) lgkmcnt(0)" ::: "memory");
  __syncthreads();
  epoch += 1;
  if (threadIdx.x == 0) {
    const unsigned old = xb_add(&bar[XB_XSUB(xcc)]);
    if (old + 1 == epoch * cntx) {
      __builtin_amdgcn_fence(__ATOMIC_RELEASE, "agent");
      asm volatile("s_waitcnt vmcnt(0) lgkmcnt(0)" ::: "memory");
      const unsigned old2 = xb_add(&bar[XB_TOP]);
      if (old2 + 1 == epoch * nxcc) xb_st(&bar[XB_TOPGEN], epoch);
      else while (xb_ld(&bar[XB_TOPGEN]) < epoch) __builtin_amdgcn_s_sleep(1);
      xb_st(&bar[XB_XGEN(xcc)], epoch);
    } else {
      while (xb_ld(&bar[XB_XGEN(xcc)]) < epoch) __builtin_amdgcn_s_sleep(1);
    }
    __builtin_amdgcn_fence(__ATOMIC_ACQUIRE, "agent");
    asm volatile("s_waitcnt vmcnt(0) lgkmcnt(0)" ::: "memory");
  }
  __syncthreads();
}
#define GSYNC() xsync(p.bar, xepoch, xcc, cntx, nxcc)
__global__ void __launch_bounds__(256, 2) fwd_megakernel(Params p) {
  cg::grid_group grid = cg::this_grid();
  __shared__ __attribute__((aligned(16))) char smem[LDS_BYTES];
  const int G = gridDim.x;
  unsigned epoch = 0, xepoch = 0;
  if (p.njobs < 0) grid.sync();
  const unsigned xcc = (unsigned)__builtin_amdgcn_s_getreg((3 << 11) | 20) & 0xFu;
  if (threadIdx.x == 0) xb_add(&p.bar[XB_XCNT(xcc)]);
  my_gsync(p.bar, epoch, (unsigned)gridDim.x);
  const unsigned cntx = xb_ld(&p.bar[XB_XCNT(xcc)]);
  unsigned nxcc = 0;
#pragma unroll
  for (int jx = 0; jx < 16; ++jx) nxcc += (xb_ld(&p.bar[XB_XCNT(jx)]) != 0u) ? 1u : 0u;

  {
    const int nmod = 72, b_ = obid();
    if (G > 2 * nmod) {
      if (b_ < nmod) mod_item(p, b_, smem);
      else {
        for (int t = b_ - nmod; t < p.total_conv_tiles; t += G - nmod) {
          int j = 0;
#pragma unroll 1
          for (int q = 1; q < p.njobs; ++q) if (t >= p.jobs[q].tile0) j = q;
          conv_tile(p.jobs[j], t - p.jobs[j].tile0, smem);
        }
      }
    } else {
      for (int it = b_; it < nmod + p.total_conv_tiles; it += G) {
        if (it < nmod) mod_item(p, it, smem);
        else {
          const int t = it - nmod;
          int j = 0;
#pragma unroll 1
          for (int q = 1; q < p.njobs; ++q) if (t >= p.jobs[q].tile0) j = q;
          conv_tile(p.jobs[j], t - p.jobs[j].tile0, smem);
        }
      }
    }
  }
  GSYNC();
  modulate_input_phase(p);
  GSYNC();

#pragma unroll 1
  for (int l = 0; l < 2; ++l) {
    const int odd = l;
#pragma unroll 1
    for (int j = 0; j < 2; ++j) {
      if (j == 1) {
        {
          EpiStoreBf16 epi{p.R1, odd ? LDPO : LDPE};
          gemm_phase<2, EpiStoreBf16>(p.Hb, DM, odd ? p.WtInO : p.WtInE, DM, odd ? LDPO : LDPE, DM, epi, smem);
        }
        GSYNC();
        prep_vectors(p, odd);
        prep_v(p, odd, smem);
        if (odd) hgrn_pre(p, smem);
        GSYNC();
        {
          const int nlong = odd ? 128 : 160, nshort = odd ? 512 : 640, natt = 768;
          const int b_ = obid();
          if (b_ < nlong && G > nlong) {
            if (!odd) mlstm_item(p, b_, smem); else hgrn_item(p, b_, smem);
          } else {
            const int first = (G > nlong) ? b_ - nlong : b_, stride = (G > nlong) ? G - nlong : G;
            const int lo_it = (G > nlong) ? 0 : -nlong;
            for (int it = first + lo_it; it < natt + nshort; it += stride) {
              if (it < 0) { if (!odd) mlstm_item(p, it + nlong, smem); else hgrn_item(p, it + nlong, smem); }
              else if (it < natt) attn_item(p, odd, it, smem);
              else if (!odd) mlstm_item(p, nlong + (it - natt), smem);
              else hgrn_item(p, nlong + (it - natt), smem);
            }
          }
        }
        GSYNC();
        combine_phase(p, odd);
        GSYNC();
        {
          EpiResid<2> epi{p.Z, p.out, p.out + (size_t)NPR * DM, modp(p, l, 0, 5), 1.f};
          gemm_phase<2, EpiResid<2>>(p.Hb, DM, odd ? p.WtOutO : p.WtOutE, DM, DM, DM, epi, smem);
        }
        GSYNC();
        ln_phase(p, p.ln_g + (size_t)(l * 3 + 1) * DM, p.ln_b + (size_t)(l * 3 + 1) * DM, true, l, 2);
        GSYNC();
      }
      const int j2 = j * 2;
      {
        EpiSwiglu epi{p.R1};
        gemm_phase<2, EpiSwiglu>(p.Hb, DM, p.Wt13p[l * 2 + j], DM, 5632, DM, epi, smem);
      }
      GSYNC();
      {
        const bool first = (l == 0 && j == 0);
        EpiResid<2> epi{p.Z, first ? p.x_prompt : p.out, first ? p.x_sample : p.out + (size_t)NPR * DM, modp(p, l, 0, 3 * j2 + 2), 0.5f};
        gemm_phase<2, EpiResid<2>>(p.R1, DFF, p.Wt2p[l * 2 + j], DFF, DM, DFF, epi, smem);
      }
      GSYNC();
      {
        const bool last = (l == 1 && j == 1);
        const int nl = (j == 0) ? l : l + 1, nj = (j == 0) ? 1 : 0;
        ln_phase(p, p.ln_g + (size_t)(l * 3 + j2) * DM, p.ln_b + (size_t)(l * 3 + j2) * DM, !last, last ? 0 : nl, last ? 0 : nj);
      }
      GSYNC();
    }
  }
}


template <int PH>
__global__ void __launch_bounds__(256, 2) k_phase(Params p, int l, int j) {
  __shared__ __attribute__((aligned(16))) char smem[LDS_BYTES];
  const int G = gridDim.x;
  const int odd = l;
  if (PH == 0) {
    const int nmod = 72;
    for (int it = obid(); it < nmod + p.total_conv_tiles; it += G) {
      if (it < nmod) mod_item(p, it, smem);
      else {
        const int t = it - nmod;
        int jj = 0;
#pragma unroll 1
        for (int q = 1; q < p.njobs; ++q) if (t >= p.jobs[q].tile0) jj = q;
        conv_tile(p.jobs[jj], t - p.jobs[jj].tile0, smem);
      }
    }
  } else if (PH == 1) {
    modulate_input_phase(p);
  } else if (PH == 2) {
    EpiStoreBf16 epi{p.R1, odd ? LDPO : LDPE};
    gemm_phase<2, EpiStoreBf16>(p.Hb, DM, odd ? p.WtInO : p.WtInE, DM, odd ? LDPO : LDPE, DM, epi, smem);
  } else if (PH == 3) {
    prep_vectors(p, odd);
    prep_v(p, odd, smem);
    if (odd) hgrn_pre(p, smem);
  } else if (PH == 4) {
    for (int it = obid(); it < 160 + 640 + 768; it += G) {
      if (it < 160) mlstm_item(p, it, smem);
      else if (it < 160 + 768) attn_item(p, 0, it - 160, smem);
      else mlstm_item(p, it - 768, smem);
    }
  } else if (PH == 5) {
    for (int it = obid(); it < 128 + 512 + 768; it += G) {
      if (it < 128) hgrn_item(p, it, smem);
      else if (it < 128 + 768) attn_item(p, 1, it - 128, smem);
      else hgrn_item(p, it - 768, smem);
    }
  } else if (PH == 6) {
    combine_phase(p, odd);
  } else if (PH == 7) {
    EpiResid<1> epi{p.Z, p.out, p.out + (size_t)NPR * DM, modp(p, l, 0, 5), 1.f};
    gemm_phase<1, EpiResid<1>>(p.Hb, DM, odd ? p.WtOutO : p.WtOutE, DM, DM, DM, epi, smem);
  } else if (PH == 8) {
    ln_phase(p, p.ln_g + (size_t)(l * 3 + 1) * DM, p.ln_b + (size_t)(l * 3 + 1) * DM, true, l, 2);
  } else if (PH == 9) {
    EpiSwiglu epi{p.R1};
    gemm_phase<2, EpiSwiglu>(p.Hb, DM, p.Wt13p[l * 2 + j], DM, 5632, DM, epi, smem);
  } else if (PH == 10) {
    const int j2 = j * 2;
    const bool first = (l == 0 && j == 0);
    EpiResid<1> epi{p.Z, first ? p.x_prompt : p.out, first ? p.x_sample : p.out + (size_t)NPR * DM, modp(p, l, 0, 3 * j2 + 2), 0.5f};
    gemm_phase<1, EpiResid<1>>(p.R1, DFF, p.Wt2p[l * 2 + j], DFF, DM, DFF, epi, smem);
  } else if (PH == 13) {
    for (size_t i = (size_t)obid() * 256 + otid(); i < (size_t)8192 * 512; i += (size_t)G * 256) p.SAVE[i] = p.Z[i];
  } else if (PH == 14) {
    bool bad = false;
    for (size_t i = (size_t)obid() * 256 + otid(); i < (size_t)8192 * 512; i += (size_t)G * 256) if (__float_as_uint(p.SAVE[i]) != __float_as_uint(p.Z[i])) bad = true;
    if (bad) { volatile int* q = (volatile int*)p.SAVE; while (q[0] != 0x7fffffff) { __builtin_amdgcn_s_sleep(10); } }
  } else if (PH == 11) {
    const int j2 = j * 2;
    const bool last = (l == 1 && j == 1);
    const int nl = (j == 0) ? l : l + 1, nj = (j == 0) ? 1 : 0;
    ln_phase(p, p.ln_g + (size_t)(l * 3 + j2) * DM, p.ln_b + (size_t)(l * 3 + j2) * DM, !last, last ? 0 : nl, last ? 0 : nj);
  }
}
extern "C" void kernel_launch(void* const* d_in, const int* in_sizes, int n_in, void* d_out, int out_size, void* d_ws,
                              size_t ws_size, hipStream_t stream) {
  static Params p;
  memset(&p, 0, sizeof(p));
  const float** ip = (const float**)&p.x_prompt;
  for (int i = 0; i < 30; ++i) ip[i] = (const float*)d_in[i];
  p.out = (float*)d_out;
  char* ws = (char*)d_ws;
  size_t off = 0;
  auto take = [&](size_t bytes) { char* r = ws + off; off += (bytes + 255) & ~(size_t)255; return r; };
  p.bar = (unsigned*)take(32768);
  char* l0_begin = ws + off;
  p.Wt13p[0] = (bf16_t*)take((size_t)5632 * 1024 * 2);
  p.Wt13p[1] = (bf16_t*)take((size_t)5632 * 1024 * 2);
  p.Wt2p[0] = (bf16_t*)take((size_t)1024 * DFF * 2);
  p.Wt2p[1] = (bf16_t*)take((size_t)1024 * DFF * 2);
  p.WtInE = (bf16_t*)take((size_t)LDPE * 1024 * 2);
  p.WtOutE = (bf16_t*)take((size_t)1024 * 1024 * 2);
  char* l0_end = ws + off;
  p.HQ = (bf16_t*)l0_begin;
  p.EV = (float*)(l0_begin + 25165824);
  p.HK0 = (bf16_t*)(l0_begin + 25165824 + 4718592);
  if (l0_begin + 25165824 + 4718592 + 12582912 > l0_end) fprintf(stderr, "layer-0 weight region too small for the HGRN buffers\n");
  p.Wt13p[2] = (bf16_t*)take((size_t)5632 * 1024 * 2);
  p.Wt13p[3] = (bf16_t*)take((size_t)5632 * 1024 * 2);
  p.Wt2p[2] = (bf16_t*)take((size_t)1024 * DFF * 2);
  p.Wt2p[3] = (bf16_t*)take((size_t)1024 * DFF * 2);
  p.WtInO = (bf16_t*)take((size_t)LDPO * 1024 * 2);
  p.WtOutO = (bf16_t*)take((size_t)1024 * 1024 * 2);
  p.HK1 = (bf16_t*)take((size_t)12582912);
  p.HKt = (bf16_t*)take((size_t)25165824);
  p.MOD = (float*)take((size_t)2 * 5 * 9216 * 4);
  p.Hb = (bf16_t*)take((size_t)NT * DM * 2);
  p.R1 = (bf16_t*)take((size_t)NT * LDPO * 2);
  p.Z = (float*)take((size_t)NT * DM * 4);
  p.Qb = (bf16_t*)take((size_t)NT * 512 * 2);
  p.Kb = (bf16_t*)take((size_t)NT * 128 * 2);
  p.Vt = (bf16_t*)take((size_t)(524288 + 1048576) * 2);
  p.Kc = (bf16_t*)take((size_t)262144 * 2);
  p.Vct = (bf16_t*)take((size_t)262144 * 2);
  p.DEN = (float*)take((size_t)2 * NT * 4 * 4);
  p.CL = (float*)take((size_t)2 * NT * 4 * 4);
  if (off > ws_size) fprintf(stderr, "workspace too small: need %zu have %zu\n", off, ws_size);
  int nj = 0, tiles = 0;
  auto add = [&](const float* src, bf16_t* dst, int K, int N, int Npad, int mode) {
    ConvJob& jb = p.jobs[nj++];
    jb.src = src; jb.dst = dst; jb.K = K; jb.N = N; jb.Npad = Npad; jb.mode = mode; jb.tile0 = tiles; jb.pad0 = 0;
    tiles += (K / 64) * (Npad / 64);
  };
  for (int lj = 0; lj < 4; ++lj) {
    add(p.ffn_w1 + (size_t)lj * 1024 * DFF, p.Wt13p[lj], 1024, DFF, DFF, 1);
    add(p.ffn_w3 + (size_t)lj * 1024 * DFF, p.Wt13p[lj], 1024, DFF, DFF, 2);
    add(p.ffn_w2 + (size_t)lj * DFF * 1024, p.Wt2p[lj], DFF, 1024, 1024, 0);
  }
  add(p.w_in_even, p.WtInE, 1024, 2832, LDPE, 0);
  add(p.w_in_odd, p.WtInO, 1024, LDPO, LDPO, 0);
  add(p.w_out_even, p.WtOutE, 1024, 1024, 1024, 0);
  add(p.w_out_odd, p.WtOutO, 1024, 1024, 1024, 0);
  p.njobs = nj; p.total_conv_tiles = tiles;
  static int grid_blocks = 0;
  if (!grid_blocks) {
    int dev = 0, cus = 0, per_cu = 0;
    hipGetDevice(&dev);
    hipDeviceGetAttribute(&cus, hipDeviceAttributeMultiprocessorCount, dev);
    hipOccupancyMaxActiveBlocksPerMultiprocessor(&per_cu, fwd_megakernel, 256, 0);
    per_cu = 2;
    grid_blocks = cus * per_cu;
  }
  hipMemsetAsync(p.bar, 0, 32768, stream);
#if MULTI_LAUNCH
  const dim3 g(512), b(256);
  k_phase<0><<<g, b, 0, stream>>>(p, 0, 0);
  k_phase<1><<<g, b, 0, stream>>>(p, 0, 0);
  for (int l = 0; l < 2; ++l)
    for (int j = 0; j < 2; ++j) {
      if (j == 1) {
        k_phase<2><<<g, b, 0, stream>>>(p, l, j);
        k_phase<3><<<g, b, 0, stream>>>(p, l, j);
        if (l == 0) k_phase<4><<<g, b, 0, stream>>>(p, l, j); else k_phase<5><<<g, b, 0, stream>>>(p, l, j);
        k_phase<6><<<g, b, 0, stream>>>(p, l, j);
        k_phase<7><<<g, b, 0, stream>>>(p, l, j);
        k_phase<8><<<g, b, 0, stream>>>(p, l, j);
      }
      k_phase<9><<<g, b, 0, stream>>>(p, l, j);
      k_phase<10><<<g, b, 0, stream>>>(p, l, j);
      k_phase<11><<<g, b, 0, stream>>>(p, l, j);
    }
#else
  void* args[] = {&p};
  hipError_t e = hipLaunchCooperativeKernel((void*)fwd_megakernel, dim3(grid_blocks), dim3(256), args, 0, stream);
  if (e != hipSuccess) fprintf(stderr, "cooperative launch failed: %s (grid %d)\n", hipGetErrorString(e), grid_blocks);
#endif
}
```

```cpp
#define MULTI_LAUNCH 0
#include <hip/hip_runtime.h>
#include <hip/hip_cooperative_groups.h>
#include <cstdint>
#include <cstring>
#include <cstdio>
namespace cg = cooperative_groups;

typedef unsigned short bf16_t;
typedef short s16x8 __attribute__((ext_vector_type(8)));
typedef short s16x4 __attribute__((ext_vector_type(4)));
typedef float f32x4 __attribute__((ext_vector_type(4)));
typedef float f32x16 __attribute__((ext_vector_type(16)));
typedef unsigned u32x4 __attribute__((ext_vector_type(4)));

#define NT 12288
#define NPR 4096
#define DM 1024
#define DFF 2816
#define LDPE 2944
#define LDPO 3328
#define ALPHA_F 1.4142135623730951f
#define LOG2E 1.4426950408889634f
#define LDS_BYTES 77824

struct ConvJob { const float* src; bf16_t* dst; int K, N, Npad, mode, tile0, pad0; };

struct Params {
  const float *x_prompt, *x_sample, *c, *cache_a_k, *cache_a_v, *state_b_C, *state_b_n, *state_b_m, *state_c_S,
      *cache_d_k, *cache_d_v, *c_ctx, *ada_w, *ada_b, *ln_g, *ln_b, *ffn_w1, *ffn_w3, *ffn_w2, *w_in_even,
      *w_out_even, *a_sink, *b_gate_bias, *b_norm_g, *w_in_odd, *w_out_odd, *c_lb_logits, *c_norm_g, *d_q_norm,
      *d_k_norm;
  float* out;
  bf16_t *Wt13p[4], *Wt2p[4], *WtInE, *WtInO, *WtOutE, *WtOutO;
  bf16_t *HQ, *HK0, *HK1, *HKt; float* EV;
  float* MOD;
  bf16_t* Hb;
  bf16_t* R1;
  float* Z;
  bf16_t *Qb, *Kb, *Vt, *Kc, *Vct;
  float *DEN, *CL;
  ConvJob jobs[16];
  int njobs, total_conv_tiles, conv_tiles_l0, pad1;
  float* SAVE;
  unsigned* bar;
};

__device__ __forceinline__ int otid() { int t = threadIdx.x; asm volatile("" : "+v"(t)); return t; }
__device__ __forceinline__ int obid() { int t = blockIdx.x; asm volatile("" : "+s"(t)); return t; }
__device__ __forceinline__ u32x4 gload16(const void* ptr) {
  u32x4 r;
  asm volatile("global_load_dwordx4 %0, %1, off" : "=v"(r) : "v"(ptr) : "memory");
  return r;
}
__device__ __forceinline__ unsigned gload2(const void* ptr) {
  unsigned r;
  asm volatile("global_load_ushort %0, %1, off" : "=v"(r) : "v"(ptr) : "memory");
  return r;
}
__device__ __forceinline__ void vm_wait4(u32x4& a, u32x4& b, u32x4& c, u32x4& d) {
  asm volatile("s_waitcnt vmcnt(0)" : "+v"(a), "+v"(b), "+v"(c), "+v"(d) : : "memory");
}
__device__ __forceinline__ void vm_wait2(u32x4& a, u32x4& b) {
  asm volatile("s_waitcnt vmcnt(0)" : "+v"(a), "+v"(b) : : "memory");
}
__device__ __forceinline__ f32x4 mfma16_safe(s16x8 a, s16x8 b, f32x4 c) {
  asm volatile("s_nop 4\n\tv_mfma_f32_16x16x32_bf16 %0, %1, %2, %0\n\ts_nop 7\n\ts_nop 7" : "+v"(c) : "v"(a), "v"(b));
  return c;
}
__device__ __forceinline__ float bf2f(bf16_t v) { return __uint_as_float(((unsigned)v) << 16); }
__device__ __forceinline__ bf16_t f2bf(float f) {
  unsigned u = __float_as_uint(f);
  u += 0x7fffu + ((u >> 16) & 1u);
  return (bf16_t)(u >> 16);
}
__device__ __forceinline__ unsigned pk2(float a, float b) { return (unsigned)f2bf(a) | ((unsigned)f2bf(b) << 16); }
__device__ __forceinline__ float wave_sum(float v) {
#pragma unroll
  for (int o = 32; o > 0; o >>= 1) v += __shfl_xor(v, o);
  return v;
}
__device__ __forceinline__ int mod_index(int row) { return row < NPR ? 0 : 1 + ((row - NPR) >> 11); }
__device__ __forceinline__ const float* modp(const Params& p, int l, int mi, int part) {
  return p.MOD + ((size_t)((l * 5 + mi) * 9 + part)) * DM;
}
__device__ __forceinline__ float sigmoidf_(float x) { return 1.f / (1.f + __expf(-x)); }

__device__ __forceinline__ void conv_tile(const ConvJob& jb, int t, char* smem) {
  float* sT = (float*)smem;
  const int nkt = jb.K >> 6;
  const int kt = t % nkt, nt = t / nkt;
  const int k0 = kt * 64, n0 = nt * 64;
  const int tid = otid();
#pragma unroll
  for (int i = 0; i < 4; ++i) {
    const int r = (tid >> 4) + 16 * i, c4 = (tid & 15) * 4, n = n0 + c4;
    float4 v = make_float4(0.f, 0.f, 0.f, 0.f);
    if (n < jb.N) v = *(const float4*)(jb.src + (size_t)(k0 + r) * jb.N + n);
    sT[r * 65 + c4 + 0] = v.x; sT[r * 65 + c4 + 1] = v.y; sT[r * 65 + c4 + 2] = v.z; sT[r * 65 + c4 + 3] = v.w;
  }
  __syncthreads();
#pragma unroll
  for (int i = 0; i < 2; ++i) {
    const int id = tid + i * 256, nl = id >> 3, ch = id & 7;
    const int n = n0 + nl;
    int drow = n;
    if (jb.mode == 1) drow = (n >> 5) * 64 + (n & 31);
    else if (jb.mode == 2) drow = (n >> 5) * 64 + 32 + (n & 31);
    uint4 w;
    w.x = pk2(sT[(ch * 8 + 0) * 65 + nl], sT[(ch * 8 + 1) * 65 + nl]);
    w.y = pk2(sT[(ch * 8 + 2) * 65 + nl], sT[(ch * 8 + 3) * 65 + nl]);
    w.z = pk2(sT[(ch * 8 + 4) * 65 + nl], sT[(ch * 8 + 5) * 65 + nl]);
    w.w = pk2(sT[(ch * 8 + 6) * 65 + nl], sT[(ch * 8 + 7) * 65 + nl]);
    if (n < jb.Npad) *(uint4*)(jb.dst + (size_t)drow * jb.K + k0 + ch * 8) = w;
  }
  __syncthreads();
}

__device__ __forceinline__ void mod_item(const Params& p, int item, char* smem) {
  float* sv = (float*)smem;
  float4* red = (float4*)(smem + 20480);
  const int l = item / 36, cgp = item % 36, tid = otid();
  for (int idx = tid; idx < 5120; idx += 256) {
    const int n = idx >> 10, k = idx & 1023;
    const float v = (n == 0) ? p.c_ctx[k] : p.c[(n - 1) * 1024 + k];
    sv[idx] = v * sigmoidf_(v);
  }
  __syncthreads();
  const int kq = tid >> 6, cl = tid & 63, col = cgp * 256 + cl * 4;
  const float* W = p.ada_w + (size_t)l * 1024 * 9216 + col;
  float4 acc[5];
#pragma unroll
  for (int n = 0; n < 5; ++n) acc[n] = make_float4(0.f, 0.f, 0.f, 0.f);
  for (int kb = 0; kb < 256; kb += 8) {
    float4 w[8];
#pragma unroll
    for (int u = 0; u < 8; ++u) w[u] = *(const float4*)(W + (size_t)(kq * 256 + kb + u) * 9216);
#pragma unroll
    for (int u = 0; u < 8; ++u) {
#pragma unroll
      for (int n = 0; n < 5; ++n) {
        const float s = sv[n * 1024 + kq * 256 + kb + u];
        acc[n].x += s * w[u].x; acc[n].y += s * w[u].y; acc[n].z += s * w[u].z; acc[n].w += s * w[u].w;
      }
    }
  }
#pragma unroll
  for (int n = 0; n < 5; ++n) red[(kq * 5 + n) * 64 + cl] = acc[n];
  __syncthreads();
  for (int idx = tid; idx < 320; idx += 256) {
    const int n = idx >> 6, c2 = idx & 63;
    float4 s = red[(0 * 5 + n) * 64 + c2];
#pragma unroll
    for (int q = 1; q < 4; ++q) {
      const float4 t = red[(q * 5 + n) * 64 + c2];
      s.x += t.x; s.y += t.y; s.z += t.z; s.w += t.w;
    }
    const int cc = cgp * 256 + c2 * 4;
    const float4 b = *(const float4*)(p.ada_b + (size_t)l * 9216 + cc);
    s.x += b.x; s.y += b.y; s.z += b.z; s.w += b.w;
    *(float4*)(p.MOD + (size_t)(l * 5 + n) * 9216 + cc) = s;
  }
  __syncthreads();
}

__device__ __forceinline__ void modulate_input_phase(const Params& p) {
  const int tid_ = otid(); const int lane = tid_ & 63, w = tid_ >> 6;
  for (int row = obid() * 4 + w; row < NT; row += gridDim.x * 4) {
    const float* xr = row < NPR ? p.x_prompt + (size_t)row * DM : p.x_sample + (size_t)(row - NPR) * DM;
    const int mi = mod_index(row);
    const float* sh = modp(p, 0, mi, 0);
    const float* sc = modp(p, 0, mi, 1);
#pragma unroll
    for (int i = 0; i < 4; ++i) {
      const int c = lane * 4 + 256 * i;
      const float4 x = *(const float4*)(xr + c);
      const float4 s = *(const float4*)(sc + c);
      const float4 h = *(const float4*)(sh + c);
      uint2 o;
      o.x = pk2(x.x * (1.f + s.x) + h.x, x.y * (1.f + s.y) + h.y);
      o.y = pk2(x.z * (1.f + s.z) + h.z, x.w * (1.f + s.w) + h.w);
      *(uint2*)(p.Hb + (size_t)row * DM + c) = o;
    }
  }
}

__device__ __forceinline__ void ln_phase(const Params& p, const float* g, const float* b, bool write_h, int nl, int nj) {
  const int tid_ = otid(); const int lane = tid_ & 63, w = tid_ >> 6;
  float* X = p.out;
  float4 gg[4], bb[4];
#pragma unroll
  for (int i = 0; i < 4; ++i) { gg[i] = *(const float4*)(g + lane * 4 + 256 * i); bb[i] = *(const float4*)(b + lane * 4 + 256 * i); }
  for (int row0 = (obid() * 4 + w) * 2; row0 < NT; row0 += gridDim.x * 8) {
    float4 v[2][4], s4[4], h4[4];
#pragma unroll
    for (int r = 0; r < 2; ++r)
#pragma unroll
      for (int i = 0; i < 4; ++i) v[r][i] = *(const float4*)(p.Z + (size_t)(row0 + r) * DM + lane * 4 + 256 * i);
    const int mi = mod_index(row0);
    const float* sh = modp(p, nl, mi, 3 * nj);
    const float* sc = modp(p, nl, mi, 3 * nj + 1);
    if (write_h) {
#pragma unroll
      for (int i = 0; i < 4; ++i) { s4[i] = *(const float4*)(sc + lane * 4 + 256 * i); h4[i] = *(const float4*)(sh + lane * 4 + 256 * i); }
    }
    float s0 = 0.f, s1 = 0.f;
#pragma unroll
    for (int i = 0; i < 4; ++i) {
      s0 += (v[0][i].x + v[0][i].y) + (v[0][i].z + v[0][i].w);
      s1 += (v[1][i].x + v[1][i].y) + (v[1][i].z + v[1][i].w);
    }
#pragma unroll
    for (int o = 32; o > 0; o >>= 1) { s0 += __shfl_xor(s0, o); s1 += __shfl_xor(s1, o); }
    const float mu0 = s0 * (1.f / 1024.f), mu1 = s1 * (1.f / 1024.f);
    float q0 = 0.f, q1 = 0.f;
#pragma unroll
    for (int i = 0; i < 4; ++i) {
      v[0][i].x -= mu0; v[0][i].y -= mu0; v[0][i].z -= mu0; v[0][i].w -= mu0;
      v[1][i].x -= mu1; v[1][i].y -= mu1; v[1][i].z -= mu1; v[1][i].w -= mu1;
      q0 += (v[0][i].x * v[0][i].x + v[0][i].y * v[0][i].y) + (v[0][i].z * v[0][i].z + v[0][i].w * v[0][i].w);
      q1 += (v[1][i].x * v[1][i].x + v[1][i].y * v[1][i].y) + (v[1][i].z * v[1][i].z + v[1][i].w * v[1][i].w);
    }
#pragma unroll
    for (int o = 32; o > 0; o >>= 1) { q0 += __shfl_xor(q0, o); q1 += __shfl_xor(q1, o); }
    const float rs[2] = {rsqrtf(q0 * (1.f / 1024.f) + 1e-5f), rsqrtf(q1 * (1.f / 1024.f) + 1e-5f)};
#pragma unroll
    for (int r = 0; r < 2; ++r)
#pragma unroll
      for (int i = 0; i < 4; ++i) {
        const int c = lane * 4 + 256 * i;
        float4 y;
        y.x = v[r][i].x * rs[r] * gg[i].x + bb[i].x; y.y = v[r][i].y * rs[r] * gg[i].y + bb[i].y;
        y.z = v[r][i].z * rs[r] * gg[i].z + bb[i].z; y.w = v[r][i].w * rs[r] * gg[i].w + bb[i].w;
        *(float4*)(X + (size_t)(row0 + r) * DM + c) = y;
        if (write_h) {
          uint2 o;
          o.x = pk2(y.x * (1.f + s4[i].x) + h4[i].x, y.y * (1.f + s4[i].y) + h4[i].y);
          o.y = pk2(y.z * (1.f + s4[i].z) + h4[i].z, y.w * (1.f + s4[i].w) + h4[i].w);
          *(uint2*)(p.Hb + (size_t)(row0 + r) * DM + c) = o;
        }
      }
  }
}

__device__ __forceinline__ void stage_acc(const f32x16 (&acc)[2][2], float* sA, int wr, int wc, int lane) {
#pragma unroll
  for (int mi = 0; mi < 2; ++mi)
#pragma unroll
    for (int ni = 0; ni < 2; ++ni)
#pragma unroll
      for (int r = 0; r < 16; ++r) {
        const int row = wr * 64 + mi * 32 + (r & 3) + 8 * (r >> 2) + 4 * (lane >> 5), col = wc * 64 + ni * 32 + (lane & 31);
        sA[row * 132 + col] = acc[mi][ni][r];
      }
}
struct EpiSwiglu {
  bf16_t* G;
  __device__ __forceinline__ void operator()(const f32x16 (&acc)[2][2], char* smem, int row0, int col0, int wr, int wc, int lane, int tid) const {
    float* sA = (float*)smem;
#pragma unroll
    for (int mi = 0; mi < 2; ++mi)
#pragma unroll
      for (int r = 0; r < 16; ++r) {
        const int row = wr * 64 + mi * 32 + (r & 3) + 8 * (r >> 2) + 4 * (lane >> 5);
        const float a = acc[mi][0][r], bb = acc[mi][1][r];
        sA[row * 68 + wc * 32 + (lane & 31)] = a * sigmoidf_(a) * bb;
      }
    __syncthreads();
    const int n0 = (col0 >> 7) * 64;
#pragma unroll
    for (int i = 0; i < 4; ++i) {
      const int idx = tid + i * 256, row = idx >> 3, c8 = (idx & 7) * 8;
      const float4 v0 = *(const float4*)(sA + row * 68 + c8), v1 = *(const float4*)(sA + row * 68 + c8 + 4);
      uint4 o; o.x = pk2(v0.x, v0.y); o.y = pk2(v0.z, v0.w); o.z = pk2(v1.x, v1.y); o.w = pk2(v1.z, v1.w);
      *(uint4*)(G + (size_t)(row0 + row) * DFF + n0 + c8) = o;
    }
    __syncthreads();
  }
};
template <int NI>
struct EpiResid {
  float* Z; const float* r0; const float* r1; const float* gate_base; float gs;
  __device__ __forceinline__ void operator()(const f32x16 (&acc)[2][NI], char* smem, int row0, int col0, int wr, int wc, int lane, int tid) const {
    float* sA = (float*)smem;
    stage_acc(acc, sA, wr, wc, lane);
    __syncthreads();
    const float* gate = gate_base + (size_t)mod_index(row0) * 9 * DM;
    const float* rbase = (row0 < NPR) ? r0 : r1 - (size_t)NPR * DM;
    const int c4 = (tid & 31) * 4;
    float4 gv = *(const float4*)(gate + col0 + c4);
    gv.x *= gs; gv.y *= gs; gv.z *= gs; gv.w *= gs;
#pragma unroll
    for (int i = 0; i < 16; ++i) {
      const int row = (tid >> 5) + i * 8;
      const float4 a = *(const float4*)(sA + row * 132 + c4);
      const size_t o = (size_t)(row0 + row) * DM + col0 + c4;
      const float4 x = *(const float4*)(rbase + o);
      float4 z;
      z.x = ALPHA_F * x.x + gv.x * a.x; z.y = ALPHA_F * x.y + gv.y * a.y; z.z = ALPHA_F * x.z + gv.z * a.z; z.w = ALPHA_F * x.w + gv.w * a.w;
      *(float4*)(Z + o) = z;
    }
    __syncthreads();
  }
};
struct EpiStoreBf16 {
  bf16_t* P; int ld;
  __device__ __forceinline__ void operator()(const f32x16 (&acc)[2][2], char* smem, int row0, int col0, int wr, int wc, int lane, int tid) const {
    float* sA = (float*)smem;
    stage_acc(acc, sA, wr, wc, lane);
    __syncthreads();
#pragma unroll
    for (int i = 0; i < 8; ++i) {
      const int idx = tid + i * 256, row = idx >> 4, c8 = (idx & 15) * 8;
      const float4 v0 = *(const float4*)(sA + row * 132 + c8), v1 = *(const float4*)(sA + row * 132 + c8 + 4);
      uint4 o; o.x = pk2(v0.x, v0.y); o.y = pk2(v0.z, v0.w); o.z = pk2(v1.x, v1.y); o.w = pk2(v1.z, v1.w);
      *(uint4*)(P + (size_t)(row0 + row) * ld + col0 + c8) = o;
    }
    __syncthreads();
  }
};

#define LAS __attribute__((address_space(3)))
template <int NI, class Epi>
__device__ __forceinline__ void gemm_tile(const bf16_t* __restrict__ A, int lda, const bf16_t* __restrict__ Bt, int ldb,
                                          int K, int row0, int col0, const Epi& epi, char* smem) {
  static_assert(NI == 2, "LDS-DMA tile is 128 x 128");
  constexpr int STAGE_B = 32768;
  const int tid = otid(), lane = tid & 63, w = tid >> 6, wr = w >> 1, wc = w & 1, h = lane >> 5;
  LAS char* lds = (LAS char*)smem;
  const int lrow = lane >> 3;
  const int c0 = (lane & 7) ^ (lane >> 4), c1 = (lane & 7) ^ (4 + (lane >> 4));
  const bf16_t* Ag[4];
  const bf16_t* Bg[4];
#pragma unroll
  for (int i = 0; i < 4; ++i) {
    const int row = (w * 4 + i) * 8 + lrow, c = (i & 1) ? c1 : c0;
    Ag[i] = A + (size_t)(row0 + row) * lda + c * 8;
    Bg[i] = Bt + (size_t)(col0 + row) * ldb + c * 8;
  }
#define GEMM_STAGE(buf_, k0_)                                                                                              \
  {                                                                                                                        \
    _Pragma("unroll") for (int i = 0; i < 4; ++i) {                                                                        \
      __builtin_amdgcn_global_load_lds((const __attribute__((address_space(1))) unsigned*)(Ag[i] + (k0_)),                 \
                                       (LAS unsigned*)(lds + (buf_) * STAGE_B + (w * 4 + i) * 1024), 16, 0, 0);            \
      __builtin_amdgcn_global_load_lds((const __attribute__((address_space(1))) unsigned*)(Bg[i] + (k0_)),                 \
                                       (LAS unsigned*)(lds + (buf_) * STAGE_B + 16384 + (w * 4 + i) * 1024), 16, 0, 0);    \
    }                                                                                                                      \
  }
  f32x16 acc[2][NI];
#pragma unroll
  for (int mi = 0; mi < 2; ++mi)
#pragma unroll
    for (int ni = 0; ni < NI; ++ni)
#pragma unroll
      for (int r = 0; r < 16; ++r) acc[mi][ni][r] = 0.f;
  const int nk = K >> 6;
  GEMM_STAGE(0, 0);
  __syncthreads();
  const int sw = ((lane & 31) >> 1) & 7;
  const int aoff = (wr * 64 + (lane & 31)) * 128;
  const int boff = 16384 + (wc * 64 + (lane & 31)) * 128;
  for (int kt = 0; kt < nk; ++kt) {
    const int cur = kt & 1;
    if (kt + 1 < nk) GEMM_STAGE(cur ^ 1, (kt + 1) * 64);
    LAS const char* sc = lds + cur * STAGE_B;
#pragma unroll
    for (int kk = 0; kk < 4; ++kk) {
      const int co = ((kk * 2 + h) ^ sw) * 16;
      s16x8 af[2], bfr[NI];
#pragma unroll
      for (int mi = 0; mi < 2; ++mi) af[mi] = *(LAS const s16x8*)(sc + aoff + mi * 4096 + co);
#pragma unroll
      for (int ni = 0; ni < NI; ++ni) bfr[ni] = *(LAS const s16x8*)(sc + boff + ni * 4096 + co);
#pragma unroll
      for (int mi = 0; mi < 2; ++mi)
#pragma unroll
        for (int ni = 0; ni < NI; ++ni)
          acc[mi][ni] = __builtin_amdgcn_mfma_f32_32x32x16_bf16(af[mi], bfr[ni], acc[mi][ni], 0, 0, 0);
    }
    __syncthreads();
  }
#undef GEMM_STAGE
  epi(acc, smem, row0, col0, wr, wc, lane, tid);
}

template <int NI, class Epi>
__device__ __forceinline__ void gemm_phase(const bf16_t* A, int lda, const bf16_t* Bt, int ldb, int N, int K, const Epi& epi, char* smem) {
  constexpr int BN = NI * 64;
  const int nMt = NT / 128, nNt = N / BN, T = nMt * nNt;
  for (int t = obid(); t < T; t += gridDim.x) {
    const int s = (t & 7) * (T >> 3) + (t >> 3);
    const int grp = s / (8 * nNt), r = s % (8 * nNt);
    const int mt = grp * 8 + (r & 7), nt = r >> 3;
    gemm_tile<NI, Epi>(A, lda, Bt, ldb, K, mt * 128, nt * BN, epi, smem);
  }
}

__device__ __forceinline__ void prep_vectors(const Params& p, int odd) {
  const int tid_ = otid(); const int lane = tid_ & 63, w = tid_ >> 6;
  const bf16_t* P = p.R1;
  const int ldp = odd ? LDPO : LDPE;
  const int qcol = odd ? 2560 : 0, kcol = odd ? 3072 : 512;
  float* outk = p.out + (size_t)NT * DM + (odd ? (size_t)(524288 * 2 + 2097152 + 16384 + 128 + 2097152) : 0);
  const float qn = odd ? p.d_q_norm[lane] : 1.f, kn = odd ? p.d_k_norm[lane] : 1.f;
  const int i16 = lane & 15;
  const float inv = exp2f(-(float)i16 * (13.287712379549449f / 16.f));
  for (int row = obid() * 4 + w; row < NT; row += gridDim.x * 4) {
    const bf16_t* pr_ = P + (size_t)row * ldp;
    float v[10];
#pragma unroll
    for (int hv = 0; hv < 8; ++hv) v[hv] = bf2f(pr_[qcol + hv * 64 + lane]);
#pragma unroll
    for (int hv = 0; hv < 2; ++hv) v[8 + hv] = bf2f(pr_[kcol + hv * 64 + lane]);
    if (odd) {
#pragma unroll
      for (int hv = 0; hv < 10; ++hv) {
        const float ms = wave_sum(v[hv] * v[hv]) * (1.f / 64.f);
        v[hv] = v[hv] * rsqrtf(ms + 1e-6f) * (hv < 8 ? qn : kn);
      }
    }
    if (row < NPR) {
      outk[(size_t)row * 128 + lane] = v[8];
      outk[(size_t)row * 128 + 64 + lane] = v[9];
    } else {
      const int t = (row - NPR) & 2047;
      const float pos = (lane < 32) ? (float)(t >> 6) : (float)(t & 63);
      const float ang = pos * inv;
      const float cs = __cosf(ang), sn = __sinf(ang);
#pragma unroll
      for (int hv = 0; hv < 10; ++hv) {
        const float pr = __shfl_xor(v[hv], 16);
        v[hv] = ((lane & 16) == 0) ? (v[hv] * cs - pr * sn) : (pr * sn + v[hv] * cs);
      }
    }
#pragma unroll
    for (int hv = 0; hv < 8; ++hv) p.Qb[(size_t)row * 512 + hv * 64 + lane] = f2bf(v[hv] * (0.125f * LOG2E));
#pragma unroll
    for (int hv = 0; hv < 2; ++hv) p.Kb[(size_t)row * 128 + hv * 64 + lane] = f2bf(v[8 + hv]);
  }
}

__device__ __forceinline__ void prep_v(const Params& p, int odd, char* smem) {
  bf16_t* sT = (bf16_t*)smem;
  const bf16_t* P = p.R1;
  const int ldp = odd ? LDPO : LDPE;
  const int vcol = odd ? 3200 : 640;
  const float* cv = odd ? p.cache_d_v : p.cache_a_v;
  const float* ck = odd ? p.cache_d_k : p.cache_a_k;
  float* outv = p.out + (size_t)NT * DM + (odd ? (size_t)(524288 * 2 + 2097152 + 16384 + 128 + 2097152 + 524288) : (size_t)524288);
  const int tid = otid();
  const int nitems = 192 * 2 + 64 + 64;
  for (int it = obid(); it < nitems; it += gridDim.x) {
    if (it < 448) {
      bf16_t* dst; int dstride;
      if (it < 384) {
        const int tb = it >> 1, kv = it & 1, row0 = tb * 64;
#pragma unroll
        for (int i = 0; i < 16; ++i) {
          const int r = (tid >> 6) + 4 * i, d = tid & 63;
          const bf16_t raw = P[(size_t)(row0 + r) * ldp + vcol + kv * 64 + d];
          sT[d * 72 + r] = raw;
          if (row0 < NPR) outv[(size_t)(row0 + r) * 128 + kv * 64 + d] = bf2f(raw);
        }
        if (row0 < NPR) { const int b = row0 >> 8, pos0 = row0 & 255; dst = p.Vt + (size_t)((b * 2 + kv) * 64) * 256 + pos0; dstride = 256; }
        else { const int rr = row0 - NPR, b = rr >> 11, pos0 = rr & 2047; dst = p.Vt + 524288 + (size_t)((b * 2 + kv) * 64) * 2048 + pos0; dstride = 2048; }
      } else {
        const int j = it - 384, b = j >> 4, kv = (j >> 3) & 1, kb = j & 7;
#pragma unroll
        for (int i = 0; i < 16; ++i) {
          const int r = (tid >> 6) + 4 * i, d = tid & 63;
          sT[d * 72 + r] = f2bf(cv[((size_t)(b * 512 + kb * 64 + r) * 2 + kv) * 64 + d]);
        }
        dst = p.Vct + (size_t)((b * 2 + kv) * 64) * 512 + kb * 64; dstride = 512;
      }
      __syncthreads();
#pragma unroll
      for (int i = 0; i < 2; ++i) {
        const int id = tid + i * 256, d = id >> 3, ch = id & 7;
        *(uint4*)(dst + (size_t)d * dstride + ch * 8) = *(const uint4*)(sT + d * 72 + ch * 8);
      }
      __syncthreads();
    } else {
      const int j = it - 448;
#pragma unroll
      for (int i = 0; i < 16; ++i) {
        const int idx = j * 4096 + i * 256 + tid;
        p.Kc[idx] = f2bf(ck[idx]);
      }
    }
  }
}

__device__ __forceinline__ void attn_item(const Params& p, int odd, int item, char* smem) {
  bf16_t* Ks = (bf16_t*)smem;
  bf16_t* Vs = Ks + 64 * 72;
  const int tid = otid(), lane = tid & 63, g = tid >> 6, ql = lane & 31, h = lane >> 5;
  int b, kv, qb, L, seq_row0; bool sample;
  if (item < 512) { sample = true; b = item >> 7; kv = (item >> 6) & 1; qb = item & 63; L = 2048; seq_row0 = NPR + b * 2048; }
  else { const int it = item - 512; sample = false; b = it >> 4; kv = (it >> 3) & 1; qb = it & 7; L = 256; seq_row0 = b * 256; }
  const int t0 = qb * 32, q_row0 = seq_row0 + t0;
  const bf16_t* vbase = sample ? p.Vt + 524288 + (size_t)((b * 2 + kv) * 64) * 2048 : p.Vt + (size_t)((b * 2 + kv) * 64) * 256;
  const bf16_t* kbase = p.Kb + (size_t)seq_row0 * 128 + kv * 64;
  const bf16_t* kcb = p.Kc + (size_t)b * 512 * 128 + kv * 64;
  const bf16_t* vcb = p.Vct + (size_t)((b * 2 + kv) * 64) * 512;
  const bool band = sample && !odd;
  int lo = 0, hi = L >> 6;
  if (band) { lo = (t0 - 128) < 0 ? 0 : ((t0 - 128) >> 6); hi = (t0 + 160 + 63) >> 6; if (hi > 32) hi = 32; }
  const int nloc = hi - lo, ntiles = nloc + (sample ? 8 : 0);
  const int hq = kv * 4 + g;
  s16x8 qf[4];
#pragma unroll
  for (int kk = 0; kk < 4; ++kk) qf[kk] = *(const s16x8*)(p.Qb + (size_t)(q_row0 + ql) * 512 + hq * 64 + kk * 16 + h * 8);
  float m = -1e30f, lsum = 0.f;
  if (!odd) { m = p.a_sink[kv * 4 + g] * LOG2E; lsum = (h == 0) ? 1.f : 0.f; }
  f32x16 o0, o1;
#pragma unroll
  for (int r = 0; r < 16; ++r) { o0[r] = 0.f; o1[r] = 0.f; }
  u32x4 kr0, kr1, vr0, vr1;
  const int lr = tid >> 3, lch = tid & 7;
#define ATT_GL(ti_)                                                                                   \
  {                                                                                                   \
    const int ti__ = (ti_);                                                                           \
    const bf16_t* kp_; const bf16_t* vp_; size_t vst_;                                                \
    if (ti__ < nloc) { const int kt_ = lo + ti__; kp_ = kbase + (size_t)(kt_ * 64 + lr) * 128 + lch * 8; vp_ = vbase + (size_t)lr * L + kt_ * 64 + lch * 8; vst_ = (size_t)L; } \
    else { const int c_ = ti__ - nloc; kp_ = kcb + (size_t)(c_ * 64 + lr) * 128 + lch * 8; vp_ = vcb + (size_t)lr * 512 + c_ * 64 + lch * 8; vst_ = 512; } \
    kr0 = gload16(kp_); kr1 = gload16(kp_ + 32 * 128);                                                \
    vr0 = gload16(vp_); vr1 = gload16(vp_ + 32 * vst_);                                               \
  }
  ATT_GL(0);
  for (int ti = 0; ti < ntiles; ++ti) {
    vm_wait4(kr0, kr1, vr0, vr1);
    *(u32x4*)(Ks + lr * 72 + lch * 8) = kr0;
    *(u32x4*)(Ks + (lr + 32) * 72 + lch * 8) = kr1;
    *(u32x4*)(Vs + lr * 72 + lch * 8) = vr0;
    *(u32x4*)(Vs + (lr + 32) * 72 + lch * 8) = vr1;
    __syncthreads();
    if (ti + 1 < ntiles) ATT_GL(ti + 1);
    __builtin_amdgcn_sched_barrier(0);
    f32x16 s0, s1;
#pragma unroll
    for (int r = 0; r < 16; ++r) { s0[r] = 0.f; s1[r] = 0.f; }
#pragma unroll
    for (int kk = 0; kk < 4; ++kk) {
      const s16x8 a0 = *(const s16x8*)(Ks + ql * 72 + kk * 16 + h * 8);
      const s16x8 a1 = *(const s16x8*)(Ks + (32 + ql) * 72 + kk * 16 + h * 8);
      s0 = __builtin_amdgcn_mfma_f32_32x32x16_bf16(a0, qf[kk], s0, 0, 0, 0);
      s1 = __builtin_amdgcn_mfma_f32_32x32x16_bf16(a1, qf[kk], s1, 0, 0, 0);
    }
    if (band && ti < nloc) {
      const int kbase_pos = (lo + ti) * 64 + 4 * h - (t0 + ql);
#pragma unroll
      for (int r = 0; r < 16; ++r) {
        const int dlt = kbase_pos + (r & 3) + 8 * (r >> 2);
        if (dlt > 128 || dlt < -128) s0[r] = -1e30f;
        const int dl2 = dlt + 32;
        if (dl2 > 128 || dl2 < -128) s1[r] = -1e30f;
      }
    }
    float mx = -1e30f;
#pragma unroll
    for (int r = 0; r < 16; ++r) mx = fmaxf(mx, fmaxf(s0[r], s1[r]));
    mx = fmaxf(mx, __shfl_xor(mx, 32));
    const float mnew = fmaxf(m, mx);
    const float alpha = __builtin_amdgcn_exp2f(m - mnew);
    m = mnew;
    float ps = 0.f;
#pragma unroll
    for (int r = 0; r < 16; ++r) {
      s0[r] = __builtin_amdgcn_exp2f(s0[r] - mnew);
      s1[r] = __builtin_amdgcn_exp2f(s1[r] - mnew);
      ps += s0[r] + s1[r];
    }
    lsum = lsum * alpha + ps;
#pragma unroll
    for (int r = 0; r < 16; ++r) { o0[r] *= alpha; o1[r] *= alpha; }
#pragma unroll
    for (int ks = 0; ks < 4; ++ks) {
      const int kbk = ks >> 1, sp = ks & 1;
      s16x8 pf;
#pragma unroll
      for (int j = 0; j < 8; ++j) pf[j] = (short)f2bf(kbk == 0 ? s0[8 * sp + j] : s1[8 * sp + j]);
      const int keyoff = kbk * 32 + 16 * sp + 4 * h;
#pragma unroll
      for (int db = 0; db < 2; ++db) {
        const bf16_t* vp = Vs + (db * 32 + ql) * 72 + keyoff;
        const s16x4 lo4 = *(const s16x4*)(vp);
        const s16x4 hi4 = *(const s16x4*)(vp + 8);
        s16x8 vf;
        vf[0] = lo4[0]; vf[1] = lo4[1]; vf[2] = lo4[2]; vf[3] = lo4[3];
        vf[4] = hi4[0]; vf[5] = hi4[1]; vf[6] = hi4[2]; vf[7] = hi4[3];
        if (db == 0) o0 = __builtin_amdgcn_mfma_f32_32x32x16_bf16(vf, pf, o0, 0, 0, 0);
        else o1 = __builtin_amdgcn_mfma_f32_32x32x16_bf16(vf, pf, o1, 0, 0, 0);
      }
    }
    __syncthreads();
  }
  const float ltot = lsum + __shfl_xor(lsum, 32);
  const float inv = 1.f / ltot;
  bf16_t* cat = p.Hb + (size_t)(q_row0 + ql) * DM + (odd ? 512 : 0) + hq * 64;
#pragma unroll
  for (int rg = 0; rg < 4; ++rg) {
    uint2 w0, w1;
    w0.x = pk2(o0[rg * 4 + 0] * inv, o0[rg * 4 + 1] * inv); w0.y = pk2(o0[rg * 4 + 2] * inv, o0[rg * 4 + 3] * inv);
    w1.x = pk2(o1[rg * 4 + 0] * inv, o1[rg * 4 + 1] * inv); w1.y = pk2(o1[rg * 4 + 2] * inv, o1[rg * 4 + 3] * inv);
    *(uint2*)(cat + 8 * rg + 4 * h) = w0;
    *(uint2*)(cat + 32 + 8 * rg + 4 * h) = w1;
  }
}

__device__ __forceinline__ void mlstm_item(const Params& p, int item, char* smem) {
  bf16_t* sQ = (bf16_t*)smem;
  bf16_t* sK = sQ + 64 * 136;
  bf16_t* sKt = sK + 64 * 136;
  bf16_t* sVt = sKt + 128 * 72;
  bf16_t* sW = sVt + 32 * 72;
  bf16_t* sCt = sW + 64 * 72;
  float* sU = (float*)(sCt + 32 * 136);
  float* sM = sU + 64;
  float* sA = sM + 64;
  float* sWs = sA + 64;
  float* sCl = sWs + 64;
  float* sMisc = sCl + 64;
  const bf16_t* P = p.R1;
  const int ldp = LDPE;
  const float kscale = 0.08838834764831845f;
  const int tid = otid(), lane = tid & 63, w = tid >> 6, l15 = lane & 15, kg = lane >> 4;
  bool sample; int b, head, dir, slice, L, seq_row0;
  if (item < 160) { sample = true; const int s5 = item / 5; slice = item % 5; b = s5 >> 3; head = (s5 >> 1) & 3; dir = s5 & 1; L = 2048; seq_row0 = NPR + b * 2048; }
  else { const int it = item - 160; sample = false; const int s5 = it / 5; slice = it % 5; b = s5 >> 3; head = (s5 >> 1) & 3; dir = s5 & 1; L = 256; seq_row0 = b * 256; }
  const bool nsl = (slice == 4);
  const int nch = L >> 6;
  float m = 0.f;
  f32x4 cacc[2][2];
#pragma unroll
  for (int rb = 0; rb < 2; ++rb)
#pragma unroll
    for (int nb = 0; nb < 2; ++nb)
#pragma unroll
      for (int r = 0; r < 4; ++r) cacc[rb][nb][r] = 0.f;
  if (sample) {
    const size_t sidx = (size_t)((b * 2 + dir) * 4 + head);
    m = p.state_b_m[sidx];
#pragma unroll
    for (int rb = 0; rb < 2; ++rb)
#pragma unroll
      for (int nb = 0; nb < 2; ++nb)
#pragma unroll
        for (int r = 0; r < 4; ++r) {
          const int d = 32 * w + rb * 16 + 4 * kg + r, e = nb * 16 + l15;
          float v;
          if (!nsl) v = p.state_b_C[(sidx * 128 + d) * 128 + slice * 32 + e];
          else v = (e == 0) ? p.state_b_n[sidx * 128 + d] : 0.f;
          cacc[rb][nb][r] = v;
        }
  }
#pragma unroll
  for (int rb = 0; rb < 2; ++rb)
#pragma unroll
    for (int nb = 0; nb < 2; ++nb) {
      uint2 o; o.x = pk2(cacc[rb][nb][0], cacc[rb][nb][1]); o.y = pk2(cacc[rb][nb][2], cacc[rb][nb][3]);
      *(uint2*)(sCt + (nb * 16 + l15) * 136 + 32 * w + rb * 16 + 4 * kg) = o;
    }
  const float bias_i = p.b_gate_bias[(2 * dir) * 4 + head], bias_f = p.b_gate_bias[(2 * dir + 1) * 4 + head];
  float* NUM = p.Z + (size_t)dir * NT * 512;
  u32x4 pq[4], pk[4], pv;
  unsigned pgi, pgf;
#define ML_ISSUE(cc_)                                                                                         \
  {                                                                                                           \
    const int c__ = (cc_);                                                                                    \
    {                                                                                                         \
      const int pos_ = dir ? (L - 1 - (c__ * 64 + lane)) : (c__ * 64 + lane);                                 \
      const bf16_t* gp_ = P + (size_t)(seq_row0 + pos_) * ldp + 2304;                                         \
      pgi = gload2(gp_ + (2 * dir) * 4 + head);                                                               \
      pgf = gload2(gp_ + (2 * dir + 1) * 4 + head);                                                           \
    }                                                                                                         \
    _Pragma("unroll") for (int i = 0; i < 4; ++i) {                                                           \
      const int r_ = tid & 63, ch_ = (tid >> 6) + 4 * i;                                                      \
      const int pos_ = dir ? (L - 1 - (c__ * 64 + r_)) : (c__ * 64 + r_);                                     \
      const bf16_t* rp_ = P + (size_t)(seq_row0 + pos_) * ldp + head * 128 + ch_ * 8;                         \
      pq[i] = gload16(rp_ + 768);                                                                             \
      pk[i] = gload16(rp_ + 1280);                                                                            \
    }                                                                                                         \
    if (!nsl) {                                                                                               \
      const int r_ = tid & 63, ch_ = tid >> 6;                                                                \
      const int pos_ = dir ? (L - 1 - (c__ * 64 + r_)) : (c__ * 64 + r_);                                     \
      pv = gload16(P + (size_t)(seq_row0 + pos_) * ldp + 1792 + head * 128 + slice * 32 + ch_ * 8);          \
    }                                                                                                         \
  }
  pv = (u32x4){0u, 0u, 0u, 0u};
  ML_ISSUE(0);
  for (int c = 0; c < nch; ++c) {
    asm volatile("s_waitcnt vmcnt(0)" : "+v"(pgi), "+v"(pgf), "+v"(pq[0]), "+v"(pq[1]), "+v"(pq[2]), "+v"(pq[3]), "+v"(pk[0]), "+v"(pk[1]), "+v"(pk[2]), "+v"(pk[3]), "+v"(pv) : : "memory");
    {
      const float ig = bf2f((bf16_t)pgi) + bias_i;
      const float fr = bf2f((bf16_t)pgf) + bias_f;
      const float lf = fminf(fr, 0.f) - __logf(1.f + __expf(-fabsf(fr)));
      float bc = lf;
#pragma unroll
      for (int o = 1; o < 64; o <<= 1) { const float y = __shfl_up(bc, o); if (lane >= o) bc += y; }
      const float u = ig - bc;
      float pm = u;
#pragma unroll
      for (int o = 1; o < 64; o <<= 1) { const float y = __shfl_up(pm, o); if (lane >= o) pm = fmaxf(pm, y); }
      const float M = fmaxf(m, pm);
      const float Mlast = __shfl(M, 63), bclast = __shfl(bc, 63);
      if (w == 0) {
        sU[lane] = u; sM[lane] = M; sA[lane] = __expf(m - M);
        sWs[lane] = __expf(u - Mlast) * kscale;
        sCl[lane] = __expf(-(bc + M));
        if (lane == 0) { sMisc[0] = bclast + Mlast; sMisc[1] = __expf(m - Mlast); }
      }
    }
    __syncthreads();
#pragma unroll
    for (int i = 0; i < 4; ++i) {
      const int r = tid & 63, ch = (tid >> 6) + 4 * i;
      *(u32x4*)(sQ + r * 136 + ch * 8) = pq[i];
      *(u32x4*)(sK + r * 136 + ch * 8) = pk[i];
      const float ws = sWs[r];
#pragma unroll
      for (int j = 0; j < 4; ++j) {
        sKt[(ch * 8 + 2 * j) * 72 + r] = f2bf(bf2f((bf16_t)(pk[i][j] & 0xffffu)) * ws);
        sKt[(ch * 8 + 2 * j + 1) * 72 + r] = f2bf(bf2f((bf16_t)(pk[i][j] >> 16)) * ws);
      }
    }
    {
      const int r = tid & 63, ch = tid >> 6;
      if (!nsl) {
#pragma unroll
        for (int j = 0; j < 4; ++j) {
          sVt[(ch * 8 + 2 * j) * 72 + r] = (bf16_t)(pv[j] & 0xffffu);
          sVt[(ch * 8 + 2 * j + 1) * 72 + r] = (bf16_t)(pv[j] >> 16);
        }
      } else {
#pragma unroll
        for (int j = 0; j < 8; ++j) sVt[(ch * 8 + j) * 72 + r] = (ch == 0 && j == 0) ? (bf16_t)0x3F80 : (bf16_t)0;
      }
    }
    __builtin_amdgcn_sched_barrier(0);
    if (c + 1 < nch) ML_ISSUE(c + 1);
    __builtin_amdgcn_sched_barrier(0);
    __syncthreads();
    {
      const int wr = w >> 1, wc = w & 1, h = lane >> 5, l31 = lane & 31;
      f32x16 sacc;
#pragma unroll
      for (int r = 0; r < 16; ++r) sacc[r] = 0.f;
      if (!(wr == 0 && wc == 1)) {
#pragma unroll
        for (int kk = 0; kk < 8; ++kk) {
          const s16x8 a = *(const s16x8*)(sQ + (wr * 32 + l31) * 136 + kk * 16 + h * 8);
          const s16x8 bb = *(const s16x8*)(sK + (wc * 32 + l31) * 136 + kk * 16 + h * 8);
          sacc = __builtin_amdgcn_mfma_f32_32x32x16_bf16(a, bb, sacc, 0, 0, 0);
        }
      }
      const int s = wc * 32 + l31;
      const float us = sU[s];
#pragma unroll
      for (int r = 0; r < 16; ++r) {
        const int t = wr * 32 + (r & 3) + 8 * (r >> 2) + 4 * h;
        const float wv = (s <= t) ? __expf(us - sM[t]) * sacc[r] * kscale : 0.f;
        sW[t * 72 + s] = f2bf(wv);
      }
    }
    __syncthreads();
    {
      f32x4 a1[2], a2[2];
#pragma unroll
      for (int nb = 0; nb < 2; ++nb)
#pragma unroll
        for (int r = 0; r < 4; ++r) { a1[nb][r] = 0.f; a2[nb][r] = 0.f; }
#pragma unroll
      for (int kk = 0; kk < 4; ++kk) {
        const s16x8 a = *(const s16x8*)(sQ + (16 * w + l15) * 136 + kk * 32 + kg * 8);
#pragma unroll
        for (int nb = 0; nb < 2; ++nb) {
          const s16x8 bb = *(const s16x8*)(sCt + (nb * 16 + l15) * 136 + kk * 32 + kg * 8);
          a1[nb] = mfma16_safe(a, bb, a1[nb]);
        }
      }
#pragma unroll
      for (int kk = 0; kk < 2; ++kk) {
        const s16x8 a = *(const s16x8*)(sW + (16 * w + l15) * 72 + kk * 32 + kg * 8);
#pragma unroll
        for (int nb = 0; nb < 2; ++nb) {
          const s16x8 bb = *(const s16x8*)(sVt + (nb * 16 + l15) * 72 + kk * 32 + kg * 8);
          a2[nb] = mfma16_safe(a, bb, a2[nb]);
        }
      }
#pragma unroll
      for (int r = 0; r < 4; ++r) {
        const int t = 16 * w + 4 * kg + r;
        const int pos = dir ? (L - 1 - (c * 64 + t)) : (c * 64 + t);
        const size_t row = (size_t)(seq_row0 + pos);
        const float at = sA[t];
#pragma unroll
        for (int nb = 0; nb < 2; ++nb) {
          const float val = at * a1[nb][r] + a2[nb][r];
          const int e = nb * 16 + l15;
          if (!nsl) NUM[row * 512 + head * 128 + slice * 32 + e] = val;
          else if (e == 0) { p.DEN[((size_t)dir * NT + row) * 4 + head] = val; p.CL[((size_t)dir * NT + row) * 4 + head] = sCl[t]; }
        }
      }
      const float decay = sMisc[1];
#pragma unroll
      for (int rb = 0; rb < 2; ++rb)
#pragma unroll
        for (int nb = 0; nb < 2; ++nb)
#pragma unroll
          for (int r = 0; r < 4; ++r) cacc[rb][nb][r] *= decay;
#pragma unroll
      for (int kk = 0; kk < 2; ++kk)
#pragma unroll
        for (int rb = 0; rb < 2; ++rb) {
          const s16x8 a = *(const s16x8*)(sKt + (32 * w + rb * 16 + l15) * 72 + kk * 32 + kg * 8);
#pragma unroll
          for (int nb = 0; nb < 2; ++nb) {
            const s16x8 bb = *(const s16x8*)(sVt + (nb * 16 + l15) * 72 + kk * 32 + kg * 8);
            cacc[rb][nb] = mfma16_safe(a, bb, cacc[rb][nb]);
          }
        }
      m = sMisc[0];
    }
    __syncthreads();
#pragma unroll
    for (int rb = 0; rb < 2; ++rb)
#pragma unroll
      for (int nb = 0; nb < 2; ++nb) {
        uint2 o; o.x = pk2(cacc[rb][nb][0], cacc[rb][nb][1]); o.y = pk2(cacc[rb][nb][2], cacc[rb][nb][3]);
        *(uint2*)(sCt + (nb * 16 + l15) * 136 + 32 * w + rb * 16 + 4 * kg) = o;
      }
  }
  if (!sample) {
    float* oC = p.out + (size_t)NT * DM + 524288 * 2;
    float* oN = oC + 2097152;
    float* oM = oN + 16384;
    const size_t sidx = (size_t)((b * 2 + dir) * 4 + head);
#pragma unroll
    for (int rb = 0; rb < 2; ++rb)
#pragma unroll
      for (int nb = 0; nb < 2; ++nb)
#pragma unroll
        for (int r = 0; r < 4; ++r) {
          const int d = 32 * w + rb * 16 + 4 * kg + r, e = nb * 16 + l15;
          if (!nsl) oC[(sidx * 128 + d) * 128 + slice * 32 + e] = cacc[rb][nb][r];
          else if (e == 0) oN[sidx * 128 + d] = cacc[rb][nb][r];
        }
    if (nsl && tid == 0) oM[sidx] = m;
  }
  __syncthreads();
}

__device__ __forceinline__ void hgrn_pre(const Params& p, char* smem) {
  float* sTot = (float*)smem;
  const bf16_t* P = p.R1;
  const int ldp = LDPO;
  const int tid = otid(), d = tid & 127, half = tid >> 7;
  for (int it = obid(); it < 3072; it += gridDim.x) {
    const int dir = it / 1536, rem = it % 1536, gc = rem >> 2, head = rem & 3;
    const float lbv = 1.f / (1.f + __expf(p.c_lb_logits[head * 128 + d] - p.c_lb_logits[512 + head * 128 + d]));
    const int fcol = (dir ? 1024 : 512) + head * 128 + d;
    float Al[16], qv[16], kvv[16];
    float run = 0.f;
#pragma unroll
    for (int tt = 0; tt < 16; ++tt) {
      const int t = half * 16 + tt;
      const bf16_t* rp = P + (size_t)(gc * 32 + (dir ? 31 - t : t)) * ldp;
      const float fp = bf2f(rp[fcol]);
      const float cq = bf2f(rp[head * 128 + d]);
      const float f = lbv + (1.f - lbv) * sigmoidf_(fp);
      run += __logf(f);
      Al[tt] = run; kvv[tt] = 1.f - f; qv[tt] = cq * sigmoidf_(cq);
    }
    sTot[half * 128 + d] = run;
    __syncthreads();
    const float tot0 = sTot[d], tot1 = sTot[128 + d];
    const float Atot = tot0 + tot1, off = half ? tot0 : 0.f;
    const size_t base = (size_t)((dir * 384 + gc) * 4 + head) * 4096;
    bf16_t* hk = (dir ? p.HK1 : p.HK0) + (size_t)(gc * 4 + head) * 4096;
    unsigned kt[8];
#pragma unroll
    for (int tt = 0; tt < 16; ++tt) {
      const int t = half * 16 + tt;
      const float A = Al[tt] + off;
      p.HQ[base + t * 128 + d] = f2bf(qv[tt] * __expf(A - tot0));
      const bf16_t kb = f2bf(kvv[tt] * __expf(tot0 - A));
      hk[t * 128 + d] = kb;
      if (tt & 1) kt[tt >> 1] |= ((unsigned)kb << 16); else kt[tt >> 1] = (unsigned)kb;
    }
    {
      u32x4 w0 = {kt[0], kt[1], kt[2], kt[3]}, w1 = {kt[4], kt[5], kt[6], kt[7]};
      *(u32x4*)(p.HKt + base + d * 32 + half * 16) = w0;
      *(u32x4*)(p.HKt + base + d * 32 + half * 16 + 8) = w1;
    }
    if (half == 0) {
      float* ev = p.EV + (size_t)((dir * 384 + gc) * 4 + head) * 384;
      ev[d] = __expf(tot0); ev[128 + d] = __expf(Atot - tot0); ev[256 + d] = __expf(Atot);
    }
    __syncthreads();
  }
}

__device__ __forceinline__ void hgrn_item(const Params& p, int item, char* smem) {
  bf16_t* sQt = (bf16_t*)smem;
  bf16_t* sKt_ = sQt + 32 * 136;
  bf16_t* sK2t = sKt_ + 32 * 136;
  bf16_t* sVt = sK2t + 128 * 40;
  bf16_t* sAtt = sVt + 32 * 40;
  bf16_t* sSt = sAtt + 32 * 40;
  const bf16_t* P = p.R1;
  const int ldp = LDPO;
  const int tid = otid(), lane = tid & 63, w = tid >> 6, l15 = lane & 15, kg = lane >> 4;
  bool sample; int b, head, dir, slice, L, seq_row0;
  if (item < 128) { sample = true; const int s4 = item >> 2; slice = item & 3; b = s4 >> 3; head = (s4 >> 1) & 3; dir = s4 & 1; L = 2048; seq_row0 = NPR + b * 2048; }
  else { const int it = item - 128; sample = false; const int s4 = it >> 2; slice = it & 3; b = s4 >> 3; head = (s4 >> 1) & 3; dir = s4 & 1; L = 256; seq_row0 = b * 256; }
  const int nch = L >> 5, gc0 = seq_row0 >> 5;
  const bf16_t* HKd = dir ? p.HK1 : p.HK0;
  f32x4 sacc[2][2];
#pragma unroll
  for (int rb = 0; rb < 2; ++rb)
#pragma unroll
    for (int nb = 0; nb < 2; ++nb)
#pragma unroll
      for (int r = 0; r < 4; ++r) {
        float v = 0.f;
        if (sample) {
          const int dd = 32 * w + rb * 16 + 4 * kg + r, e = nb * 16 + l15;
          v = p.state_c_S[(((size_t)((b * 2 + dir) * 4 + head)) * 128 + dd) * 128 + slice * 32 + e];
        }
        sacc[rb][nb][r] = v;
      }
  float* O = p.Z + (size_t)dir * NT * 512;
  u32x4 rq[2], rk[2], rkt[2], rv, ev[3][2];
  rv = (u32x4){0u, 0u, 0u, 0u};
#define HG_ISSUE(cc_)                                                                                          \
  {                                                                                                            \
    const int gc_ = gc0 + (dir ? nch - 1 - (cc_) : (cc_));                                                     \
    const size_t base_ = (size_t)((dir * 384 + gc_) * 4 + head) * 4096;                                        \
    const size_t kb_ = (size_t)(gc_ * 4 + head) * 4096;                                                        \
    _Pragma("unroll") for (int i = 0; i < 2; ++i) {                                                            \
      const int id_ = tid + i * 256;                                                                           \
      rq[i] = gload16(p.HQ + base_ + id_ * 8);                                                                 \
      rk[i] = gload16(HKd + kb_ + id_ * 8);                                                                    \
      rkt[i] = gload16(p.HKt + base_ + id_ * 8);                                                               \
    }                                                                                                          \
    if (tid < 128) {                                                                                           \
      const int r_ = tid & 31, ch_ = tid >> 5;                                                                 \
      rv = gload16(P + (size_t)(gc_ * 32 + (dir ? 31 - r_ : r_)) * ldp + 1536 + head * 128 + slice * 32 + ch_ * 8); \
    }                                                                                                          \
    const float* evb_ = p.EV + (size_t)((dir * 384 + gc_) * 4 + head) * 384 + 32 * w + 4 * kg;                 \
    _Pragma("unroll") for (int x = 0; x < 3; ++x) {                                                            \
      ev[x][0] = gload16(evb_ + x * 128);                                                                      \
      ev[x][1] = gload16(evb_ + x * 128 + 16);                                                                 \
    }                                                                                                          \
  }
#define HG_WAIT() asm volatile("s_waitcnt vmcnt(0)" : "+v"(rq[0]), "+v"(rq[1]), "+v"(rk[0]), "+v"(rk[1]), "+v"(rkt[0]), "+v"(rkt[1]), "+v"(rv), "+v"(ev[0][0]), "+v"(ev[0][1]), "+v"(ev[1][0]), "+v"(ev[1][1]), "+v"(ev[2][0]), "+v"(ev[2][1]) : : "memory")
  f32x4 curE[2], cure2[2];
#define HG_STAGE()                                                                                             \
  {                                                                                                            \
    _Pragma("unroll") for (int i = 0; i < 2; ++i) {                                                            \
      const int id_ = tid + i * 256;                                                                           \
      *(u32x4*)(sQt + (id_ >> 4) * 136 + (id_ & 15) * 8) = rq[i];                                              \
      *(u32x4*)(sKt_ + (id_ >> 4) * 136 + (id_ & 15) * 8) = rk[i];                                             \
      *(u32x4*)(sK2t + (id_ >> 2) * 40 + (id_ & 3) * 8) = rkt[i];                                              \
    }                                                                                                          \
    if (tid < 128) {                                                                                           \
      const int r_ = tid & 31, ch_ = tid >> 5;                                                                 \
      _Pragma("unroll") for (int j = 0; j < 4; ++j) {                                                          \
        sVt[(ch_ * 8 + 2 * j) * 40 + r_] = (bf16_t)(rv[j] & 0xffffu);                                          \
        sVt[(ch_ * 8 + 2 * j + 1) * 40 + r_] = (bf16_t)(rv[j] >> 16);                                          \
      }                                                                                                        \
    }                                                                                                          \
    _Pragma("unroll") for (int rb = 0; rb < 2; ++rb) {                                                         \
      f32x4 e1_;                                                                                               \
      _Pragma("unroll") for (int r = 0; r < 4; ++r) {                                                          \
        e1_[r] = __uint_as_float(ev[0][rb][r]);                                                                \
        cure2[rb][r] = __uint_as_float(ev[1][rb][r]);                                                          \
        curE[rb][r] = __uint_as_float(ev[2][rb][r]);                                                           \
      }                                                                                                        \
      _Pragma("unroll") for (int nb = 0; nb < 2; ++nb) {                                                       \
        uint2 o_;                                                                                              \
        o_.x = pk2(sacc[rb][nb][0] * e1_[0], sacc[rb][nb][1] * e1_[1]);                                        \
        o_.y = pk2(sacc[rb][nb][2] * e1_[2], sacc[rb][nb][3] * e1_[3]);                                        \
        *(uint2*)(sSt + (nb * 16 + l15) * 136 + 32 * w + rb * 16 + 4 * kg) = o_;                               \
      }                                                                                                        \
    }                                                                                                          \
  }
  HG_ISSUE(0);
  HG_WAIT();
  HG_STAGE();
  __syncthreads();
  const int br = w >> 1, bcn = w & 1;
  for (int c = 0; c < nch; ++c) {
    if (c + 1 < nch) HG_ISSUE(c + 1);
    __builtin_amdgcn_sched_barrier(0);
    {
      f32x4 acc;
#pragma unroll
      for (int r = 0; r < 4; ++r) acc[r] = 0.f;
      if (!(br == 0 && bcn == 1)) {
#pragma unroll
        for (int kk = 0; kk < 4; ++kk) {
          const s16x8 a = *(const s16x8*)(sQt + (br * 16 + l15) * 136 + kk * 32 + kg * 8);
          const s16x8 bb = *(const s16x8*)(sKt_ + (bcn * 16 + l15) * 136 + kk * 32 + kg * 8);
          acc = mfma16_safe(a, bb, acc);
        }
      }
#pragma unroll
      for (int r = 0; r < 4; ++r) {
        const int t = br * 16 + 4 * kg + r, sidx = bcn * 16 + l15;
        sAtt[t * 40 + sidx] = (sidx <= t) ? f2bf(acc[r]) : (bf16_t)0;
      }
    }
    __syncthreads();
    {
      f32x4 oacc;
#pragma unroll
      for (int r = 0; r < 4; ++r) oacc[r] = 0.f;
#pragma unroll
      for (int kk = 0; kk < 4; ++kk) {
        const s16x8 a = *(const s16x8*)(sQt + (br * 16 + l15) * 136 + kk * 32 + kg * 8);
        const s16x8 bb = *(const s16x8*)(sSt + (bcn * 16 + l15) * 136 + kk * 32 + kg * 8);
        oacc = mfma16_safe(a, bb, oacc);
      }
      {
        const s16x8 a = *(const s16x8*)(sAtt + (br * 16 + l15) * 40 + kg * 8);
        const s16x8 bb = *(const s16x8*)(sVt + (bcn * 16 + l15) * 40 + kg * 8);
        oacc = mfma16_safe(a, bb, oacc);
      }
      const int gc = gc0 + (dir ? nch - 1 - c : c);
#pragma unroll
      for (int r = 0; r < 4; ++r) {
        const int t = br * 16 + 4 * kg + r, e = bcn * 16 + l15;
        O[(size_t)(gc * 32 + (dir ? 31 - t : t)) * 512 + head * 128 + slice * 32 + e] = oacc[r];
      }
#pragma unroll
      for (int rb = 0; rb < 2; ++rb) {
        const s16x8 a = *(const s16x8*)(sK2t + (32 * w + rb * 16 + l15) * 40 + kg * 8);
#pragma unroll
        for (int nb = 0; nb < 2; ++nb) {
          const s16x8 bb = *(const s16x8*)(sVt + (nb * 16 + l15) * 40 + kg * 8);
          f32x4 ds;
#pragma unroll
          for (int r = 0; r < 4; ++r) ds[r] = 0.f;
          ds = mfma16_safe(a, bb, ds);
#pragma unroll
          for (int r = 0; r < 4; ++r) sacc[rb][nb][r] = curE[rb][r] * sacc[rb][nb][r] + cure2[rb][r] * ds[r];
        }
      }
    }
    __syncthreads();
    if (c + 1 < nch) {
      HG_WAIT();
      HG_STAGE();
    }
    __syncthreads();
  }
  if (!sample) {
    float* oS = p.out + (size_t)NT * DM + 524288 * 2 + 2097152 + 16384 + 128;
#pragma unroll
    for (int rb = 0; rb < 2; ++rb)
#pragma unroll
      for (int nb = 0; nb < 2; ++nb)
#pragma unroll
        for (int r = 0; r < 4; ++r) {
          const int dd = 32 * w + rb * 16 + 4 * kg + r, e = nb * 16 + l15;
          oS[(((size_t)((b * 2 + dir) * 4 + head)) * 128 + dd) * 128 + slice * 32 + e] = sacc[rb][nb][r];
        }
  }
  __syncthreads();
}

__device__ __forceinline__ void combine_phase(const Params& p, int odd) {
  const int tid_ = otid(); const int lane = tid_ & 63, w = tid_ >> 6;
  const bf16_t* P = p.R1;
  const float* N0 = p.Z;
  const float* N1 = p.Z + (size_t)NT * 512;
  const float* gp = odd ? p.c_norm_g : p.b_norm_g;
  float g0[4], g1[4];
#pragma unroll
  for (int hd = 0; hd < 4; ++hd) { g0[hd] = gp[hd * 128 + lane]; g1[hd] = gp[hd * 128 + 64 + lane]; }
  const int ldp = odd ? LDPO : LDPE, gcol = odd ? 2048 : 2320, ocol = odd ? 0 : 512;
  for (int row = obid() * 4 + w; row < NT; row += gridDim.x * 4) {
    float a0[4], a1[4], b0[4], b1[4], gt0[4], gt1[4], i0[4], i1[4];
#pragma unroll
    for (int hd = 0; hd < 4; ++hd) {
      const size_t o = (size_t)row * 512 + hd * 128;
      a0[hd] = N0[o + lane]; a1[hd] = N0[o + 64 + lane]; b0[hd] = N1[o + lane]; b1[hd] = N1[o + 64 + lane];
      gt0[hd] = bf2f(P[(size_t)row * ldp + gcol + hd * 128 + lane]);
      gt1[hd] = bf2f(P[(size_t)row * ldp + gcol + hd * 128 + 64 + lane]);
      i0[hd] = 1.f; i1[hd] = 1.f;
      if (!odd) {
        const float d0 = p.DEN[((size_t)row) * 4 + hd], c0 = p.CL[((size_t)row) * 4 + hd];
        const float d1 = p.DEN[((size_t)NT + row) * 4 + hd], c1 = p.CL[((size_t)NT + row) * 4 + hd];
        i0[hd] = 1.f / fmaxf(fabsf(d0), c0); i1[hd] = 1.f / fmaxf(fabsf(d1), c1);
      }
    }
#pragma unroll
    for (int hd = 0; hd < 4; ++hd) {
      const float h0 = a0[hd] * i0[hd] + b0[hd] * i1[hd];
      const float h1 = a1[hd] * i0[hd] + b1[hd] * i1[hd];
      const float ms = wave_sum(h0 * h0 + h1 * h1) * (1.f / 128.f);
      const float rs = rsqrtf(ms + 1e-6f);
      const float m0 = odd ? gt0[hd] * sigmoidf_(gt0[hd]) : sigmoidf_(gt0[hd]);
      const float m1 = odd ? gt1[hd] * sigmoidf_(gt1[hd]) : sigmoidf_(gt1[hd]);
      p.Hb[(size_t)row * DM + ocol + hd * 128 + lane] = f2bf(m0 * h0 * rs * g0[hd]);
      p.Hb[(size_t)row * DM + ocol + hd * 128 + 64 + lane] = f2bf(m1 * h1 * rs * g1[hd]);
    }
  }
}

__device__ __forceinline__ void my_gsync(unsigned* bar, unsigned& epoch, unsigned nblocks) {
  asm volatile("s_waitcnt vmcnt(0) lgkmcnt(0)" ::: "memory");
  __syncthreads();
  epoch += 1;
  if (threadIdx.x == 0) {
    __builtin_amdgcn_fence(__ATOMIC_RELEASE, "agent");
    asm volatile("s_waitcnt vmcnt(0) lgkmcnt(0)" ::: "memory");
    const unsigned g = blockIdx.x & 31u;
    const unsigned gsize = (nblocks >> 5) + ((g < (nblocks & 31u)) ? 1u : 0u);
    const unsigned old = __hip_atomic_fetch_add(&bar[g * 64], 1u, __ATOMIC_RELAXED, __HIP_MEMORY_SCOPE_AGENT);
    if (old + 1 == epoch * gsize) {
      const unsigned ngroups = nblocks < 32u ? nblocks : 32u;
      const unsigned old2 = __hip_atomic_fetch_add(&bar[32 * 64], 1u, __ATOMIC_RELAXED, __HIP_MEMORY_SCOPE_AGENT);
      if (old2 + 1 == epoch * ngroups) __hip_atomic_store(&bar[33 * 64], epoch, __ATOMIC_RELAXED, __HIP_MEMORY_SCOPE_AGENT);
    }
    while (__hip_atomic_load(&bar[33 * 64], __ATOMIC_RELAXED, __HIP_MEMORY_SCOPE_AGENT) < epoch) __builtin_amdgcn_s_sleep(1);
    __builtin_amdgcn_fence(__ATOMIC_ACQUIRE, "agent");
  }
  __syncthreads();
  __builtin_amdgcn_fence(__ATOMIC_ACQUIRE, "agent");
}
#define XB_XCNT(j) (4096 + 64 * (j))
#define XB_XSUB(j) (5120 + 64 * (j))
#define XB_XGEN(j) (6144 + 64 * (j))
#define XB_TOP 7168
#define XB_TOPGEN 7232
__device__ __forceinline__ unsigned xb_ld(unsigned* q) { return __hip_atomic_load(q, __ATOMIC_RELAXED, __HIP_MEMORY_SCOPE_AGENT); }
__device__ __forceinline__ unsigned xb_add(unsigned* q) { return __hip_atomic_fetch_add(q, 1u, __ATOMIC_RELAXED, __HIP_MEMORY_SCOPE_AGENT); }
__device__ __forceinline__ void xb_st(unsigned* q, unsigned v) { __hip_atomic_store(q, v, __ATOMIC_RELAXED, __HIP_MEMORY_SCOPE_AGENT); }
__device__ __forceinline__ void xsync(unsigned* bar, unsigned& epoch, unsigned xcc, unsigned cntx, unsigned nxcc) {
  asm volatile("s_waitcnt vmcnt(0) lgkmcnt(0)" ::: "memory");
  __syncthreads();
  epoch += 1;
  if (threadIdx.x == 0) {
    const unsigned old = xb_add(&bar[XB_XSUB(xcc)]);
    if (old + 1 == epoch * cntx) {
      __builtin_amdgcn_fence(__ATOMIC_RELEASE, "agent");
      asm volatile("s_waitcnt vmcnt(0) lgkmcnt(0)" ::: "memory");
      const unsigned old2 = xb_add(&bar[XB_TOP]);
      if (old2 + 1 == epoch * nxcc) xb_st(&bar[XB_TOPGEN], epoch);
      else while (xb_ld(&bar[XB_TOPGEN]) < epoch) __builtin_amdgcn_s_sleep(1);
      xb_st(&bar[XB_XGEN(xcc)], epoch);
    } else {
      while (xb_ld(&bar[XB_XGEN(xcc)]) < epoch) __builtin_amdgcn_s_sleep(1);
    }
    __builtin_amdgcn_fence(__ATOMIC_ACQUIRE, "agent");
    asm volatile("s_waitcnt vmcnt(0) lgkmcnt(0)" ::: "memory");
  }
  __syncthreads();
}
#define GSYNC() xsync(p.bar, xepoch, xcc, cntx, nxcc)
__global__ void __launch_bounds__(256, 2) fwd_megakernel(Params p) {
  cg::grid_group grid = cg::this_grid();
  __shared__ __attribute__((aligned(16))) char smem[LDS_BYTES];
  const int G = gridDim.x;
  unsigned epoch = 0, xepoch = 0;
  if (p.njobs < 0) grid.sync();
  const unsigned xcc = (unsigned)__builtin_amdgcn_s_getreg((3 << 11) | 20) & 0xFu;
  if (threadIdx.x == 0) xb_add(&p.bar[XB_XCNT(xcc)]);
  my_gsync(p.bar, epoch, (unsigned)gridDim.x);
  const unsigned cntx = xb_ld(&p.bar[XB_XCNT(xcc)]);
  unsigned nxcc = 0;
#pragma unroll
  for (int jx = 0; jx < 16; ++jx) nxcc += (xb_ld(&p.bar[XB_XCNT(jx)]) != 0u) ? 1u : 0u;

  {
    const int nmod = 72, b_ = obid();
    if (G > 2 * nmod) {
      if (b_ < nmod) mod_item(p, b_, smem);
      else {
        for (int t = b_ - nmod; t < p.conv_tiles_l0; t += G - nmod) {
          int j = 0;
#pragma unroll 1
          for (int q = 1; q < p.njobs; ++q) if (t >= p.jobs[q].tile0) j = q;
          conv_tile(p.jobs[j], t - p.jobs[j].tile0, smem);
        }
      }
    } else {
      for (int it = b_; it < nmod + p.total_conv_tiles; it += G) {
        if (it < nmod) mod_item(p, it, smem);
        else {
          const int t = it - nmod;
          int j = 0;
#pragma unroll 1
          for (int q = 1; q < p.njobs; ++q) if (t >= p.jobs[q].tile0) j = q;
          conv_tile(p.jobs[j], t - p.jobs[j].tile0, smem);
        }
      }
    }
  }
  GSYNC();
  modulate_input_phase(p);
  GSYNC();

#pragma unroll 1
  for (int l = 0; l < 2; ++l) {
    const int odd = l;
#pragma unroll 1
    for (int j = 0; j < 2; ++j) {
      if (j == 1) {
        {
          EpiStoreBf16 epi{p.R1, odd ? LDPO : LDPE};
          gemm_phase<2, EpiStoreBf16>(p.Hb, DM, odd ? p.WtInO : p.WtInE, DM, odd ? LDPO : LDPE, DM, epi, smem);
        }
        GSYNC();
        prep_vectors(p, odd);
        prep_v(p, odd, smem);
        if (odd) hgrn_pre(p, smem);
        GSYNC();
        {
          const int nlong = odd ? 128 : 160, nshort = odd ? 512 : 640, natt = 768;
          const int b_ = obid();
          if (b_ < nlong && G > nlong) {
            if (!odd) mlstm_item(p, b_, smem); else hgrn_item(p, b_, smem);
          } else {
            const int first = (G > nlong) ? b_ - nlong : b_, stride = (G > nlong) ? G - nlong : G;
            const int lo_it = (G > nlong) ? 0 : -nlong;
            for (int it = first + lo_it; it < natt + nshort; it += stride) {
              if (it < 0) { if (!odd) mlstm_item(p, it + nlong, smem); else hgrn_item(p, it + nlong, smem); }
              else if (it < natt) attn_item(p, odd, it, smem);
              else if (!odd) mlstm_item(p, nlong + (it - natt), smem);
              else hgrn_item(p, nlong + (it - natt), smem);
            }
            if (!odd) {
              const int nx = p.total_conv_tiles - p.conv_tiles_l0;
              for (int x = first; x < nx; x += stride) {
                const int t = p.conv_tiles_l0 + x;
                int jj = 0;
#pragma unroll 1
                for (int q = 1; q < p.njobs; ++q) if (t >= p.jobs[q].tile0) jj = q;
                conv_tile(p.jobs[jj], t - p.jobs[jj].tile0, smem);
              }
            }
          }
        }
        GSYNC();
        combine_phase(p, odd);
        GSYNC();
        {
          EpiResid<2> epi{p.Z, p.out, p.out + (size_t)NPR * DM, modp(p, l, 0, 5), 1.f};
          gemm_phase<2, EpiResid<2>>(p.Hb, DM, odd ? p.WtOutO : p.WtOutE, DM, DM, DM, epi, smem);
        }
        GSYNC();
        ln_phase(p, p.ln_g + (size_t)(l * 3 + 1) * DM, p.ln_b + (size_t)(l * 3 + 1) * DM, true, l, 2);
        GSYNC();
      }
      const int j2 = j * 2;
      {
        EpiSwiglu epi{p.R1};
        gemm_phase<2, EpiSwiglu>(p.Hb, DM, p.Wt13p[l * 2 + j], DM, 5632, DM, epi, smem);
      }
      GSYNC();
      {
        const bool first = (l == 0 && j == 0);
        EpiResid<2> epi{p.Z, first ? p.x_prompt : p.out, first ? p.x_sample : p.out + (size_t)NPR * DM, modp(p, l, 0, 3 * j2 + 2), 0.5f};
        gemm_phase<2, EpiResid<2>>(p.R1, DFF, p.Wt2p[l * 2 + j], DFF, DM, DFF, epi, smem);
      }
      GSYNC();
      {
        const bool last = (l == 1 && j == 1);
        const int nl = (j == 0) ? l : l + 1, nj = (j == 0) ? 1 : 0;
        ln_phase(p, p.ln_g + (size_t)(l * 3 + j2) * DM, p.ln_b + (size_t)(l * 3 + j2) * DM, !last, last ? 0 : nl, last ? 0 : nj);
      }
      GSYNC();
    }
  }
}


template <int PH>
__global__ void __launch_bounds__(256, 2) k_phase(Params p, int l, int j) {
  __shared__ __attribute__((aligned(16))) char smem[LDS_BYTES];
  const int G = gridDim.x;
  const int odd = l;
  if (PH == 0) {
    const int nmod = 72;
    for (int it = obid(); it < nmod + p.total_conv_tiles; it += G) {
      if (it < nmod) mod_item(p, it, smem);
      else {
        const int t = it - nmod;
        int jj = 0;
#pragma unroll 1
        for (int q = 1; q < p.njobs; ++q) if (t >= p.jobs[q].tile0) jj = q;
        conv_tile(p.jobs[jj], t - p.jobs[jj].tile0, smem);
      }
    }
  } else if (PH == 1) {
    modulate_input_phase(p);
  } else if (PH == 2) {
    EpiStoreBf16 epi{p.R1, odd ? LDPO : LDPE};
    gemm_phase<2, EpiStoreBf16>(p.Hb, DM, odd ? p.WtInO : p.WtInE, DM, odd ? LDPO : LDPE, DM, epi, smem);
  } else if (PH == 3) {
    prep_vectors(p, odd);
    prep_v(p, odd, smem);
    if (odd) hgrn_pre(p, smem);
  } else if (PH == 4) {
    for (int it = obid(); it < 160 + 640 + 768; it += G) {
      if (it < 160) mlstm_item(p, it, smem);
      else if (it < 160 + 768) attn_item(p, 0, it - 160, smem);
      else mlstm_item(p, it - 768, smem);
    }
  } else if (PH == 5) {
    for (int it = obid(); it < 128 + 512 + 768; it += G) {
      if (it < 128) hgrn_item(p, it, smem);
      else if (it < 128 + 768) attn_item(p, 1, it - 128, smem);
      else hgrn_item(p, it - 768, smem);
    }
  } else if (PH == 6) {
    combine_phase(p, odd);
  } else if (PH == 7) {
    EpiResid<1> epi{p.Z, p.out, p.out + (size_t)NPR * DM, modp(p, l, 0, 5), 1.f};
    gemm_phase<1, EpiResid<1>>(p.Hb, DM, odd ? p.WtOutO : p.WtOutE, DM, DM, DM, epi, smem);
  } else if (PH == 8) {
    ln_phase(p, p.ln_g + (size_t)(l * 3 + 1) * DM, p.ln_b + (size_t)(l * 3 + 1) * DM, true, l, 2);
  } else if (PH == 9) {
    EpiSwiglu epi{p.R1};
    gemm_phase<2, EpiSwiglu>(p.Hb, DM, p.Wt13p[l * 2 + j], DM, 5632, DM, epi, smem);
  } else if (PH == 10) {
    const int j2 = j * 2;
    const bool first = (l == 0 && j == 0);
    EpiResid<1> epi{p.Z, first ? p.x_prompt : p.out, first ? p.x_sample : p.out + (size_t)NPR * DM, modp(p, l, 0, 3 * j2 + 2), 0.5f};
    gemm_phase<1, EpiResid<1>>(p.R1, DFF, p.Wt2p[l * 2 + j], DFF, DM, DFF, epi, smem);
  } else if (PH == 13) {
    for (size_t i = (size_t)obid() * 256 + otid(); i < (size_t)8192 * 512; i += (size_t)G * 256) p.SAVE[i] = p.Z[i];
  } else if (PH == 14) {
    bool bad = false;
    for (size_t i = (size_t)obid() * 256 + otid(); i < (size_t)8192 * 512; i += (size_t)G * 256) if (__float_as_uint(p.SAVE[i]) != __float_as_uint(p.Z[i])) bad = true;
    if (bad) { volatile int* q = (volatile int*)p.SAVE; while (q[0] != 0x7fffffff) { __builtin_amdgcn_s_sleep(10); } }
  } else if (PH == 11) {
    const int j2 = j * 2;
    const bool last = (l == 1 && j == 1);
    const int nl = (j == 0) ? l : l + 1, nj = (j == 0) ? 1 : 0;
    ln_phase(p, p.ln_g + (size_t)(l * 3 + j2) * DM, p.ln_b + (size_t)(l * 3 + j2) * DM, !last, last ? 0 : nl, last ? 0 : nj);
  }
}
extern "C" void kernel_launch(void* const* d_in, const int* in_sizes, int n_in, void* d_out, int out_size, void* d_ws,
                              size_t ws_size, hipStream_t stream) {
  static Params p;
  memset(&p, 0, sizeof(p));
  const float** ip = (const float**)&p.x_prompt;
  for (int i = 0; i < 30; ++i) ip[i] = (const float*)d_in[i];
  p.out = (float*)d_out;
  char* ws = (char*)d_ws;
  size_t off = 0;
  auto take = [&](size_t bytes) { char* r = ws + off; off += (bytes + 255) & ~(size_t)255; return r; };
  p.bar = (unsigned*)take(32768);
  char* l0_begin = ws + off;
  p.Wt13p[0] = (bf16_t*)take((size_t)5632 * 1024 * 2);
  p.Wt13p[1] = (bf16_t*)take((size_t)5632 * 1024 * 2);
  p.Wt2p[0] = (bf16_t*)take((size_t)1024 * DFF * 2);
  p.Wt2p[1] = (bf16_t*)take((size_t)1024 * DFF * 2);
  p.WtInE = (bf16_t*)take((size_t)LDPE * 1024 * 2);
  p.WtOutE = (bf16_t*)take((size_t)1024 * 1024 * 2);
  char* l0_end = ws + off;
  p.HQ = (bf16_t*)l0_begin;
  p.EV = (float*)(l0_begin + 25165824);
  p.HK0 = (bf16_t*)(l0_begin + 25165824 + 4718592);
  if (l0_begin + 25165824 + 4718592 + 12582912 > l0_end) fprintf(stderr, "layer-0 weight region too small for the HGRN buffers\n");
  p.Wt13p[2] = (bf16_t*)take((size_t)5632 * 1024 * 2);
  p.Wt13p[3] = (bf16_t*)take((size_t)5632 * 1024 * 2);
  p.Wt2p[2] = (bf16_t*)take((size_t)1024 * DFF * 2);
  p.Wt2p[3] = (bf16_t*)take((size_t)1024 * DFF * 2);
  p.WtInO = (bf16_t*)take((size_t)LDPO * 1024 * 2);
  p.WtOutO = (bf16_t*)take((size_t)1024 * 1024 * 2);
  p.HK1 = (bf16_t*)take((size_t)12582912);
  p.HKt = (bf16_t*)take((size_t)25165824);
  p.MOD = (float*)take((size_t)2 * 5 * 9216 * 4);
  p.Hb = (bf16_t*)take((size_t)NT * DM * 2);
  p.R1 = (bf16_t*)take((size_t)NT * LDPO * 2);
  p.Z = (float*)take((size_t)NT * DM * 4);
  p.Qb = (bf16_t*)take((size_t)NT * 512 * 2);
  p.Kb = (bf16_t*)take((size_t)NT * 128 * 2);
  p.Vt = (bf16_t*)take((size_t)(524288 + 1048576) * 2);
  p.Kc = (bf16_t*)take((size_t)262144 * 2);
  p.Vct = (bf16_t*)take((size_t)262144 * 2);
  p.DEN = (float*)take((size_t)2 * NT * 4 * 4);
  p.CL = (float*)take((size_t)2 * NT * 4 * 4);
  if (off > ws_size) fprintf(stderr, "workspace too small: need %zu have %zu\n", off, ws_size);
  int nj = 0, tiles = 0;
  auto add = [&](const float* src, bf16_t* dst, int K, int N, int Npad, int mode) {
    ConvJob& jb = p.jobs[nj++];
    jb.src = src; jb.dst = dst; jb.K = K; jb.N = N; jb.Npad = Npad; jb.mode = mode; jb.tile0 = tiles; jb.pad0 = 0;
    tiles += (K / 64) * (Npad / 64);
  };
  for (int lj = 0; lj < 2; ++lj) {
    add(p.ffn_w1 + (size_t)lj * 1024 * DFF, p.Wt13p[lj], 1024, DFF, DFF, 1);
    add(p.ffn_w3 + (size_t)lj * 1024 * DFF, p.Wt13p[lj], 1024, DFF, DFF, 2);
    add(p.ffn_w2 + (size_t)lj * DFF * 1024, p.Wt2p[lj], DFF, 1024, 1024, 0);
  }
  add(p.w_in_even, p.WtInE, 1024, 2832, LDPE, 0);
  add(p.w_out_even, p.WtOutE, 1024, 1024, 1024, 0);
  p.conv_tiles_l0 = tiles;
  for (int lj = 2; lj < 4; ++lj) {
    add(p.ffn_w1 + (size_t)lj * 1024 * DFF, p.Wt13p[lj], 1024, DFF, DFF, 1);
    add(p.ffn_w3 + (size_t)lj * 1024 * DFF, p.Wt13p[lj], 1024, DFF, DFF, 2);
    add(p.ffn_w2 + (size_t)lj * DFF * 1024, p.Wt2p[lj], DFF, 1024, 1024, 0);
  }
  add(p.w_in_odd, p.WtInO, 1024, LDPO, LDPO, 0);
  add(p.w_out_odd, p.WtOutO, 1024, 1024, 1024, 0);
  p.njobs = nj; p.total_conv_tiles = tiles;
  static int grid_blocks = 0;
  if (!grid_blocks) {
    int dev = 0, cus = 0, per_cu = 0;
    hipGetDevice(&dev);
    hipDeviceGetAttribute(&cus, hipDeviceAttributeMultiprocessorCount, dev);
    hipOccupancyMaxActiveBlocksPerMultiprocessor(&per_cu, fwd_megakernel, 256, 0);
    per_cu = 2;
    grid_blocks = cus * per_cu;
  }
  hipMemsetAsync(p.bar, 0, 32768, stream);
#if MULTI_LAUNCH
  const dim3 g(512), b(256);
  k_phase<0><<<g, b, 0, stream>>>(p, 0, 0);
  k_phase<1><<<g, b, 0, stream>>>(p, 0, 0);
  for (int l = 0; l < 2; ++l)
    for (int j = 0; j < 2; ++j) {
      if (j == 1) {
        k_phase<2><<<g, b, 0, stream>>>(p, l, j);
        k_phase<3><<<g, b, 0, stream>>>(p, l, j);
        if (l == 0) k_phase<4><<<g, b, 0, stream>>>(p, l, j); else k_phase<5><<<g, b, 0, stream>>>(p, l, j);
        k_phase<6><<<g, b, 0, stream>>>(p, l, j);
        k_phase<7><<<g, b, 0, stream>>>(p, l, j);
        k_phase<8><<<g, b, 0, stream>>>(p, l, j);
      }
      k_phase<9><<<g, b, 0, stream>>>(p, l, j);
      k_phase<10><<<g, b, 0, stream>>>(p, l, j);
      k_phase<11><<<g, b, 0, stream>>>(p, l, j);
    }
#else
  void* args[] = {&p};
  hipError_t e = hipLaunchCooperativeKernel((void*)fwd_megakernel, dim3(grid_blocks), dim3(256), args, 0, stream);
  if (e != hipSuccess) fprintf(stderr, "cooperative launch failed: %s (grid %d)\n", hipGetErrorString(e), grid_blocks);
#endif
}
```

```cpp
#define MULTI_LAUNCH 0
#include <hip/hip_runtime.h>
#include <hip/hip_cooperative_groups.h>
#include <cstdint>
#include <cstring>
#include <cstdio>
namespace cg = cooperative_groups;

typedef unsigned short bf16_t;
typedef short s16x8 __attribute__((ext_vector_type(8)));
typedef short s16x4 __attribute__((ext_vector_type(4)));
typedef float f32x4 __attribute__((ext_vector_type(4)));
typedef float f32x16 __attribute__((ext_vector_type(16)));
typedef unsigned u32x4 __attribute__((ext_vector_type(4)));

#define NT 12288
#define NPR 4096
#define DM 1024
#define DFF 2816
#define LDPE 2944
#define LDPO 3328
#define ALPHA_F 1.4142135623730951f
#define LOG2E 1.4426950408889634f
#define LDS_BYTES 77824

struct ConvJob { const float* src; bf16_t* dst; int K, N, Npad, mode, tile0, pad0; };

struct Params {
  const float *x_prompt, *x_sample, *c, *cache_a_k, *cache_a_v, *state_b_C, *state_b_n, *state_b_m, *state_c_S,
      *cache_d_k, *cache_d_v, *c_ctx, *ada_w, *ada_b, *ln_g, *ln_b, *ffn_w1, *ffn_w3, *ffn_w2, *w_in_even,
      *w_out_even, *a_sink, *b_gate_bias, *b_norm_g, *w_in_odd, *w_out_odd, *c_lb_logits, *c_norm_g, *d_q_norm,
      *d_k_norm;
  float* out;
  bf16_t *Wt13p[4], *Wt2p[4], *WtInE, *WtInO, *WtOutE, *WtOutO;
  bf16_t *HQ, *HK0, *HK1, *HKt; float* EV;
  float* MOD;
  bf16_t* Hb;
  bf16_t* R1;
  float* Z;
  bf16_t *Qb, *Kb, *Vt, *Kc, *Vct;
  float *DEN, *CL;
  ConvJob jobs[16];
  int njobs, total_conv_tiles, conv_tiles_l0, pad1;
  float* SAVE;
  unsigned* bar;
};

__device__ __forceinline__ int otid() { int t = threadIdx.x; asm volatile("" : "+v"(t)); return t; }
__device__ __forceinline__ int obid() { int t = blockIdx.x; asm volatile("" : "+s"(t)); return t; }
__device__ __forceinline__ u32x4 gload16(const void* ptr) {
  u32x4 r;
  asm volatile("global_load_dwordx4 %0, %1, off" : "=v"(r) : "v"(ptr) : "memory");
  return r;
}
__device__ __forceinline__ unsigned gload2(const void* ptr) {
  unsigned r;
  asm volatile("global_load_ushort %0, %1, off" : "=v"(r) : "v"(ptr) : "memory");
  return r;
}
__device__ __forceinline__ void vm_wait4(u32x4& a, u32x4& b, u32x4& c, u32x4& d) {
  asm volatile("s_waitcnt vmcnt(0)" : "+v"(a), "+v"(b), "+v"(c), "+v"(d) : : "memory");
}
__device__ __forceinline__ void vm_wait2(u32x4& a, u32x4& b) {
  asm volatile("s_waitcnt vmcnt(0)" : "+v"(a), "+v"(b) : : "memory");
}
__device__ __forceinline__ f32x4 mfma16_safe(s16x8 a, s16x8 b, f32x4 c) {
  asm volatile("s_nop 4\n\tv_mfma_f32_16x16x32_bf16 %0, %1, %2, %0\n\ts_nop 7\n\ts_nop 7" : "+v"(c) : "v"(a), "v"(b));
  return c;
}
__device__ __forceinline__ float bf2f(bf16_t v) { return __uint_as_float(((unsigned)v) << 16); }
__device__ __forceinline__ bf16_t f2bf(float f) {
  unsigned u = __float_as_uint(f);
  u += 0x7fffu + ((u >> 16) & 1u);
  return (bf16_t)(u >> 16);
}
__device__ __forceinline__ unsigned pk2(float a, float b) { return (unsigned)f2bf(a) | ((unsigned)f2bf(b) << 16); }
__device__ __forceinline__ float wave_sum(float v) {
#pragma unroll
  for (int o = 32; o > 0; o >>= 1) v += __shfl_xor(v, o);
  return v;
}
__device__ __forceinline__ int mod_index(int row) { return row < NPR ? 0 : 1 + ((row - NPR) >> 11); }
__device__ __forceinline__ const float* modp(const Params& p, int l, int mi, int part) {
  return p.MOD + ((size_t)((l * 5 + mi) * 9 + part)) * DM;
}
__device__ __forceinline__ float sigmoidf_(float x) { return __builtin_amdgcn_rcpf(1.f + __expf(-x)); }

__device__ __forceinline__ void conv_tile(const ConvJob& jb, int t, char* smem) {
  float* sT = (float*)smem;
  const int nkt = jb.K >> 6;
  const int kt = t % nkt, nt = t / nkt;
  const int k0 = kt * 64, n0 = nt * 64;
  const int tid = otid();
#pragma unroll
  for (int i = 0; i < 4; ++i) {
    const int r = (tid >> 4) + 16 * i, c4 = (tid & 15) * 4, n = n0 + c4;
    float4 v = make_float4(0.f, 0.f, 0.f, 0.f);
    if (n < jb.N) v = *(const float4*)(jb.src + (size_t)(k0 + r) * jb.N + n);
    sT[r * 65 + c4 + 0] = v.x; sT[r * 65 + c4 + 1] = v.y; sT[r * 65 + c4 + 2] = v.z; sT[r * 65 + c4 + 3] = v.w;
  }
  __syncthreads();
#pragma unroll
  for (int i = 0; i < 2; ++i) {
    const int id = tid + i * 256, nl = id >> 3, ch = id & 7;
    const int n = n0 + nl;
    int drow = n;
    if (jb.mode == 1) drow = (n >> 5) * 64 + (n & 31);
    else if (jb.mode == 2) drow = (n >> 5) * 64 + 32 + (n & 31);
    uint4 w;
    w.x = pk2(sT[(ch * 8 + 0) * 65 + nl], sT[(ch * 8 + 1) * 65 + nl]);
    w.y = pk2(sT[(ch * 8 + 2) * 65 + nl], sT[(ch * 8 + 3) * 65 + nl]);
    w.z = pk2(sT[(ch * 8 + 4) * 65 + nl], sT[(ch * 8 + 5) * 65 + nl]);
    w.w = pk2(sT[(ch * 8 + 6) * 65 + nl], sT[(ch * 8 + 7) * 65 + nl]);
    if (n < jb.Npad) *(uint4*)(jb.dst + (size_t)drow * jb.K + k0 + ch * 8) = w;
  }
  __syncthreads();
}

__device__ __forceinline__ void mod_item(const Params& p, int item, char* smem) {
  float* sv = (float*)smem;
  float4* red = (float4*)(smem + 20480);
  const int l = item / 36, cgp = item % 36, tid = otid();
  for (int idx = tid; idx < 5120; idx += 256) {
    const int n = idx >> 10, k = idx & 1023;
    const float v = (n == 0) ? p.c_ctx[k] : p.c[(n - 1) * 1024 + k];
    sv[idx] = v * sigmoidf_(v);
  }
  __syncthreads();
  const int kq = tid >> 6, cl = tid & 63, col = cgp * 256 + cl * 4;
  const float* W = p.ada_w + (size_t)l * 1024 * 9216 + col;
  float4 acc[5];
#pragma unroll
  for (int n = 0; n < 5; ++n) acc[n] = make_float4(0.f, 0.f, 0.f, 0.f);
  for (int kb = 0; kb < 256; kb += 8) {
    float4 w[8];
#pragma unroll
    for (int u = 0; u < 8; ++u) w[u] = *(const float4*)(W + (size_t)(kq * 256 + kb + u) * 9216);
#pragma unroll
    for (int u = 0; u < 8; ++u) {
#pragma unroll
      for (int n = 0; n < 5; ++n) {
        const float s = sv[n * 1024 + kq * 256 + kb + u];
        acc[n].x += s * w[u].x; acc[n].y += s * w[u].y; acc[n].z += s * w[u].z; acc[n].w += s * w[u].w;
      }
    }
  }
#pragma unroll
  for (int n = 0; n < 5; ++n) red[(kq * 5 + n) * 64 + cl] = acc[n];
  __syncthreads();
  for (int idx = tid; idx < 320; idx += 256) {
    const int n = idx >> 6, c2 = idx & 63;
    float4 s = red[(0 * 5 + n) * 64 + c2];
#pragma unroll
    for (int q = 1; q < 4; ++q) {
      const float4 t = red[(q * 5 + n) * 64 + c2];
      s.x += t.x; s.y += t.y; s.z += t.z; s.w += t.w;
    }
    const int cc = cgp * 256 + c2 * 4;
    const float4 b = *(const float4*)(p.ada_b + (size_t)l * 9216 + cc);
    s.x += b.x; s.y += b.y; s.z += b.z; s.w += b.w;
    *(float4*)(p.MOD + (size_t)(l * 5 + n) * 9216 + cc) = s;
  }
  __syncthreads();
}

__device__ __forceinline__ void modulate_input_phase(const Params& p) {
  const int tid_ = otid(); const int lane = tid_ & 63, w = tid_ >> 6;
  for (int row = obid() * 4 + w; row < NT; row += gridDim.x * 4) {
    const float* xr = row < NPR ? p.x_prompt + (size_t)row * DM : p.x_sample + (size_t)(row - NPR) * DM;
    const int mi = mod_index(row);
    const float* sh = modp(p, 0, mi, 0);
    const float* sc = modp(p, 0, mi, 1);
#pragma unroll
    for (int i = 0; i < 4; ++i) {
      const int c = lane * 4 + 256 * i;
      const float4 x = *(const float4*)(xr + c);
      const float4 s = *(const float4*)(sc + c);
      const float4 h = *(const float4*)(sh + c);
      uint2 o;
      o.x = pk2(x.x * (1.f + s.x) + h.x, x.y * (1.f + s.y) + h.y);
      o.y = pk2(x.z * (1.f + s.z) + h.z, x.w * (1.f + s.w) + h.w);
      *(uint2*)(p.Hb + (size_t)row * DM + c) = o;
    }
  }
}

__device__ __forceinline__ void ln_phase(const Params& p, const float* g, const float* b, bool write_h, int nl, int nj) {
  const int tid_ = otid(); const int lane = tid_ & 63, w = tid_ >> 6;
  float* X = p.out;
  float4 gg[4], bb[4];
#pragma unroll
  for (int i = 0; i < 4; ++i) { gg[i] = *(const float4*)(g + lane * 4 + 256 * i); bb[i] = *(const float4*)(b + lane * 4 + 256 * i); }
  for (int row0 = (obid() * 4 + w) * 2; row0 < NT; row0 += gridDim.x * 8) {
    float4 v[2][4], s4[4], h4[4];
#pragma unroll
    for (int r = 0; r < 2; ++r)
#pragma unroll
      for (int i = 0; i < 4; ++i) v[r][i] = *(const float4*)(p.Z + (size_t)(row0 + r) * DM + lane * 4 + 256 * i);
    const int mi = mod_index(row0);
    const float* sh = modp(p, nl, mi, 3 * nj);
    const float* sc = modp(p, nl, mi, 3 * nj + 1);
    if (write_h) {
#pragma unroll
      for (int i = 0; i < 4; ++i) { s4[i] = *(const float4*)(sc + lane * 4 + 256 * i); h4[i] = *(const float4*)(sh + lane * 4 + 256 * i); }
    }
    float s0 = 0.f, s1 = 0.f;
#pragma unroll
    for (int i = 0; i < 4; ++i) {
      s0 += (v[0][i].x + v[0][i].y) + (v[0][i].z + v[0][i].w);
      s1 += (v[1][i].x + v[1][i].y) + (v[1][i].z + v[1][i].w);
    }
#pragma unroll
    for (int o = 32; o > 0; o >>= 1) { s0 += __shfl_xor(s0, o); s1 += __shfl_xor(s1, o); }
    const float mu0 = s0 * (1.f / 1024.f), mu1 = s1 * (1.f / 1024.f);
    float q0 = 0.f, q1 = 0.f;
#pragma unroll
    for (int i = 0; i < 4; ++i) {
      v[0][i].x -= mu0; v[0][i].y -= mu0; v[0][i].z -= mu0; v[0][i].w -= mu0;
      v[1][i].x -= mu1; v[1][i].y -= mu1; v[1][i].z -= mu1; v[1][i].w -= mu1;
      q0 += (v[0][i].x * v[0][i].x + v[0][i].y * v[0][i].y) + (v[0][i].z * v[0][i].z + v[0][i].w * v[0][i].w);
      q1 += (v[1][i].x * v[1][i].x + v[1][i].y * v[1][i].y) + (v[1][i].z * v[1][i].z + v[1][i].w * v[1][i].w);
    }
#pragma unroll
    for (int o = 32; o > 0; o >>= 1) { q0 += __shfl_xor(q0, o); q1 += __shfl_xor(q1, o); }
    const float rs[2] = {rsqrtf(q0 * (1.f / 1024.f) + 1e-5f), rsqrtf(q1 * (1.f / 1024.f) + 1e-5f)};
#pragma unroll
    for (int r = 0; r < 2; ++r)
#pragma unroll
      for (int i = 0; i < 4; ++i) {
        const int c = lane * 4 + 256 * i;
        float4 y;
        y.x = v[r][i].x * rs[r] * gg[i].x + bb[i].x; y.y = v[r][i].y * rs[r] * gg[i].y + bb[i].y;
        y.z = v[r][i].z * rs[r] * gg[i].z + bb[i].z; y.w = v[r][i].w * rs[r] * gg[i].w + bb[i].w;
        *(float4*)(X + (size_t)(row0 + r) * DM + c) = y;
        if (write_h) {
          uint2 o;
          o.x = pk2(y.x * (1.f + s4[i].x) + h4[i].x, y.y * (1.f + s4[i].y) + h4[i].y);
          o.y = pk2(y.z * (1.f + s4[i].z) + h4[i].z, y.w * (1.f + s4[i].w) + h4[i].w);
          *(uint2*)(p.Hb + (size_t)(row0 + r) * DM + c) = o;
        }
      }
  }
}

__device__ __forceinline__ void stage_acc(const f32x16 (&acc)[2][2], float* sA, int wr, int wc, int lane) {
#pragma unroll
  for (int mi = 0; mi < 2; ++mi)
#pragma unroll
    for (int ni = 0; ni < 2; ++ni)
#pragma unroll
      for (int r = 0; r < 16; ++r) {
        const int row = wr * 64 + mi * 32 + (r & 3) + 8 * (r >> 2) + 4 * (lane >> 5), col = wc * 64 + ni * 32 + (lane & 31);
        sA[row * 132 + col] = acc[mi][ni][r];
      }
}
struct EpiSwiglu {
  bf16_t* G;
  __device__ __forceinline__ void operator()(const f32x16 (&acc)[2][2], char* smem, int row0, int col0, int wr, int wc, int lane, int tid) const {
    float* sA = (float*)smem;
#pragma unroll
    for (int mi = 0; mi < 2; ++mi)
#pragma unroll
      for (int r = 0; r < 16; ++r) {
        const int row = wr * 64 + mi * 32 + (r & 3) + 8 * (r >> 2) + 4 * (lane >> 5);
        const float a = acc[mi][0][r], bb = acc[mi][1][r];
        sA[row * 68 + wc * 32 + (lane & 31)] = a * sigmoidf_(a) * bb;
      }
    __syncthreads();
    const int n0 = (col0 >> 7) * 64;
#pragma unroll
    for (int i = 0; i < 4; ++i) {
      const int idx = tid + i * 256, row = idx >> 3, c8 = (idx & 7) * 8;
      const float4 v0 = *(const float4*)(sA + row * 68 + c8), v1 = *(const float4*)(sA + row * 68 + c8 + 4);
      uint4 o; o.x = pk2(v0.x, v0.y); o.y = pk2(v0.z, v0.w); o.z = pk2(v1.x, v1.y); o.w = pk2(v1.z, v1.w);
      *(uint4*)(G + (size_t)(row0 + row) * DFF + n0 + c8) = o;
    }
    __syncthreads();
  }
};
template <int NI>
struct EpiResid {
  float* Z; const float* r0; const float* r1; const float* gate_base; float gs;
  __device__ __forceinline__ void operator()(const f32x16 (&acc)[2][NI], char* smem, int row0, int col0, int wr, int wc, int lane, int tid) const {
    float* sA = (float*)smem;
    stage_acc(acc, sA, wr, wc, lane);
    __syncthreads();
    const float* gate = gate_base + (size_t)mod_index(row0) * 9 * DM;
    const float* rbase = (row0 < NPR) ? r0 : r1 - (size_t)NPR * DM;
    const int c4 = (tid & 31) * 4;
    float4 gv = *(const float4*)(gate + col0 + c4);
    gv.x *= gs; gv.y *= gs; gv.z *= gs; gv.w *= gs;
#pragma unroll
    for (int i = 0; i < 16; ++i) {
      const int row = (tid >> 5) + i * 8;
      const float4 a = *(const float4*)(sA + row * 132 + c4);
      const size_t o = (size_t)(row0 + row) * DM + col0 + c4;
      const float4 x = *(const float4*)(rbase + o);
      float4 z;
      z.x = ALPHA_F * x.x + gv.x * a.x; z.y = ALPHA_F * x.y + gv.y * a.y; z.z = ALPHA_F * x.z + gv.z * a.z; z.w = ALPHA_F * x.w + gv.w * a.w;
      *(float4*)(Z + o) = z;
    }
    __syncthreads();
  }
};
struct EpiStoreBf16 {
  bf16_t* P; int ld;
  __device__ __forceinline__ void operator()(const f32x16 (&acc)[2][2], char* smem, int row0, int col0, int wr, int wc, int lane, int tid) const {
    float* sA = (float*)smem;
    stage_acc(acc, sA, wr, wc, lane);
    __syncthreads();
#pragma unroll
    for (int i = 0; i < 8; ++i) {
      const int idx = tid + i * 256, row = idx >> 4, c8 = (idx & 15) * 8;
      const float4 v0 = *(const float4*)(sA + row * 132 + c8), v1 = *(const float4*)(sA + row * 132 + c8 + 4);
      uint4 o; o.x = pk2(v0.x, v0.y); o.y = pk2(v0.z, v0.w); o.z = pk2(v1.x, v1.y); o.w = pk2(v1.z, v1.w);
      *(uint4*)(P + (size_t)(row0 + row) * ld + col0 + c8) = o;
    }
    __syncthreads();
  }
};

#define LAS __attribute__((address_space(3)))
template <int NI, class Epi>
__device__ __forceinline__ void gemm_tile(const bf16_t* __restrict__ A, int lda, const bf16_t* __restrict__ Bt, int ldb,
                                          int K, int row0, int col0, const Epi& epi, char* smem) {
  static_assert(NI == 2, "LDS-DMA tile is 128 x 128");
  constexpr int STAGE_B = 32768;
  const int tid = otid(), lane = tid & 63, w = tid >> 6, wr = w >> 1, wc = w & 1, h = lane >> 5;
  LAS char* lds = (LAS char*)smem;
  const int lrow = lane >> 3;
  const int c0 = (lane & 7) ^ (lane >> 4), c1 = (lane & 7) ^ (4 + (lane >> 4));
  const bf16_t* Ag[4];
  const bf16_t* Bg[4];
#pragma unroll
  for (int i = 0; i < 4; ++i) {
    const int row = (w * 4 + i) * 8 + lrow, c = (i & 1) ? c1 : c0;
    Ag[i] = A + (size_t)(row0 + row) * lda + c * 8;
    Bg[i] = Bt + (size_t)(col0 + row) * ldb + c * 8;
  }
#define GEMM_STAGE(buf_, k0_)                                                                                              \
  {                                                                                                                        \
    _Pragma("unroll") for (int i = 0; i < 4; ++i) {                                                                        \
      __builtin_amdgcn_global_load_lds((const __attribute__((address_space(1))) unsigned*)(Ag[i] + (k0_)),                 \
                                       (LAS unsigned*)(lds + (buf_) * STAGE_B + (w * 4 + i) * 1024), 16, 0, 0);            \
      __builtin_amdgcn_global_load_lds((const __attribute__((address_space(1))) unsigned*)(Bg[i] + (k0_)),                 \
                                       (LAS unsigned*)(lds + (buf_) * STAGE_B + 16384 + (w * 4 + i) * 1024), 16, 0, 0);    \
    }                                                                                                                      \
  }
  f32x16 acc[2][NI];
#pragma unroll
  for (int mi = 0; mi < 2; ++mi)
#pragma unroll
    for (int ni = 0; ni < NI; ++ni)
#pragma unroll
      for (int r = 0; r < 16; ++r) acc[mi][ni][r] = 0.f;
  const int nk = K >> 6;
  GEMM_STAGE(0, 0);
  __syncthreads();
  const int sw = ((lane & 31) >> 1) & 7;
  const int aoff = (wr * 64 + (lane & 31)) * 128;
  const int boff = 16384 + (wc * 64 + (lane & 31)) * 128;
  for (int kt = 0; kt < nk; ++kt) {
    const int cur = kt & 1;
    if (kt + 1 < nk) GEMM_STAGE(cur ^ 1, (kt + 1) * 64);
    LAS const char* sc = lds + cur * STAGE_B;
#pragma unroll
    for (int kk = 0; kk < 4; ++kk) {
      const int co = ((kk * 2 + h) ^ sw) * 16;
      s16x8 af[2], bfr[NI];
#pragma unroll
      for (int mi = 0; mi < 2; ++mi) af[mi] = *(LAS const s16x8*)(sc + aoff + mi * 4096 + co);
#pragma unroll
      for (int ni = 0; ni < NI; ++ni) bfr[ni] = *(LAS const s16x8*)(sc + boff + ni * 4096 + co);
#pragma unroll
      for (int mi = 0; mi < 2; ++mi)
#pragma unroll
        for (int ni = 0; ni < NI; ++ni)
          acc[mi][ni] = __builtin_amdgcn_mfma_f32_32x32x16_bf16(af[mi], bfr[ni], acc[mi][ni], 0, 0, 0);
    }
    __syncthreads();
  }
#undef GEMM_STAGE
  epi(acc, smem, row0, col0, wr, wc, lane, tid);
}

template <int NI, class Epi>
__device__ __forceinline__ void gemm_phase(const bf16_t* A, int lda, const bf16_t* Bt, int ldb, int N, int K, const Epi& epi, char* smem) {
  constexpr int BN = NI * 64;
  const int nMt = NT / 128, nNt = N / BN, T = nMt * nNt;
  for (int t = obid(); t < T; t += gridDim.x) {
    const int s = (t & 7) * (T >> 3) + (t >> 3);
    const int grp = s / (8 * nNt), r = s % (8 * nNt);
    const int mt = grp * 8 + (r & 7), nt = r >> 3;
    gemm_tile<NI, Epi>(A, lda, Bt, ldb, K, mt * 128, nt * BN, epi, smem);
  }
}

__device__ __forceinline__ void prep_vectors(const Params& p, int odd) {
  const int tid_ = otid(); const int lane = tid_ & 63, w = tid_ >> 6;
  const bf16_t* P = p.R1;
  const int ldp = odd ? LDPO : LDPE;
  const int qcol = odd ? 2560 : 0, kcol = odd ? 3072 : 512;
  float* outk = p.out + (size_t)NT * DM + (odd ? (size_t)(524288 * 2 + 2097152 + 16384 + 128 + 2097152) : 0);
  const float qn = odd ? p.d_q_norm[lane] : 1.f, kn = odd ? p.d_k_norm[lane] : 1.f;
  const int i16 = lane & 15;
  const float inv = exp2f(-(float)i16 * (13.287712379549449f / 16.f));
  for (int row = obid() * 4 + w; row < NT; row += gridDim.x * 4) {
    const bf16_t* pr_ = P + (size_t)row * ldp;
    float v[10];
#pragma unroll
    for (int hv = 0; hv < 8; ++hv) v[hv] = bf2f(pr_[qcol + hv * 64 + lane]);
#pragma unroll
    for (int hv = 0; hv < 2; ++hv) v[8 + hv] = bf2f(pr_[kcol + hv * 64 + lane]);
    if (odd) {
#pragma unroll
      for (int hv = 0; hv < 10; ++hv) {
        const float ms = wave_sum(v[hv] * v[hv]) * (1.f / 64.f);
        v[hv] = v[hv] * rsqrtf(ms + 1e-6f) * (hv < 8 ? qn : kn);
      }
    }
    if (row < NPR) {
      outk[(size_t)row * 128 + lane] = v[8];
      outk[(size_t)row * 128 + 64 + lane] = v[9];
    } else {
      const int t = (row - NPR) & 2047;
      const float pos = (lane < 32) ? (float)(t >> 6) : (float)(t & 63);
      const float ang = pos * inv;
      const float cs = __cosf(ang), sn = __sinf(ang);
#pragma unroll
      for (int hv = 0; hv < 10; ++hv) {
        const float pr = __shfl_xor(v[hv], 16);
        v[hv] = ((lane & 16) == 0) ? (v[hv] * cs - pr * sn) : (pr * sn + v[hv] * cs);
      }
    }
#pragma unroll
    for (int hv = 0; hv < 8; ++hv) p.Qb[(size_t)row * 512 + hv * 64 + lane] = f2bf(v[hv] * (0.125f * LOG2E));
#pragma unroll
    for (int hv = 0; hv < 2; ++hv) p.Kb[(size_t)row * 128 + hv * 64 + lane] = f2bf(v[8 + hv]);
  }
}

__device__ __forceinline__ void prep_v(const Params& p, int odd, char* smem) {
  bf16_t* sT = (bf16_t*)smem;
  const bf16_t* P = p.R1;
  const int ldp = odd ? LDPO : LDPE;
  const int vcol = odd ? 3200 : 640;
  const float* cv = odd ? p.cache_d_v : p.cache_a_v;
  const float* ck = odd ? p.cache_d_k : p.cache_a_k;
  float* outv = p.out + (size_t)NT * DM + (odd ? (size_t)(524288 * 2 + 2097152 + 16384 + 128 + 2097152 + 524288) : (size_t)524288);
  const int tid = otid();
  const int nitems = 192 * 2 + 64 + 64;
  for (int it = obid(); it < nitems; it += gridDim.x) {
    if (it < 448) {
      bf16_t* dst; int dstride;
      if (it < 384) {
        const int tb = it >> 1, kv = it & 1, row0 = tb * 64;
#pragma unroll
        for (int i = 0; i < 16; ++i) {
          const int r = (tid >> 6) + 4 * i, d = tid & 63;
          const bf16_t raw = P[(size_t)(row0 + r) * ldp + vcol + kv * 64 + d];
          sT[d * 72 + r] = raw;
          if (row0 < NPR) outv[(size_t)(row0 + r) * 128 + kv * 64 + d] = bf2f(raw);
        }
        if (row0 < NPR) { const int b = row0 >> 8, pos0 = row0 & 255; dst = p.Vt + (size_t)((b * 2 + kv) * 64) * 256 + pos0; dstride = 256; }
        else { const int rr = row0 - NPR, b = rr >> 11, pos0 = rr & 2047; dst = p.Vt + 524288 + (size_t)((b * 2 + kv) * 64) * 2048 + pos0; dstride = 2048; }
      } else {
        const int j = it - 384, b = j >> 4, kv = (j >> 3) & 1, kb = j & 7;
#pragma unroll
        for (int i = 0; i < 16; ++i) {
          const int r = (tid >> 6) + 4 * i, d = tid & 63;
          sT[d * 72 + r] = f2bf(cv[((size_t)(b * 512 + kb * 64 + r) * 2 + kv) * 64 + d]);
        }
        dst = p.Vct + (size_t)((b * 2 + kv) * 64) * 512 + kb * 64; dstride = 512;
      }
      __syncthreads();
#pragma unroll
      for (int i = 0; i < 2; ++i) {
        const int id = tid + i * 256, d = id >> 3, ch = id & 7;
        *(uint4*)(dst + (size_t)d * dstride + ch * 8) = *(const uint4*)(sT + d * 72 + ch * 8);
      }
      __syncthreads();
    } else {
      const int j = it - 448;
#pragma unroll
      for (int i = 0; i < 16; ++i) {
        const int idx = j * 4096 + i * 256 + tid;
        p.Kc[idx] = f2bf(ck[idx]);
      }
    }
  }
}

__device__ __forceinline__ void attn_item(const Params& p, int odd, int item, char* smem) {
  bf16_t* Ks = (bf16_t*)smem;
  bf16_t* Vs = Ks + 64 * 72;
  const int tid = otid(), lane = tid & 63, g = tid >> 6, ql = lane & 31, h = lane >> 5;
  int b, kv, qb, L, seq_row0; bool sample;
  if (item < 512) { sample = true; b = item >> 7; kv = (item >> 6) & 1; qb = item & 63; L = 2048; seq_row0 = NPR + b * 2048; }
  else { const int it = item - 512; sample = false; b = it >> 4; kv = (it >> 3) & 1; qb = it & 7; L = 256; seq_row0 = b * 256; }
  const int t0 = qb * 32, q_row0 = seq_row0 + t0;
  const bf16_t* vbase = sample ? p.Vt + 524288 + (size_t)((b * 2 + kv) * 64) * 2048 : p.Vt + (size_t)((b * 2 + kv) * 64) * 256;
  const bf16_t* kbase = p.Kb + (size_t)seq_row0 * 128 + kv * 64;
  const bf16_t* kcb = p.Kc + (size_t)b * 512 * 128 + kv * 64;
  const bf16_t* vcb = p.Vct + (size_t)((b * 2 + kv) * 64) * 512;
  const bool band = sample && !odd;
  int lo = 0, hi = L >> 6;
  if (band) { lo = (t0 - 128) < 0 ? 0 : ((t0 - 128) >> 6); hi = (t0 + 160 + 63) >> 6; if (hi > 32) hi = 32; }
  const int nloc = hi - lo, ntiles = nloc + (sample ? 8 : 0);
  const int hq = kv * 4 + g;
  s16x8 qf[4];
#pragma unroll
  for (int kk = 0; kk < 4; ++kk) qf[kk] = *(const s16x8*)(p.Qb + (size_t)(q_row0 + ql) * 512 + hq * 64 + kk * 16 + h * 8);
  float m = -1e30f, lsum = 0.f;
  if (!odd) { m = p.a_sink[kv * 4 + g] * LOG2E; lsum = (h == 0) ? 1.f : 0.f; }
  f32x16 o0, o1;
#pragma unroll
  for (int r = 0; r < 16; ++r) { o0[r] = 0.f; o1[r] = 0.f; }
  u32x4 kr0, kr1, vr0, vr1;
  const int lr = tid >> 3, lch = tid & 7;
#define ATT_GL(ti_)                                                                                   \
  {                                                                                                   \
    const int ti__ = (ti_);                                                                           \
    const bf16_t* kp_; const bf16_t* vp_; size_t vst_;                                                \
    if (ti__ < nloc) { const int kt_ = lo + ti__; kp_ = kbase + (size_t)(kt_ * 64 + lr) * 128 + lch * 8; vp_ = vbase + (size_t)lr * L + kt_ * 64 + lch * 8; vst_ = (size_t)L; } \
    else { const int c_ = ti__ - nloc; kp_ = kcb + (size_t)(c_ * 64 + lr) * 128 + lch * 8; vp_ = vcb + (size_t)lr * 512 + c_ * 64 + lch * 8; vst_ = 512; } \
    kr0 = gload16(kp_); kr1 = gload16(kp_ + 32 * 128);                                                \
    vr0 = gload16(vp_); vr1 = gload16(vp_ + 32 * vst_);                                               \
  }
  ATT_GL(0);
  for (int ti = 0; ti < ntiles; ++ti) {
    vm_wait4(kr0, kr1, vr0, vr1);
    *(u32x4*)(Ks + lr * 72 + lch * 8) = kr0;
    *(u32x4*)(Ks + (lr + 32) * 72 + lch * 8) = kr1;
    *(u32x4*)(Vs + lr * 72 + lch * 8) = vr0;
    *(u32x4*)(Vs + (lr + 32) * 72 + lch * 8) = vr1;
    __syncthreads();
    if (ti + 1 < ntiles) ATT_GL(ti + 1);
    __builtin_amdgcn_sched_barrier(0);
    f32x16 s0, s1;
#pragma unroll
    for (int r = 0; r < 16; ++r) { s0[r] = 0.f; s1[r] = 0.f; }
#pragma unroll
    for (int kk = 0; kk < 4; ++kk) {
      const s16x8 a0 = *(const s16x8*)(Ks + ql * 72 + kk * 16 + h * 8);
      const s16x8 a1 = *(const s16x8*)(Ks + (32 + ql) * 72 + kk * 16 + h * 8);
      s0 = __builtin_amdgcn_mfma_f32_32x32x16_bf16(a0, qf[kk], s0, 0, 0, 0);
      s1 = __builtin_amdgcn_mfma_f32_32x32x16_bf16(a1, qf[kk], s1, 0, 0, 0);
    }
    if (band && ti < nloc) {
      const int kbase_pos = (lo + ti) * 64 + 4 * h - (t0 + ql);
#pragma unroll
      for (int r = 0; r < 16; ++r) {
        const int dlt = kbase_pos + (r & 3) + 8 * (r >> 2);
        if (dlt > 128 || dlt < -128) s0[r] = -1e30f;
        const int dl2 = dlt + 32;
        if (dl2 > 128 || dl2 < -128) s1[r] = -1e30f;
      }
    }
    float mx = -1e30f;
#pragma unroll
    for (int r = 0; r < 16; ++r) mx = fmaxf(mx, fmaxf(s0[r], s1[r]));
    mx = fmaxf(mx, __shfl_xor(mx, 32));
    const float mnew = fmaxf(m, mx);
    const float alpha = __builtin_amdgcn_exp2f(m - mnew);
    m = mnew;
    float ps = 0.f;
#pragma unroll
    for (int r = 0; r < 16; ++r) {
      s0[r] = __builtin_amdgcn_exp2f(s0[r] - mnew);
      s1[r] = __builtin_amdgcn_exp2f(s1[r] - mnew);
      ps += s0[r] + s1[r];
    }
    lsum = lsum * alpha + ps;
#pragma unroll
    for (int r = 0; r < 16; ++r) { o0[r] *= alpha; o1[r] *= alpha; }
#pragma unroll
    for (int ks = 0; ks < 4; ++ks) {
      const int kbk = ks >> 1, sp = ks & 1;
      s16x8 pf;
#pragma unroll
      for (int j = 0; j < 8; ++j) pf[j] = (short)f2bf(kbk == 0 ? s0[8 * sp + j] : s1[8 * sp + j]);
      const int keyoff = kbk * 32 + 16 * sp + 4 * h;
#pragma unroll
      for (int db = 0; db < 2; ++db) {
        const bf16_t* vp = Vs + (db * 32 + ql) * 72 + keyoff;
        const s16x4 lo4 = *(const s16x4*)(vp);
        const s16x4 hi4 = *(const s16x4*)(vp + 8);
        s16x8 vf;
        vf[0] = lo4[0]; vf[1] = lo4[1]; vf[2] = lo4[2]; vf[3] = lo4[3];
        vf[4] = hi4[0]; vf[5] = hi4[1]; vf[6] = hi4[2]; vf[7] = hi4[3];
        if (db == 0) o0 = __builtin_amdgcn_mfma_f32_32x32x16_bf16(vf, pf, o0, 0, 0, 0);
        else o1 = __builtin_amdgcn_mfma_f32_32x32x16_bf16(vf, pf, o1, 0, 0, 0);
      }
    }
    __syncthreads();
  }
  const float ltot = lsum + __shfl_xor(lsum, 32);
  const float inv = 1.f / ltot;
  bf16_t* cat = p.Hb + (size_t)(q_row0 + ql) * DM + (odd ? 512 : 0) + hq * 64;
#pragma unroll
  for (int rg = 0; rg < 4; ++rg) {
    uint2 w0, w1;
    w0.x = pk2(o0[rg * 4 + 0] * inv, o0[rg * 4 + 1] * inv); w0.y = pk2(o0[rg * 4 + 2] * inv, o0[rg * 4 + 3] * inv);
    w1.x = pk2(o1[rg * 4 + 0] * inv, o1[rg * 4 + 1] * inv); w1.y = pk2(o1[rg * 4 + 2] * inv, o1[rg * 4 + 3] * inv);
    *(uint2*)(cat + 8 * rg + 4 * h) = w0;
    *(uint2*)(cat + 32 + 8 * rg + 4 * h) = w1;
  }
}

__device__ __forceinline__ void mlstm_item(const Params& p, int item, char* smem) {
  bf16_t* sQ = (bf16_t*)smem;
  bf16_t* sK = sQ + 64 * 136;
  bf16_t* sKt = sK + 64 * 136;
  bf16_t* sVt = sKt + 128 * 72;
  bf16_t* sW = sVt + 32 * 72;
  bf16_t* sCt = sW + 64 * 72;
  float* sU = (float*)(sCt + 32 * 136);
  float* sM = sU + 64;
  float* sA = sM + 64;
  float* sWs = sA + 64;
  float* sCl = sWs + 64;
  float* sMisc = sCl + 64;
  const bf16_t* P = p.R1;
  const int ldp = LDPE;
  const float kscale = 0.08838834764831845f;
  const int tid = otid(), lane = tid & 63, w = tid >> 6, l15 = lane & 15, kg = lane >> 4;
  bool sample; int b, head, dir, slice, L, seq_row0;
  if (item < 160) { sample = true; const int s5 = item / 5; slice = item % 5; b = s5 >> 3; head = (s5 >> 1) & 3; dir = s5 & 1; L = 2048; seq_row0 = NPR + b * 2048; }
  else { const int it = item - 160; sample = false; const int s5 = it / 5; slice = it % 5; b = s5 >> 3; head = (s5 >> 1) & 3; dir = s5 & 1; L = 256; seq_row0 = b * 256; }
  const bool nsl = (slice == 4);
  const int nch = L >> 6;
  float m = 0.f;
  f32x4 cacc[2][2];
#pragma unroll
  for (int rb = 0; rb < 2; ++rb)
#pragma unroll
    for (int nb = 0; nb < 2; ++nb)
#pragma unroll
      for (int r = 0; r < 4; ++r) cacc[rb][nb][r] = 0.f;
  if (sample) {
    const size_t sidx = (size_t)((b * 2 + dir) * 4 + head);
    m = p.state_b_m[sidx];
#pragma unroll
    for (int rb = 0; rb < 2; ++rb)
#pragma unroll
      for (int nb = 0; nb < 2; ++nb)
#pragma unroll
        for (int r = 0; r < 4; ++r) {
          const int d = 32 * w + rb * 16 + 4 * kg + r, e = nb * 16 + l15;
          float v;
          if (!nsl) v = p.state_b_C[(sidx * 128 + d) * 128 + slice * 32 + e];
          else v = (e == 0) ? p.state_b_n[sidx * 128 + d] : 0.f;
          cacc[rb][nb][r] = v;
        }
  }
#pragma unroll
  for (int rb = 0; rb < 2; ++rb)
#pragma unroll
    for (int nb = 0; nb < 2; ++nb) {
      uint2 o; o.x = pk2(cacc[rb][nb][0], cacc[rb][nb][1]); o.y = pk2(cacc[rb][nb][2], cacc[rb][nb][3]);
      *(uint2*)(sCt + (nb * 16 + l15) * 136 + 32 * w + rb * 16 + 4 * kg) = o;
    }
  const float bias_i = p.b_gate_bias[(2 * dir) * 4 + head], bias_f = p.b_gate_bias[(2 * dir + 1) * 4 + head];
  float* NUM = p.Z + (size_t)dir * NT * 512;
  u32x4 pq[4], pk[4], pv;
  unsigned pgi, pgf;
#define ML_ISSUE(cc_)                                                                                         \
  {                                                                                                           \
    const int c__ = (cc_);                                                                                    \
    {                                                                                                         \
      const int pos_ = dir ? (L - 1 - (c__ * 64 + lane)) : (c__ * 64 + lane);                                 \
      const bf16_t* gp_ = P + (size_t)(seq_row0 + pos_) * ldp + 2304;                                         \
      pgi = gload2(gp_ + (2 * dir) * 4 + head);                                                               \
      pgf = gload2(gp_ + (2 * dir + 1) * 4 + head);                                                           \
    }                                                                                                         \
    _Pragma("unroll") for (int i = 0; i < 4; ++i) {                                                           \
      const int r_ = tid & 63, ch_ = (tid >> 6) + 4 * i;                                                      \
      const int pos_ = dir ? (L - 1 - (c__ * 64 + r_)) : (c__ * 64 + r_);                                     \
      const bf16_t* rp_ = P + (size_t)(seq_row0 + pos_) * ldp + head * 128 + ch_ * 8;                         \
      pq[i] = gload16(rp_ + 768);                                                                             \
      pk[i] = gload16(rp_ + 1280);                                                                            \
    }                                                                                                         \
    if (!nsl) {                                                                                               \
      const int r_ = tid & 63, ch_ = tid >> 6;                                                                \
      const int pos_ = dir ? (L - 1 - (c__ * 64 + r_)) : (c__ * 64 + r_);                                     \
      pv = gload16(P + (size_t)(seq_row0 + pos_) * ldp + 1792 + head * 128 + slice * 32 + ch_ * 8);          \
    }                                                                                                         \
  }
  pv = (u32x4){0u, 0u, 0u, 0u};
  ML_ISSUE(0);
  for (int c = 0; c < nch; ++c) {
    asm volatile("s_waitcnt vmcnt(0)" : "+v"(pgi), "+v"(pgf), "+v"(pq[0]), "+v"(pq[1]), "+v"(pq[2]), "+v"(pq[3]), "+v"(pk[0]), "+v"(pk[1]), "+v"(pk[2]), "+v"(pk[3]), "+v"(pv) : : "memory");
    {
      const float ig = bf2f((bf16_t)pgi) + bias_i;
      const float fr = bf2f((bf16_t)pgf) + bias_f;
      const float lf = fminf(fr, 0.f) - __logf(1.f + __expf(-fabsf(fr)));
      float bc = lf;
#pragma unroll
      for (int o = 1; o < 64; o <<= 1) { const float y = __shfl_up(bc, o); if (lane >= o) bc += y; }
      const float u = ig - bc;
      float pm = u;
#pragma unroll
      for (int o = 1; o < 64; o <<= 1) { const float y = __shfl_up(pm, o); if (lane >= o) pm = fmaxf(pm, y); }
      const float M = fmaxf(m, pm);
      const float Mlast = __shfl(M, 63), bclast = __shfl(bc, 63);
      if (w == 0) {
        sU[lane] = u; sM[lane] = M; sA[lane] = __expf(m - M);
        sWs[lane] = __expf(u - Mlast) * kscale;
        sCl[lane] = __expf(-(bc + M));
        if (lane == 0) { sMisc[0] = bclast + Mlast; sMisc[1] = __expf(m - Mlast); }
      }
    }
    __syncthreads();
#pragma unroll
    for (int i = 0; i < 4; ++i) {
      const int r = tid & 63, ch = (tid >> 6) + 4 * i;
      *(u32x4*)(sQ + r * 136 + ch * 8) = pq[i];
      *(u32x4*)(sK + r * 136 + ch * 8) = pk[i];
      const float ws = sWs[r];
#pragma unroll
      for (int j = 0; j < 4; ++j) {
        sKt[(ch * 8 + 2 * j) * 72 + r] = f2bf(bf2f((bf16_t)(pk[i][j] & 0xffffu)) * ws);
        sKt[(ch * 8 + 2 * j + 1) * 72 + r] = f2bf(bf2f((bf16_t)(pk[i][j] >> 16)) * ws);
      }
    }
    {
      const int r = tid & 63, ch = tid >> 6;
      if (!nsl) {
#pragma unroll
        for (int j = 0; j < 4; ++j) {
          sVt[(ch * 8 + 2 * j) * 72 + r] = (bf16_t)(pv[j] & 0xffffu);
          sVt[(ch * 8 + 2 * j + 1) * 72 + r] = (bf16_t)(pv[j] >> 16);
        }
      } else {
#pragma unroll
        for (int j = 0; j < 8; ++j) sVt[(ch * 8 + j) * 72 + r] = (ch == 0 && j == 0) ? (bf16_t)0x3F80 : (bf16_t)0;
      }
    }
    __builtin_amdgcn_sched_barrier(0);
    if (c + 1 < nch) ML_ISSUE(c + 1);
    __builtin_amdgcn_sched_barrier(0);
    __syncthreads();
    {
      const int wr = w >> 1, wc = w & 1, h = lane >> 5, l31 = lane & 31;
      f32x16 sacc;
#pragma unroll
      for (int r = 0; r < 16; ++r) sacc[r] = 0.f;
      if (!(wr == 0 && wc == 1)) {
#pragma unroll
        for (int kk = 0; kk < 8; ++kk) {
          const s16x8 a = *(const s16x8*)(sQ + (wr * 32 + l31) * 136 + kk * 16 + h * 8);
          const s16x8 bb = *(const s16x8*)(sK + (wc * 32 + l31) * 136 + kk * 16 + h * 8);
          sacc = __builtin_amdgcn_mfma_f32_32x32x16_bf16(a, bb, sacc, 0, 0, 0);
        }
      }
      const int s = wc * 32 + l31;
      const float us = sU[s];
#pragma unroll
      for (int r = 0; r < 16; ++r) {
        const int t = wr * 32 + (r & 3) + 8 * (r >> 2) + 4 * h;
        const float wv = (s <= t) ? __expf(us - sM[t]) * sacc[r] * kscale : 0.f;
        sW[t * 72 + s] = f2bf(wv);
      }
    }
    __syncthreads();
    {
      f32x4 a1[2], a2[2];
#pragma unroll
      for (int nb = 0; nb < 2; ++nb)
#pragma unroll
        for (int r = 0; r < 4; ++r) { a1[nb][r] = 0.f; a2[nb][r] = 0.f; }
#pragma unroll
      for (int kk = 0; kk < 4; ++kk) {
        const s16x8 a = *(const s16x8*)(sQ + (16 * w + l15) * 136 + kk * 32 + kg * 8);
#pragma unroll
        for (int nb = 0; nb < 2; ++nb) {
          const s16x8 bb = *(const s16x8*)(sCt + (nb * 16 + l15) * 136 + kk * 32 + kg * 8);
          a1[nb] = mfma16_safe(a, bb, a1[nb]);
        }
      }
#pragma unroll
      for (int kk = 0; kk < 2; ++kk) {
        const s16x8 a = *(const s16x8*)(sW + (16 * w + l15) * 72 + kk * 32 + kg * 8);
#pragma unroll
        for (int nb = 0; nb < 2; ++nb) {
          const s16x8 bb = *(const s16x8*)(sVt + (nb * 16 + l15) * 72 + kk * 32 + kg * 8);
          a2[nb] = mfma16_safe(a, bb, a2[nb]);
        }
      }
#pragma unroll
      for (int r = 0; r < 4; ++r) {
        const int t = 16 * w + 4 * kg + r;
        const int pos = dir ? (L - 1 - (c * 64 + t)) : (c * 64 + t);
        const size_t row = (size_t)(seq_row0 + pos);
        const float at = sA[t];
#pragma unroll
        for (int nb = 0; nb < 2; ++nb) {
          const float val = at * a1[nb][r] + a2[nb][r];
          const int e = nb * 16 + l15;
          if (!nsl) NUM[row * 512 + head * 128 + slice * 32 + e] = val;
          else if (e == 0) { p.DEN[((size_t)dir * NT + row) * 4 + head] = val; p.CL[((size_t)dir * NT + row) * 4 + head] = sCl[t]; }
        }
      }
      const float decay = sMisc[1];
#pragma unroll
      for (int rb = 0; rb < 2; ++rb)
#pragma unroll
        for (int nb = 0; nb < 2; ++nb)
#pragma unroll
          for (int r = 0; r < 4; ++r) cacc[rb][nb][r] *= decay;
#pragma unroll
      for (int kk = 0; kk < 2; ++kk)
#pragma unroll
        for (int rb = 0; rb < 2; ++rb) {
          const s16x8 a = *(const s16x8*)(sKt + (32 * w + rb * 16 + l15) * 72 + kk * 32 + kg * 8);
#pragma unroll
          for (int nb = 0; nb < 2; ++nb) {
            const s16x8 bb = *(const s16x8*)(sVt + (nb * 16 + l15) * 72 + kk * 32 + kg * 8);
            cacc[rb][nb] = mfma16_safe(a, bb, cacc[rb][nb]);
          }
        }
      m = sMisc[0];
    }
    __syncthreads();
#pragma unroll
    for (int rb = 0; rb < 2; ++rb)
#pragma unroll
      for (int nb = 0; nb < 2; ++nb) {
        uint2 o; o.x = pk2(cacc[rb][nb][0], cacc[rb][nb][1]); o.y = pk2(cacc[rb][nb][2], cacc[rb][nb][3]);
        *(uint2*)(sCt + (nb * 16 + l15) * 136 + 32 * w + rb * 16 + 4 * kg) = o;
      }
  }
  if (!sample) {
    float* oC = p.out + (size_t)NT * DM + 524288 * 2;
    float* oN = oC + 2097152;
    float* oM = oN + 16384;
    const size_t sidx = (size_t)((b * 2 + dir) * 4 + head);
#pragma unroll
    for (int rb = 0; rb < 2; ++rb)
#pragma unroll
      for (int nb = 0; nb < 2; ++nb)
#pragma unroll
        for (int r = 0; r < 4; ++r) {
          const int d = 32 * w + rb * 16 + 4 * kg + r, e = nb * 16 + l15;
          if (!nsl) oC[(sidx * 128 + d) * 128 + slice * 32 + e] = cacc[rb][nb][r];
          else if (e == 0) oN[sidx * 128 + d] = cacc[rb][nb][r];
        }
    if (nsl && tid == 0) oM[sidx] = m;
  }
  __syncthreads();
}

__device__ __forceinline__ void hgrn_pre(const Params& p, char* smem) {
  float* sTot = (float*)smem;
  const bf16_t* P = p.R1;
  const int ldp = LDPO;
  const int tid = otid(), d = tid & 127, half = tid >> 7;
  for (int it = obid(); it < 3072; it += gridDim.x) {
    const int dir = it / 1536, rem = it % 1536, gc = rem >> 2, head = rem & 3;
    const float lbv = 1.f / (1.f + __expf(p.c_lb_logits[head * 128 + d] - p.c_lb_logits[512 + head * 128 + d]));
    const int fcol = (dir ? 1024 : 512) + head * 128 + d;
    float Al[16], qv[16], kvv[16];
    float run = 0.f;
#pragma unroll
    for (int tt = 0; tt < 16; ++tt) {
      const int t = half * 16 + tt;
      const bf16_t* rp = P + (size_t)(gc * 32 + (dir ? 31 - t : t)) * ldp;
      const float fp = bf2f(rp[fcol]);
      const float cq = bf2f(rp[head * 128 + d]);
      const float f = lbv + (1.f - lbv) * sigmoidf_(fp);
      run += __logf(f);
      Al[tt] = run; kvv[tt] = 1.f - f; qv[tt] = cq * sigmoidf_(cq);
    }
    sTot[half * 128 + d] = run;
    __syncthreads();
    const float tot0 = sTot[d], tot1 = sTot[128 + d];
    const float Atot = tot0 + tot1, off = half ? tot0 : 0.f;
    const size_t base = (size_t)((dir * 384 + gc) * 4 + head) * 4096;
    bf16_t* hk = (dir ? p.HK1 : p.HK0) + (size_t)(gc * 4 + head) * 4096;
    unsigned kt[8];
#pragma unroll
    for (int tt = 0; tt < 16; ++tt) {
      const int t = half * 16 + tt;
      const float A = Al[tt] + off;
      p.HQ[base + t * 128 + d] = f2bf(qv[tt] * __expf(A - tot0));
      const bf16_t kb = f2bf(kvv[tt] * __expf(tot0 - A));
      hk[t * 128 + d] = kb;
      if (tt & 1) kt[tt >> 1] |= ((unsigned)kb << 16); else kt[tt >> 1] = (unsigned)kb;
    }
    {
      u32x4 w0 = {kt[0], kt[1], kt[2], kt[3]}, w1 = {kt[4], kt[5], kt[6], kt[7]};
      *(u32x4*)(p.HKt + base + d * 32 + half * 16) = w0;
      *(u32x4*)(p.HKt + base + d * 32 + half * 16 + 8) = w1;
    }
    if (half == 0) {
      float* ev = p.EV + (size_t)((dir * 384 + gc) * 4 + head) * 384;
      ev[d] = __expf(tot0); ev[128 + d] = __expf(Atot - tot0); ev[256 + d] = __expf(Atot);
    }
    __syncthreads();
  }
}

__device__ __forceinline__ void hgrn_item(const Params& p, int item, char* smem) {
  bf16_t* sQt = (bf16_t*)smem;
  bf16_t* sKt_ = sQt + 32 * 136;
  bf16_t* sK2t = sKt_ + 32 * 136;
  bf16_t* sVt = sK2t + 128 * 40;
  bf16_t* sAtt = sVt + 32 * 40;
  bf16_t* sSt = sAtt + 32 * 40;
  const bf16_t* P = p.R1;
  const int ldp = LDPO;
  const int tid = otid(), lane = tid & 63, w = tid >> 6, l15 = lane & 15, kg = lane >> 4;
  bool sample; int b, head, dir, slice, L, seq_row0;
  if (item < 128) { sample = true; const int s4 = item >> 2; slice = item & 3; b = s4 >> 3; head = (s4 >> 1) & 3; dir = s4 & 1; L = 2048; seq_row0 = NPR + b * 2048; }
  else { const int it = item - 128; sample = false; const int s4 = it >> 2; slice = it & 3; b = s4 >> 3; head = (s4 >> 1) & 3; dir = s4 & 1; L = 256; seq_row0 = b * 256; }
  const int nch = L >> 5, gc0 = seq_row0 >> 5;
  const bf16_t* HKd = dir ? p.HK1 : p.HK0;
  f32x4 sacc[2][2];
#pragma unroll
  for (int rb = 0; rb < 2; ++rb)
#pragma unroll
    for (int nb = 0; nb < 2; ++nb)
#pragma unroll
      for (int r = 0; r < 4; ++r) {
        float v = 0.f;
        if (sample) {
          const int dd = 32 * w + rb * 16 + 4 * kg + r, e = nb * 16 + l15;
          v = p.state_c_S[(((size_t)((b * 2 + dir) * 4 + head)) * 128 + dd) * 128 + slice * 32 + e];
        }
        sacc[rb][nb][r] = v;
      }
  float* O = p.Z + (size_t)dir * NT * 512;
  u32x4 rq[2], rk[2], rkt[2], rv, ev[3][2];
  rv = (u32x4){0u, 0u, 0u, 0u};
#define HG_ISSUE(cc_)                                                                                          \
  {                                                                                                            \
    const int gc_ = gc0 + (dir ? nch - 1 - (cc_) : (cc_));                                                     \
    const size_t base_ = (size_t)((dir * 384 + gc_) * 4 + head) * 4096;                                        \
    const size_t kb_ = (size_t)(gc_ * 4 + head) * 4096;                                                        \
    _Pragma("unroll") for (int i = 0; i < 2; ++i) {                                                            \
      const int id_ = tid + i * 256;                                                                           \
      rq[i] = gload16(p.HQ + base_ + id_ * 8);                                                                 \
      rk[i] = gload16(HKd + kb_ + id_ * 8);                                                                    \
      rkt[i] = gload16(p.HKt + base_ + id_ * 8);                                                               \
    }                                                                                                          \
    if (tid < 128) {                                                                                           \
      const int r_ = tid & 31, ch_ = tid >> 5;                                                                 \
      rv = gload16(P + (size_t)(gc_ * 32 + (dir ? 31 - r_ : r_)) * ldp + 1536 + head * 128 + slice * 32 + ch_ * 8); \
    }                                                                                                          \
    const float* evb_ = p.EV + (size_t)((dir * 384 + gc_) * 4 + head) * 384 + 32 * w + 4 * kg;                 \
    _Pragma("unroll") for (int x = 0; x < 3; ++x) {                                                            \
      ev[x][0] = gload16(evb_ + x * 128);                                                                      \
      ev[x][1] = gload16(evb_ + x * 128 + 16);                                                                 \
    }                                                                                                          \
  }
#define HG_WAIT() asm volatile("s_waitcnt vmcnt(0)" : "+v"(rq[0]), "+v"(rq[1]), "+v"(rk[0]), "+v"(rk[1]), "+v"(rkt[0]), "+v"(rkt[1]), "+v"(rv), "+v"(ev[0][0]), "+v"(ev[0][1]), "+v"(ev[1][0]), "+v"(ev[1][1]), "+v"(ev[2][0]), "+v"(ev[2][1]) : : "memory")
  f32x4 curE[2], cure2[2];
#define HG_STAGE()                                                                                             \
  {                                                                                                            \
    _Pragma("unroll") for (int i = 0; i < 2; ++i) {                                                            \
      const int id_ = tid + i * 256;                                                                           \
      *(u32x4*)(sQt + (id_ >> 4) * 136 + (id_ & 15) * 8) = rq[i];                                              \
      *(u32x4*)(sKt_ + (id_ >> 4) * 136 + (id_ & 15) * 8) = rk[i];                                             \
      *(u32x4*)(sK2t + (id_ >> 2) * 40 + (id_ & 3) * 8) = rkt[i];                                              \
    }                                                                                                          \
    if (tid < 128) {                                                                                           \
      const int r_ = tid & 31, ch_ = tid >> 5;                                                                 \
      _Pragma("unroll") for (int j = 0; j < 4; ++j) {                                                          \
        sVt[(ch_ * 8 + 2 * j) * 40 + r_] = (bf16_t)(rv[j] & 0xffffu);                                          \
        sVt[(ch_ * 8 + 2 * j + 1) * 40 + r_] = (bf16_t)(rv[j] >> 16);                                          \
      }                                                                                                        \
    }                                                                                                          \
    _Pragma("unroll") for (int rb = 0; rb < 2; ++rb) {                                                         \
      f32x4 e1_;                                                                                               \
      _Pragma("unroll") for (int r = 0; r < 4; ++r) {                                                          \
        e1_[r] = __uint_as_float(ev[0][rb][r]);                                                                \
        cure2[rb][r] = __uint_as_float(ev[1][rb][r]);                                                          \
        curE[rb][r] = __uint_as_float(ev[2][rb][r]);                                                           \
      }                                                                                                        \
      _Pragma("unroll") for (int nb = 0; nb < 2; ++nb) {                                                       \
        uint2 o_;                                                                                              \
        o_.x = pk2(sacc[rb][nb][0] * e1_[0], sacc[rb][nb][1] * e1_[1]);                                        \
        o_.y = pk2(sacc[rb][nb][2] * e1_[2], sacc[rb][nb][3] * e1_[3]);                                        \
        *(uint2*)(sSt + (nb * 16 + l15) * 136 + 32 * w + rb * 16 + 4 * kg) = o_;                               \
      }                                                                                                        \
    }                                                                                                          \
  }
  HG_ISSUE(0);
  HG_WAIT();
  HG_STAGE();
  __syncthreads();
  const int br = w >> 1, bcn = w & 1;
  for (int c = 0; c < nch; ++c) {
    if (c + 1 < nch) HG_ISSUE(c + 1);
    __builtin_amdgcn_sched_barrier(0);
    {
      f32x4 acc;
#pragma unroll
      for (int r = 0; r < 4; ++r) acc[r] = 0.f;
      if (!(br == 0 && bcn == 1)) {
#pragma unroll
        for (int kk = 0; kk < 4; ++kk) {
          const s16x8 a = *(const s16x8*)(sQt + (br * 16 + l15) * 136 + kk * 32 + kg * 8);
          const s16x8 bb = *(const s16x8*)(sKt_ + (bcn * 16 + l15) * 136 + kk * 32 + kg * 8);
          acc = mfma16_safe(a, bb, acc);
        }
      }
#pragma unroll
      for (int r = 0; r < 4; ++r) {
        const int t = br * 16 + 4 * kg + r, sidx = bcn * 16 + l15;
        sAtt[t * 40 + sidx] = (sidx <= t) ? f2bf(acc[r]) : (bf16_t)0;
      }
    }
    __syncthreads();
    {
      f32x4 oacc;
#pragma unroll
      for (int r = 0; r < 4; ++r) oacc[r] = 0.f;
#pragma unroll
      for (int kk = 0; kk < 4; ++kk) {
        const s16x8 a = *(const s16x8*)(sQt + (br * 16 + l15) * 136 + kk * 32 + kg * 8);
        const s16x8 bb = *(const s16x8*)(sSt + (bcn * 16 + l15) * 136 + kk * 32 + kg * 8);
        oacc = mfma16_safe(a, bb, oacc);
      }
      {
        const s16x8 a = *(const s16x8*)(sAtt + (br * 16 + l15) * 40 + kg * 8);
        const s16x8 bb = *(const s16x8*)(sVt + (bcn * 16 + l15) * 40 + kg * 8);
        oacc = mfma16_safe(a, bb, oacc);
      }
      const int gc = gc0 + (dir ? nch - 1 - c : c);
#pragma unroll
      for (int r = 0; r < 4; ++r) {
        const int t = br * 16 + 4 * kg + r, e = bcn * 16 + l15;
        O[(size_t)(gc * 32 + (dir ? 31 - t : t)) * 512 + head * 128 + slice * 32 + e] = oacc[r];
      }
#pragma unroll
      for (int rb = 0; rb < 2; ++rb) {
        const s16x8 a = *(const s16x8*)(sK2t + (32 * w + rb * 16 + l15) * 40 + kg * 8);
#pragma unroll
        for (int nb = 0; nb < 2; ++nb) {
          const s16x8 bb = *(const s16x8*)(sVt + (nb * 16 + l15) * 40 + kg * 8);
          f32x4 ds;
#pragma unroll
          for (int r = 0; r < 4; ++r) ds[r] = 0.f;
          ds = mfma16_safe(a, bb, ds);
#pragma unroll
          for (int r = 0; r < 4; ++r) sacc[rb][nb][r] = curE[rb][r] * sacc[rb][nb][r] + cure2[rb][r] * ds[r];
        }
      }
    }
    __syncthreads();
    if (c + 1 < nch) {
      HG_WAIT();
      HG_STAGE();
    }
    __syncthreads();
  }
  if (!sample) {
    float* oS = p.out + (size_t)NT * DM + 524288 * 2 + 2097152 + 16384 + 128;
#pragma unroll
    for (int rb = 0; rb < 2; ++rb)
#pragma unroll
      for (int nb = 0; nb < 2; ++nb)
#pragma unroll
        for (int r = 0; r < 4; ++r) {
          const int dd = 32 * w + rb * 16 + 4 * kg + r, e = nb * 16 + l15;
          oS[(((size_t)((b * 2 + dir) * 4 + head)) * 128 + dd) * 128 + slice * 32 + e] = sacc[rb][nb][r];
        }
  }
  __syncthreads();
}

__device__ __forceinline__ void combine_phase(const Params& p, int odd) {
  const int tid_ = otid(); const int lane = tid_ & 63, w = tid_ >> 6;
  const bf16_t* P = p.R1;
  const float* N0 = p.Z;
  const float* N1 = p.Z + (size_t)NT * 512;
  const float* gp = odd ? p.c_norm_g : p.b_norm_g;
  float g0[4], g1[4];
#pragma unroll
  for (int hd = 0; hd < 4; ++hd) { g0[hd] = gp[hd * 128 + lane]; g1[hd] = gp[hd * 128 + 64 + lane]; }
  const int ldp = odd ? LDPO : LDPE, gcol = odd ? 2048 : 2320, ocol = odd ? 0 : 512;
  for (int row = obid() * 4 + w; row < NT; row += gridDim.x * 4) {
    float a0[4], a1[4], b0[4], b1[4], gt0[4], gt1[4], i0[4], i1[4];
#pragma unroll
    for (int hd = 0; hd < 4; ++hd) {
      const size_t o = (size_t)row * 512 + hd * 128;
      a0[hd] = N0[o + lane]; a1[hd] = N0[o + 64 + lane]; b0[hd] = N1[o + lane]; b1[hd] = N1[o + 64 + lane];
      gt0[hd] = bf2f(P[(size_t)row * ldp + gcol + hd * 128 + lane]);
      gt1[hd] = bf2f(P[(size_t)row * ldp + gcol + hd * 128 + 64 + lane]);
      i0[hd] = 1.f; i1[hd] = 1.f;
      if (!odd) {
        const float d0 = p.DEN[((size_t)row) * 4 + hd], c0 = p.CL[((size_t)row) * 4 + hd];
        const float d1 = p.DEN[((size_t)NT + row) * 4 + hd], c1 = p.CL[((size_t)NT + row) * 4 + hd];
        i0[hd] = 1.f / fmaxf(fabsf(d0), c0); i1[hd] = 1.f / fmaxf(fabsf(d1), c1);
      }
    }
#pragma unroll
    for (int hd = 0; hd < 4; ++hd) {
      const float h0 = a0[hd] * i0[hd] + b0[hd] * i1[hd];
      const float h1 = a1[hd] * i0[hd] + b1[hd] * i1[hd];
      const float ms = wave_sum(h0 * h0 + h1 * h1) * (1.f / 128.f);
      const float rs = rsqrtf(ms + 1e-6f);
      const float m0 = odd ? gt0[hd] * sigmoidf_(gt0[hd]) : sigmoidf_(gt0[hd]);
      const float m1 = odd ? gt1[hd] * sigmoidf_(gt1[hd]) : sigmoidf_(gt1[hd]);
      p.Hb[(size_t)row * DM + ocol + hd * 128 + lane] = f2bf(m0 * h0 * rs * g0[hd]);
      p.Hb[(size_t)row * DM + ocol + hd * 128 + 64 + lane] = f2bf(m1 * h1 * rs * g1[hd]);
    }
  }
}

__device__ __forceinline__ void my_gsync(unsigned* bar, unsigned& epoch, unsigned nblocks) {
  asm volatile("s_waitcnt vmcnt(0) lgkmcnt(0)" ::: "memory");
  __syncthreads();
  epoch += 1;
  if (threadIdx.x == 0) {
    __builtin_amdgcn_fence(__ATOMIC_RELEASE, "agent");
    asm volatile("s_waitcnt vmcnt(0) lgkmcnt(0)" ::: "memory");
    const unsigned g = blockIdx.x & 31u;
    const unsigned gsize = (nblocks >> 5) + ((g < (nblocks & 31u)) ? 1u : 0u);
    const unsigned old = __hip_atomic_fetch_add(&bar[g * 64], 1u, __ATOMIC_RELAXED, __HIP_MEMORY_SCOPE_AGENT);
    if (old + 1 == epoch * gsize) {
      const unsigned ngroups = nblocks < 32u ? nblocks : 32u;
      const unsigned old2 = __hip_atomic_fetch_add(&bar[32 * 64], 1u, __ATOMIC_RELAXED, __HIP_MEMORY_SCOPE_AGENT);
      if (old2 + 1 == epoch * ngroups) __hip_atomic_store(&bar[33 * 64], epoch, __ATOMIC_RELAXED, __HIP_MEMORY_SCOPE_AGENT);
    }
    while (__hip_atomic_load(&bar[33 * 64], __ATOMIC_RELAXED, __HIP_MEMORY_SCOPE_AGENT) < epoch) __builtin_amdgcn_s_sleep(1);
    __builtin_amdgcn_fence(__ATOMIC_ACQUIRE, "agent");
  }
  __syncthreads();
  __builtin_amdgcn_fence(__ATOMIC_ACQUIRE, "agent");
}
#define XB_XCNT(j) (4096 + 64 * (j))
#define XB_XSUB(j) (5120 + 64 * (j))
#define XB_XGEN(j) (6144 + 64 * (j))
#define XB_TOP 7168
#define XB_TOPGEN 7232
__device__ __forceinline__ unsigned xb_ld(unsigned* q) { return __hip_atomic_load(q, __ATOMIC_RELAXED, __HIP_MEMORY_SCOPE_AGENT); }
__device__ __forceinline__ unsigned xb_add(unsigned* q) { return __hip_atomic_fetch_add(q, 1u, __ATOMIC_RELAXED, __HIP_MEMORY_SCOPE_AGENT); }
__device__ __forceinline__ void xb_st(unsigned* q, unsigned v) { __hip_atomic_store(q, v, __ATOMIC_RELAXED, __HIP_MEMORY_SCOPE_AGENT); }
__device__ __forceinline__ void xsync(unsigned* bar, unsigned& epoch, unsigned xcc, unsigned cntx, unsigned nxcc) {
  asm volatile("s_waitcnt vmcnt(0) lgkmcnt(0)" ::: "memory");
  __syncthreads();
  epoch += 1;
  if (threadIdx.x == 0) {
    const unsigned old = xb_add(&bar[XB_XSUB(xcc)]);
    if (old + 1 == epoch * cntx) {
      __builtin_amdgcn_fence(__ATOMIC_RELEASE, "agent");
      asm volatile("s_waitcnt vmcnt(0) lgkmcnt(0)" ::: "memory");
      const unsigned old2 = xb_add(&bar[XB_TOP]);
      if (old2 + 1 == epoch * nxcc) xb_st(&bar[XB_TOPGEN], epoch);
      else while (xb_ld(&bar[XB_TOPGEN]) < epoch) __builtin_amdgcn_s_sleep(1);
      xb_st(&bar[XB_XGEN(xcc)], epoch);
    } else {
      while (xb_ld(&bar[XB_XGEN(xcc)]) < epoch) __builtin_amdgcn_s_sleep(1);
    }
    __builtin_amdgcn_fence(__ATOMIC_ACQUIRE, "agent");
    asm volatile("s_waitcnt vmcnt(0) lgkmcnt(0)" ::: "memory");
  }
  __syncthreads();
}
#define GSYNC() xsync(p.bar, xepoch, xcc, cntx, nxcc)
__global__ void __launch_bounds__(256, 2) fwd_megakernel(Params p) {
  cg::grid_group grid = cg::this_grid();
  __shared__ __attribute__((aligned(16))) char smem[LDS_BYTES];
  const int G = gridDim.x;
  unsigned epoch = 0, xepoch = 0;
  if (p.njobs < 0) grid.sync();
  const unsigned xcc = (unsigned)__builtin_amdgcn_s_getreg((3 << 11) | 20) & 0xFu;
  if (threadIdx.x == 0) xb_add(&p.bar[XB_XCNT(xcc)]);
  my_gsync(p.bar, epoch, (unsigned)gridDim.x);
  const unsigned cntx = xb_ld(&p.bar[XB_XCNT(xcc)]);
  unsigned nxcc = 0;
#pragma unroll
  for (int jx = 0; jx < 16; ++jx) nxcc += (xb_ld(&p.bar[XB_XCNT(jx)]) != 0u) ? 1u : 0u;

  {
    const int nmod = 72, b_ = obid();
    if (G > 2 * nmod) {
      if (b_ < nmod) mod_item(p, b_, smem);
      else {
        for (int t = b_ - nmod; t < p.conv_tiles_l0; t += G - nmod) {
          int j = 0;
#pragma unroll 1
          for (int q = 1; q < p.njobs; ++q) if (t >= p.jobs[q].tile0) j = q;
          conv_tile(p.jobs[j], t - p.jobs[j].tile0, smem);
        }
      }
    } else {
      for (int it = b_; it < nmod + p.total_conv_tiles; it += G) {
        if (it < nmod) mod_item(p, it, smem);
        else {
          const int t = it - nmod;
          int j = 0;
#pragma unroll 1
          for (int q = 1; q < p.njobs; ++q) if (t >= p.jobs[q].tile0) j = q;
          conv_tile(p.jobs[j], t - p.jobs[j].tile0, smem);
        }
      }
    }
  }
  GSYNC();
  modulate_input_phase(p);
  GSYNC();

#pragma unroll 1
  for (int l = 0; l < 2; ++l) {
    const int odd = l;
#pragma unroll 1
    for (int j = 0; j < 2; ++j) {
      if (j == 1) {
        {
          EpiStoreBf16 epi{p.R1, odd ? LDPO : LDPE};
          gemm_phase<2, EpiStoreBf16>(p.Hb, DM, odd ? p.WtInO : p.WtInE, DM, odd ? LDPO : LDPE, DM, epi, smem);
        }
        GSYNC();
        prep_vectors(p, odd);
        prep_v(p, odd, smem);
        if (odd) hgrn_pre(p, smem);
        GSYNC();
        {
          const int nlong = odd ? 128 : 160, nshort = odd ? 512 : 640, natt = 768;
          const int b_ = obid();
          if (b_ < nlong && G > nlong) {
            if (!odd) mlstm_item(p, b_, smem); else hgrn_item(p, b_, smem);
          } else {
            const int first = (G > nlong) ? b_ - nlong : b_, stride = (G > nlong) ? G - nlong : G;
            const int lo_it = (G > nlong) ? 0 : -nlong;
            for (int it = first + lo_it; it < natt + nshort; it += stride) {
              if (it < 0) { if (!odd) mlstm_item(p, it + nlong, smem); else hgrn_item(p, it + nlong, smem); }
              else if (it < natt) attn_item(p, odd, it, smem);
              else if (!odd) mlstm_item(p, nlong + (it - natt), smem);
              else hgrn_item(p, nlong + (it - natt), smem);
            }
            if (!odd) {
              const int nx = p.total_conv_tiles - p.conv_tiles_l0;
              for (int x = first; x < nx; x += stride) {
                const int t = p.conv_tiles_l0 + x;
                int jj = 0;
#pragma unroll 1
                for (int q = 1; q < p.njobs; ++q) if (t >= p.jobs[q].tile0) jj = q;
                conv_tile(p.jobs[jj], t - p.jobs[jj].tile0, smem);
              }
            }
          }
        }
        GSYNC();
        combine_phase(p, odd);
        GSYNC();
        {
          EpiResid<2> epi{p.Z, p.out, p.out + (size_t)NPR * DM, modp(p, l, 0, 5), 1.f};
          gemm_phase<2, EpiResid<2>>(p.Hb, DM, odd ? p.WtOutO : p.WtOutE, DM, DM, DM, epi, smem);
        }
        GSYNC();
        ln_phase(p, p.ln_g + (size_t)(l * 3 + 1) * DM, p.ln_b + (size_t)(l * 3 + 1) * DM, true, l, 2);
        GSYNC();
      }
      const int j2 = j * 2;
      {
        EpiSwiglu epi{p.R1};
        gemm_phase<2, EpiSwiglu>(p.Hb, DM, p.Wt13p[l * 2 + j], DM, 5632, DM, epi, smem);
      }
      GSYNC();
      {
        const bool first = (l == 0 && j == 0);
        EpiResid<2> epi{p.Z, first ? p.x_prompt : p.out, first ? p.x_sample : p.out + (size_t)NPR * DM, modp(p, l, 0, 3 * j2 + 2), 0.5f};
        gemm_phase<2, EpiResid<2>>(p.R1, DFF, p.Wt2p[l * 2 + j], DFF, DM, DFF, epi, smem);
      }
      GSYNC();
      {
        const bool last = (l == 1 && j == 1);
        const int nl = (j == 0) ? l : l + 1, nj = (j == 0) ? 1 : 0;
        ln_phase(p, p.ln_g + (size_t)(l * 3 + j2) * DM, p.ln_b + (size_t)(l * 3 + j2) * DM, !last, last ? 0 : nl, last ? 0 : nj);
      }
      GSYNC();
    }
  }
}


template <int PH>
__global__ void __launch_bounds__(256, 2) k_phase(Params p, int l, int j) {
  __shared__ __attribute__((aligned(16))) char smem[LDS_BYTES];
  const int G = gridDim.x;
  const int odd = l;
  if (PH == 0) {
    const int nmod = 72;
    for (int it = obid(); it < nmod + p.total_conv_tiles; it += G) {
      if (it < nmod) mod_item(p, it, smem);
      else {
        const int t = it - nmod;
        int jj = 0;
#pragma unroll 1
        for (int q = 1; q < p.njobs; ++q) if (t >= p.jobs[q].tile0) jj = q;
        conv_tile(p.jobs[jj], t - p.jobs[jj].tile0, smem);
      }
    }
  } else if (PH == 1) {
    modulate_input_phase(p);
  } else if (PH == 2) {
    EpiStoreBf16 epi{p.R1, odd ? LDPO : LDPE};
    gemm_phase<2, EpiStoreBf16>(p.Hb, DM, odd ? p.WtInO : p.WtInE, DM, odd ? LDPO : LDPE, DM, epi, smem);
  } else if (PH == 3) {
    prep_vectors(p, odd);
    prep_v(p, odd, smem);
    if (odd) hgrn_pre(p, smem);
  } else if (PH == 4) {
    for (int it = obid(); it < 160 + 640 + 768; it += G) {
      if (it < 160) mlstm_item(p, it, smem);
      else if (it < 160 + 768) attn_item(p, 0, it - 160, smem);
      else mlstm_item(p, it - 768, smem);
    }
  } else if (PH == 5) {
    for (int it = obid(); it < 128 + 512 + 768; it += G) {
      if (it < 128) hgrn_item(p, it, smem);
      else if (it < 128 + 768) attn_item(p, 1, it - 128, smem);
      else hgrn_item(p, it - 768, smem);
    }
  } else if (PH == 6) {
    combine_phase(p, odd);
  } else if (PH == 7) {
    EpiResid<1> epi{p.Z, p.out, p.out + (size_t)NPR * DM, modp(p, l, 0, 5), 1.f};
    gemm_phase<1, EpiResid<1>>(p.Hb, DM, odd ? p.WtOutO : p.WtOutE, DM, DM, DM, epi, smem);
  } else if (PH == 8) {
    ln_phase(p, p.ln_g + (size_t)(l * 3 + 1) * DM, p.ln_b + (size_t)(l * 3 + 1) * DM, true, l, 2);
  } else if (PH == 9) {
    EpiSwiglu epi{p.R1};
    gemm_phase<2, EpiSwiglu>(p.Hb, DM, p.Wt13p[l * 2 + j], DM, 5632, DM, epi, smem);
  } else if (PH == 10) {
    const int j2 = j * 2;
    const bool first = (l == 0 && j == 0);
    EpiResid<1> epi{p.Z, first ? p.x_prompt : p.out, first ? p.x_sample : p.out + (size_t)NPR * DM, modp(p, l, 0, 3 * j2 + 2), 0.5f};
    gemm_phase<1, EpiResid<1>>(p.R1, DFF, p.Wt2p[l * 2 + j], DFF, DM, DFF, epi, smem);
  } else if (PH == 13) {
    for (size_t i = (size_t)obid() * 256 + otid(); i < (size_t)8192 * 512; i += (size_t)G * 256) p.SAVE[i] = p.Z[i];
  } else if (PH == 14) {
    bool bad = false;
    for (size_t i = (size_t)obid() * 256 + otid(); i < (size_t)8192 * 512; i += (size_t)G * 256) if (__float_as_uint(p.SAVE[i]) != __float_as_uint(p.Z[i])) bad = true;
    if (bad) { volatile int* q = (volatile int*)p.SAVE; while (q[0] != 0x7fffffff) { __builtin_amdgcn_s_sleep(10); } }
  } else if (PH == 11) {
    const int j2 = j * 2;
    const bool last = (l == 1 && j == 1);
    const int nl = (j == 0) ? l : l + 1, nj = (j == 0) ? 1 : 0;
    ln_phase(p, p.ln_g + (size_t)(l * 3 + j2) * DM, p.ln_b + (size_t)(l * 3 + j2) * DM, !last, last ? 0 : nl, last ? 0 : nj);
  }
}
extern "C" void kernel_launch(void* const* d_in, const int* in_sizes, int n_in, void* d_out, int out_size, void* d_ws,
                              size_t ws_size, hipStream_t stream) {
  static Params p;
  memset(&p, 0, sizeof(p));
  const float** ip = (const float**)&p.x_prompt;
  for (int i = 0; i < 30; ++i) ip[i] = (const float*)d_in[i];
  p.out = (float*)d_out;
  char* ws = (char*)d_ws;
  size_t off = 0;
  auto take = [&](size_t bytes) { char* r = ws + off; off += (bytes + 255) & ~(size_t)255; return r; };
  p.bar = (unsigned*)take(32768);
  char* l0_begin = ws + off;
  p.Wt13p[0] = (bf16_t*)take((size_t)5632 * 1024 * 2);
  p.Wt13p[1] = (bf16_t*)take((size_t)5632 * 1024 * 2);
  p.Wt2p[0] = (bf16_t*)take((size_t)1024 * DFF * 2);
  p.Wt2p[1] = (bf16_t*)take((size_t)1024 * DFF * 2);
  p.WtInE = (bf16_t*)take((size_t)LDPE * 1024 * 2);
  p.WtOutE = (bf16_t*)take((size_t)1024 * 1024 * 2);
  char* l0_end = ws + off;
  p.HQ = (bf16_t*)l0_begin;
  p.EV = (float*)(l0_begin + 25165824);
  p.HK0 = (bf16_t*)(l0_begin + 25165824 + 4718592);
  if (l0_begin + 25165824 + 4718592 + 12582912 > l0_end) fprintf(stderr, "layer-0 weight region too small for the HGRN buffers\n");
  p.Wt13p[2] = (bf16_t*)take((size_t)5632 * 1024 * 2);
  p.Wt13p[3] = (bf16_t*)take((size_t)5632 * 1024 * 2);
  p.Wt2p[2] = (bf16_t*)take((size_t)1024 * DFF * 2);
  p.Wt2p[3] = (bf16_t*)take((size_t)1024 * DFF * 2);
  p.WtInO = (bf16_t*)take((size_t)LDPO * 1024 * 2);
  p.WtOutO = (bf16_t*)take((size_t)1024 * 1024 * 2);
  p.HK1 = (bf16_t*)take((size_t)12582912);
  p.HKt = (bf16_t*)take((size_t)25165824);
  p.MOD = (float*)take((size_t)2 * 5 * 9216 * 4);
  p.Hb = (bf16_t*)take((size_t)NT * DM * 2);
  p.R1 = (bf16_t*)take((size_t)NT * LDPO * 2);
  p.Z = (float*)take((size_t)NT * DM * 4);
  p.Qb = (bf16_t*)take((size_t)NT * 512 * 2);
  p.Kb = (bf16_t*)take((size_t)NT * 128 * 2);
  p.Vt = (bf16_t*)take((size_t)(524288 + 1048576) * 2);
  p.Kc = (bf16_t*)take((size_t)262144 * 2);
  p.Vct = (bf16_t*)take((size_t)262144 * 2);
  p.DEN = (float*)take((size_t)2 * NT * 4 * 4);
  p.CL = (float*)take((size_t)2 * NT * 4 * 4);
  if (off > ws_size) fprintf(stderr, "workspace too small: need %zu have %zu\n", off, ws_size);
  int nj = 0, tiles = 0;
  auto add = [&](const float* src, bf16_t* dst, int K, int N, int Npad, int mode) {
    ConvJob& jb = p.jobs[nj++];
    jb.src = src; jb.dst = dst; jb.K = K; jb.N = N; jb.Npad = Npad; jb.mode = mode; jb.tile0 = tiles; jb.pad0 = 0;
    tiles += (K / 64) * (Npad / 64);
  };
  for (int lj = 0; lj < 2; ++lj) {
    add(p.ffn_w1 + (size_t)lj * 1024 * DFF, p.Wt13p[lj], 1024, DFF, DFF, 1);
    add(p.ffn_w3 + (size_t)lj * 1024 * DFF, p.Wt13p[lj], 1024, DFF, DFF, 2);
    add(p.ffn_w2 + (size_t)lj * DFF * 1024, p.Wt2p[lj], DFF, 1024, 1024, 0);
  }
  add(p.w_in_even, p.WtInE, 1024, 2832, LDPE, 0);
  add(p.w_out_even, p.WtOutE, 1024, 1024, 1024, 0);
  p.conv_tiles_l0 = tiles;
  for (int lj = 2; lj < 4; ++lj) {
    add(p.ffn_w1 + (size_t)lj * 1024 * DFF, p.Wt13p[lj], 1024, DFF, DFF, 1);
    add(p.ffn_w3 + (size_t)lj * 1024 * DFF, p.Wt13p[lj], 1024, DFF, DFF, 2);
    add(p.ffn_w2 + (size_t)lj * DFF * 1024, p.Wt2p[lj], DFF, 1024, 1024, 0);
  }
  add(p.w_in_odd, p.WtInO, 1024, LDPO, LDPO, 0);
  add(p.w_out_odd, p.WtOutO, 1024, 1024, 1024, 0);
  p.njobs = nj; p.total_conv_tiles = tiles;
  static int grid_blocks = 0;
  if (!grid_blocks) {
    int dev = 0, cus = 0, per_cu = 0;
    hipGetDevice(&dev);
    hipDeviceGetAttribute(&cus, hipDeviceAttributeMultiprocessorCount, dev);
    hipOccupancyMaxActiveBlocksPerMultiprocessor(&per_cu, fwd_megakernel, 256, 0);
    per_cu = 2;
    grid_blocks = cus * per_cu;
  }
  hipMemsetAsync(p.bar, 0, 32768, stream);
#if MULTI_LAUNCH
  const dim3 g(512), b(256);
  k_phase<0><<<g, b, 0, stream>>>(p, 0, 0);
  k_phase<1><<<g, b, 0, stream>>>(p, 0, 0);
  for (int l = 0; l < 2; ++l)
    for (int j = 0; j < 2; ++j) {
      if (j == 1) {
        k_phase<2><<<g, b, 0, stream>>>(p, l, j);
        k_phase<3><<<g, b, 0, stream>>>(p, l, j);
        if (l == 0) k_phase<4><<<g, b, 0, stream>>>(p, l, j); else k_phase<5><<<g, b, 0, stream>>>(p, l, j);
        k_phase<6><<<g, b, 0, stream>>>(p, l, j);
        k_phase<7><<<g, b, 0, stream>>>(p, l, j);
        k_phase<8><<<g, b, 0, stream>>>(p, l, j);
      }
      k_phase<9><<<g, b, 0, stream>>>(p, l, j);
      k_phase<10><<<g, b, 0, stream>>>(p, l, j);
      k_phase<11><<<g, b, 0, stream>>>(p, l, j);
    }
#else
  void* args[] = {&p};
  hipError_t e = hipLaunchCooperativeKernel((void*)fwd_megakernel, dim3(grid_blocks), dim3(256), args, 0, stream);
  if (e != hipSuccess) fprintf(stderr, "cooperative launch failed: %s (grid %d)\n", hipGetErrorString(e), grid_blocks);
#endif
}
```

```cpp
#define MULTI_LAUNCH 0
#include <hip/hip_runtime.h>
#include <hip/hip_cooperative_groups.h>
#include <cstdint>
#include <cstring>
#include <cstdio>
namespace cg = cooperative_groups;

typedef unsigned short bf16_t;
typedef short s16x8 __attribute__((ext_vector_type(8)));
typedef short s16x4 __attribute__((ext_vector_type(4)));
typedef float f32x4 __attribute__((ext_vector_type(4)));
typedef float f32x16 __attribute__((ext_vector_type(16)));
typedef unsigned u32x4 __attribute__((ext_vector_type(4)));

#define NT 12288
#define NPR 4096
#define DM 1024
#define DFF 2816
#define LDPE 2944
#define LDPO 3328
#define ALPHA_F 1.4142135623730951f
#define LOG2E 1.4426950408889634f
#define LDS_BYTES 77824

struct ConvJob { const float* src; bf16_t* dst; int K, N, Npad, mode, tile0, pad0; };

struct Params {
  const float *x_prompt, *x_sample, *c, *cache_a_k, *cache_a_v, *state_b_C, *state_b_n, *state_b_m, *state_c_S,
      *cache_d_k, *cache_d_v, *c_ctx, *ada_w, *ada_b, *ln_g, *ln_b, *ffn_w1, *ffn_w3, *ffn_w2, *w_in_even,
      *w_out_even, *a_sink, *b_gate_bias, *b_norm_g, *w_in_odd, *w_out_odd, *c_lb_logits, *c_norm_g, *d_q_norm,
      *d_k_norm;
  float* out;
  bf16_t *Wt13p[4], *Wt2p[4], *WtInE, *WtInO, *WtOutE, *WtOutO;
  bf16_t *HQ, *HK0, *HK1, *HKt; float* EV;
  float* MOD;
  bf16_t* Hb;
  bf16_t* R1;
  float* Z;
  bf16_t *Qb, *Kb, *Vt, *Kc, *Vct;
  float *DEN, *CL;
  ConvJob jobs[16];
  int njobs, total_conv_tiles, conv_tiles_l0, pad1;
  float* SAVE;
  unsigned* bar;
};

__device__ __forceinline__ int otid() { int t = threadIdx.x; asm volatile("" : "+v"(t)); return t; }
__device__ __forceinline__ int obid() { int t = blockIdx.x; asm volatile("" : "+s"(t)); return t; }
__device__ __forceinline__ u32x4 gload16(const void* ptr) {
  u32x4 r;
  asm volatile("global_load_dwordx4 %0, %1, off" : "=v"(r) : "v"(ptr) : "memory");
  return r;
}
__device__ __forceinline__ unsigned gload2(const void* ptr) {
  unsigned r;
  asm volatile("global_load_ushort %0, %1, off" : "=v"(r) : "v"(ptr) : "memory");
  return r;
}
__device__ __forceinline__ void vm_wait4(u32x4& a, u32x4& b, u32x4& c, u32x4& d) {
  asm volatile("s_waitcnt vmcnt(0)" : "+v"(a), "+v"(b), "+v"(c), "+v"(d) : : "memory");
}
__device__ __forceinline__ void vm_wait2(u32x4& a, u32x4& b) {
  asm volatile("s_waitcnt vmcnt(0)" : "+v"(a), "+v"(b) : : "memory");
}
__device__ __forceinline__ f32x4 mfma16_safe(s16x8 a, s16x8 b, f32x4 c) {
  asm volatile("s_nop 4\n\tv_mfma_f32_16x16x32_bf16 %0, %1, %2, %0\n\ts_nop 7\n\ts_nop 7" : "+v"(c) : "v"(a), "v"(b));
  return c;
}
__device__ __forceinline__ float bf2f(bf16_t v) { return __uint_as_float(((unsigned)v) << 16); }
__device__ __forceinline__ unsigned pk2(float a, float b) {
  unsigned r;
  asm("v_cvt_pk_bf16_f32 %0, %1, %2" : "=v"(r) : "v"(a), "v"(b));
  return r;
}
__device__ __forceinline__ bf16_t f2bf(float f) { return (bf16_t)(pk2(f, f) & 0xffffu); }
__device__ __forceinline__ float wave_sum(float v) {
#pragma unroll
  for (int o = 32; o > 0; o >>= 1) v += __shfl_xor(v, o);
  return v;
}
__device__ __forceinline__ int mod_index(int row) { return row < NPR ? 0 : 1 + ((row - NPR) >> 11); }
__device__ __forceinline__ const float* modp(const Params& p, int l, int mi, int part) {
  return p.MOD + ((size_t)((l * 5 + mi) * 9 + part)) * DM;
}
__device__ __forceinline__ float sigmoidf_(float x) { return __builtin_amdgcn_rcpf(1.f + __expf(-x)); }

__device__ __forceinline__ void conv_tile(const ConvJob& jb, int t, char* smem) {
  float* sT = (float*)smem;
  const int nkt = jb.K >> 6;
  const int kt = t % nkt, nt = t / nkt;
  const int k0 = kt * 64, n0 = nt * 64;
  const int tid = otid();
#pragma unroll
  for (int i = 0; i < 4; ++i) {
    const int r = (tid >> 4) + 16 * i, c4 = (tid & 15) * 4, n = n0 + c4;
    float4 v = make_float4(0.f, 0.f, 0.f, 0.f);
    if (n < jb.N) v = *(const float4*)(jb.src + (size_t)(k0 + r) * jb.N + n);
    sT[r * 65 + c4 + 0] = v.x; sT[r * 65 + c4 + 1] = v.y; sT[r * 65 + c4 + 2] = v.z; sT[r * 65 + c4 + 3] = v.w;
  }
  __syncthreads();
#pragma unroll
  for (int i = 0; i < 2; ++i) {
    const int id = tid + i * 256, nl = id >> 3, ch = id & 7;
    const int n = n0 + nl;
    int drow = n;
    if (jb.mode == 1) drow = (n >> 5) * 64 + (n & 31);
    else if (jb.mode == 2) drow = (n >> 5) * 64 + 32 + (n & 31);
    uint4 w;
    w.x = pk2(sT[(ch * 8 + 0) * 65 + nl], sT[(ch * 8 + 1) * 65 + nl]);
    w.y = pk2(sT[(ch * 8 + 2) * 65 + nl], sT[(ch * 8 + 3) * 65 + nl]);
    w.z = pk2(sT[(ch * 8 + 4) * 65 + nl], sT[(ch * 8 + 5) * 65 + nl]);
    w.w = pk2(sT[(ch * 8 + 6) * 65 + nl], sT[(ch * 8 + 7) * 65 + nl]);
    if (n < jb.Npad) *(uint4*)(jb.dst + (size_t)drow * jb.K + k0 + ch * 8) = w;
  }
  __syncthreads();
}

__device__ __forceinline__ void mod_item(const Params& p, int item, char* smem) {
  float* sv = (float*)smem;
  float4* red = (float4*)(smem + 20480);
  const int l = item / 36, cgp = item % 36, tid = otid();
  for (int idx = tid; idx < 5120; idx += 256) {
    const int n = idx >> 10, k = idx & 1023;
    const float v = (n == 0) ? p.c_ctx[k] : p.c[(n - 1) * 1024 + k];
    sv[idx] = v * sigmoidf_(v);
  }
  __syncthreads();
  const int kq = tid >> 6, cl = tid & 63, col = cgp * 256 + cl * 4;
  const float* W = p.ada_w + (size_t)l * 1024 * 9216 + col;
  float4 acc[5];
#pragma unroll
  for (int n = 0; n < 5; ++n) acc[n] = make_float4(0.f, 0.f, 0.f, 0.f);
  for (int kb = 0; kb < 256; kb += 8) {
    float4 w[8];
#pragma unroll
    for (int u = 0; u < 8; ++u) w[u] = *(const float4*)(W + (size_t)(kq * 256 + kb + u) * 9216);
#pragma unroll
    for (int u = 0; u < 8; ++u) {
#pragma unroll
      for (int n = 0; n < 5; ++n) {
        const float s = sv[n * 1024 + kq * 256 + kb + u];
        acc[n].x += s * w[u].x; acc[n].y += s * w[u].y; acc[n].z += s * w[u].z; acc[n].w += s * w[u].w;
      }
    }
  }
#pragma unroll
  for (int n = 0; n < 5; ++n) red[(kq * 5 + n) * 64 + cl] = acc[n];
  __syncthreads();
  for (int idx = tid; idx < 320; idx += 256) {
    const int n = idx >> 6, c2 = idx & 63;
    float4 s = red[(0 * 5 + n) * 64 + c2];
#pragma unroll
    for (int q = 1; q < 4; ++q) {
      const float4 t = red[(q * 5 + n) * 64 + c2];
      s.x += t.x; s.y += t.y; s.z += t.z; s.w += t.w;
    }
    const int cc = cgp * 256 + c2 * 4;
    const float4 b = *(const float4*)(p.ada_b + (size_t)l * 9216 + cc);
    s.x += b.x; s.y += b.y; s.z += b.z; s.w += b.w;
    *(float4*)(p.MOD + (size_t)(l * 5 + n) * 9216 + cc) = s;
  }
  __syncthreads();
}

__device__ __forceinline__ void modulate_input_phase(const Params& p) {
  const int tid_ = otid(); const int lane = tid_ & 63, w = tid_ >> 6;
  for (int row = obid() * 4 + w; row < NT; row += gridDim.x * 4) {
    const float* xr = row < NPR ? p.x_prompt + (size_t)row * DM : p.x_sample + (size_t)(row - NPR) * DM;
    const int mi = mod_index(row);
    const float* sh = modp(p, 0, mi, 0);
    const float* sc = modp(p, 0, mi, 1);
#pragma unroll
    for (int i = 0; i < 4; ++i) {
      const int c = lane * 4 + 256 * i;
      const float4 x = *(const float4*)(xr + c);
      const float4 s = *(const float4*)(sc + c);
      const float4 h = *(const float4*)(sh + c);
      uint2 o;
      o.x = pk2(x.x * (1.f + s.x) + h.x, x.y * (1.f + s.y) + h.y);
      o.y = pk2(x.z * (1.f + s.z) + h.z, x.w * (1.f + s.w) + h.w);
      *(uint2*)(p.Hb + (size_t)row * DM + c) = o;
    }
  }
}

__device__ __forceinline__ void ln_phase(const Params& p, const float* g, const float* b, bool write_h, int nl, int nj) {
  const int tid_ = otid(); const int lane = tid_ & 63, w = tid_ >> 6;
  float* X = p.out;
  float4 gg[4], bb[4];
#pragma unroll
  for (int i = 0; i < 4; ++i) { gg[i] = *(const float4*)(g + lane * 4 + 256 * i); bb[i] = *(const float4*)(b + lane * 4 + 256 * i); }
  for (int row0 = (obid() * 4 + w) * 2; row0 < NT; row0 += gridDim.x * 8) {
    float4 v[2][4], s4[4], h4[4];
#pragma unroll
    for (int r = 0; r < 2; ++r)
#pragma unroll
      for (int i = 0; i < 4; ++i) v[r][i] = *(const float4*)(p.Z + (size_t)(row0 + r) * DM + lane * 4 + 256 * i);
    const int mi = mod_index(row0);
    const float* sh = modp(p, nl, mi, 3 * nj);
    const float* sc = modp(p, nl, mi, 3 * nj + 1);
    if (write_h) {
#pragma unroll
      for (int i = 0; i < 4; ++i) { s4[i] = *(const float4*)(sc + lane * 4 + 256 * i); h4[i] = *(const float4*)(sh + lane * 4 + 256 * i); }
    }
    float s0 = 0.f, s1 = 0.f;
#pragma unroll
    for (int i = 0; i < 4; ++i) {
      s0 += (v[0][i].x + v[0][i].y) + (v[0][i].z + v[0][i].w);
      s1 += (v[1][i].x + v[1][i].y) + (v[1][i].z + v[1][i].w);
    }
#pragma unroll
    for (int o = 32; o > 0; o >>= 1) { s0 += __shfl_xor(s0, o); s1 += __shfl_xor(s1, o); }
    const float mu0 = s0 * (1.f / 1024.f), mu1 = s1 * (1.f / 1024.f);
    float q0 = 0.f, q1 = 0.f;
#pragma unroll
    for (int i = 0; i < 4; ++i) {
      v[0][i].x -= mu0; v[0][i].y -= mu0; v[0][i].z -= mu0; v[0][i].w -= mu0;
      v[1][i].x -= mu1; v[1][i].y -= mu1; v[1][i].z -= mu1; v[1][i].w -= mu1;
      q0 += (v[0][i].x * v[0][i].x + v[0][i].y * v[0][i].y) + (v[0][i].z * v[0][i].z + v[0][i].w * v[0][i].w);
      q1 += (v[1][i].x * v[1][i].x + v[1][i].y * v[1][i].y) + (v[1][i].z * v[1][i].z + v[1][i].w * v[1][i].w);
    }
#pragma unroll
    for (int o = 32; o > 0; o >>= 1) { q0 += __shfl_xor(q0, o); q1 += __shfl_xor(q1, o); }
    const float rs[2] = {rsqrtf(q0 * (1.f / 1024.f) + 1e-5f), rsqrtf(q1 * (1.f / 1024.f) + 1e-5f)};
#pragma unroll
    for (int r = 0; r < 2; ++r)
#pragma unroll
      for (int i = 0; i < 4; ++i) {
        const int c = lane * 4 + 256 * i;
        float4 y;
        y.x = v[r][i].x * rs[r] * gg[i].x + bb[i].x; y.y = v[r][i].y * rs[r] * gg[i].y + bb[i].y;
        y.z = v[r][i].z * rs[r] * gg[i].z + bb[i].z; y.w = v[r][i].w * rs[r] * gg[i].w + bb[i].w;
        *(float4*)(X + (size_t)(row0 + r) * DM + c) = y;
        if (write_h) {
          uint2 o;
          o.x = pk2(y.x * (1.f + s4[i].x) + h4[i].x, y.y * (1.f + s4[i].y) + h4[i].y);
          o.y = pk2(y.z * (1.f + s4[i].z) + h4[i].z, y.w * (1.f + s4[i].w) + h4[i].w);
          *(uint2*)(p.Hb + (size_t)(row0 + r) * DM + c) = o;
        }
      }
  }
}

__device__ __forceinline__ void stage_acc(const f32x16 (&acc)[2][2], float* sA, int wr, int wc, int lane) {
#pragma unroll
  for (int mi = 0; mi < 2; ++mi)
#pragma unroll
    for (int ni = 0; ni < 2; ++ni)
#pragma unroll
      for (int r = 0; r < 16; ++r) {
        const int row = wr * 64 + mi * 32 + (r & 3) + 8 * (r >> 2) + 4 * (lane >> 5), col = wc * 64 + ni * 32 + (lane & 31);
        sA[row * 132 + col] = acc[mi][ni][r];
      }
}
struct EpiSwiglu {
  bf16_t* G;
  __device__ __forceinline__ void operator()(const f32x16 (&acc)[2][2], char* smem, int row0, int col0, int wr, int wc, int lane, int tid) const {
    float* sA = (float*)smem;
#pragma unroll
    for (int mi = 0; mi < 2; ++mi)
#pragma unroll
      for (int r = 0; r < 16; ++r) {
        const int row = wr * 64 + mi * 32 + (r & 3) + 8 * (r >> 2) + 4 * (lane >> 5);
        const float a = acc[mi][0][r], bb = acc[mi][1][r];
        sA[row * 68 + wc * 32 + (lane & 31)] = a * sigmoidf_(a) * bb;
      }
    __syncthreads();
    const int n0 = (col0 >> 7) * 64;
#pragma unroll
    for (int i = 0; i < 4; ++i) {
      const int idx = tid + i * 256, row = idx >> 3, c8 = (idx & 7) * 8;
      const float4 v0 = *(const float4*)(sA + row * 68 + c8), v1 = *(const float4*)(sA + row * 68 + c8 + 4);
      uint4 o; o.x = pk2(v0.x, v0.y); o.y = pk2(v0.z, v0.w); o.z = pk2(v1.x, v1.y); o.w = pk2(v1.z, v1.w);
      *(uint4*)(G + (size_t)(row0 + row) * DFF + n0 + c8) = o;
    }
    __syncthreads();
  }
};
template <int NI>
struct EpiResid {
  float* Z; const float* r0; const float* r1; const float* gate_base; float gs;
  __device__ __forceinline__ void operator()(const f32x16 (&acc)[2][NI], char* smem, int row0, int col0, int wr, int wc, int lane, int tid) const {
    float* sA = (float*)smem;
    stage_acc(acc, sA, wr, wc, lane);
    __syncthreads();
    const float* gate = gate_base + (size_t)mod_index(row0) * 9 * DM;
    const float* rbase = (row0 < NPR) ? r0 : r1 - (size_t)NPR * DM;
    const int c4 = (tid & 31) * 4;
    float4 gv = *(const float4*)(gate + col0 + c4);
    gv.x *= gs; gv.y *= gs; gv.z *= gs; gv.w *= gs;
#pragma unroll
    for (int i = 0; i < 16; ++i) {
      const int row = (tid >> 5) + i * 8;
      const float4 a = *(const float4*)(sA + row * 132 + c4);
      const size_t o = (size_t)(row0 + row) * DM + col0 + c4;
      const float4 x = *(const float4*)(rbase + o);
      float4 z;
      z.x = ALPHA_F * x.x + gv.x * a.x; z.y = ALPHA_F * x.y + gv.y * a.y; z.z = ALPHA_F * x.z + gv.z * a.z; z.w = ALPHA_F * x.w + gv.w * a.w;
      *(float4*)(Z + o) = z;
    }
    __syncthreads();
  }
};
struct EpiStoreBf16 {
  bf16_t* P; int ld;
  __device__ __forceinline__ void operator()(const f32x16 (&acc)[2][2], char* smem, int row0, int col0, int wr, int wc, int lane, int tid) const {
    float* sA = (float*)smem;
    stage_acc(acc, sA, wr, wc, lane);
    __syncthreads();
#pragma unroll
    for (int i = 0; i < 8; ++i) {
      const int idx = tid + i * 256, row = idx >> 4, c8 = (idx & 15) * 8;
      const float4 v0 = *(const float4*)(sA + row * 132 + c8), v1 = *(const float4*)(sA + row * 132 + c8 + 4);
      uint4 o; o.x = pk2(v0.x, v0.y); o.y = pk2(v0.z, v0.w); o.z = pk2(v1.x, v1.y); o.w = pk2(v1.z, v1.w);
      *(uint4*)(P + (size_t)(row0 + row) * ld + col0 + c8) = o;
    }
    __syncthreads();
  }
};

#define LAS __attribute__((address_space(3)))
template <int NI, class Epi>
__device__ __forceinline__ void gemm_tile(const bf16_t* __restrict__ A, int lda, const bf16_t* __restrict__ Bt, int ldb,
                                          int K, int row0, int col0, const Epi& epi, char* smem) {
  static_assert(NI == 2, "LDS-DMA tile is 128 x 128");
  constexpr int STAGE_B = 32768;
  const int tid = otid(), lane = tid & 63, w = tid >> 6, wr = w >> 1, wc = w & 1, h = lane >> 5;
  LAS char* lds = (LAS char*)smem;
  const int lrow = lane >> 3;
  const int c0 = (lane & 7) ^ (lane >> 4), c1 = (lane & 7) ^ (4 + (lane >> 4));
  const bf16_t* Ag[4];
  const bf16_t* Bg[4];
#pragma unroll
  for (int i = 0; i < 4; ++i) {
    const int row = (w * 4 + i) * 8 + lrow, c = (i & 1) ? c1 : c0;
    Ag[i] = A + (size_t)(row0 + row) * lda + c * 8;
    Bg[i] = Bt + (size_t)(col0 + row) * ldb + c * 8;
  }
#define GEMM_STAGE(buf_, k0_)                                                                                              \
  {                                                                                                                        \
    _Pragma("unroll") for (int i = 0; i < 4; ++i) {                                                                        \
      __builtin_amdgcn_global_load_lds((const __attribute__((address_space(1))) unsigned*)(Ag[i] + (k0_)),                 \
                                       (LAS unsigned*)(lds + (buf_) * STAGE_B + (w * 4 + i) * 1024), 16, 0, 0);            \
      __builtin_amdgcn_global_load_lds((const __attribute__((address_space(1))) unsigned*)(Bg[i] + (k0_)),                 \
                                       (LAS unsigned*)(lds + (buf_) * STAGE_B + 16384 + (w * 4 + i) * 1024), 16, 0, 0);    \
    }                                                                                                                      \
  }
  f32x16 acc[2][NI];
#pragma unroll
  for (int mi = 0; mi < 2; ++mi)
#pragma unroll
    for (int ni = 0; ni < NI; ++ni)
#pragma unroll
      for (int r = 0; r < 16; ++r) acc[mi][ni][r] = 0.f;
  const int nk = K >> 6;
  GEMM_STAGE(0, 0);
  __syncthreads();
  const int sw = ((lane & 31) >> 1) & 7;
  const int aoff = (wr * 64 + (lane & 31)) * 128;
  const int boff = 16384 + (wc * 64 + (lane & 31)) * 128;
  for (int kt = 0; kt < nk; ++kt) {
    const int cur = kt & 1;
    if (kt + 1 < nk) GEMM_STAGE(cur ^ 1, (kt + 1) * 64);
    LAS const char* sc = lds + cur * STAGE_B;
#pragma unroll
    for (int kk = 0; kk < 4; ++kk) {
      const int co = ((kk * 2 + h) ^ sw) * 16;
      s16x8 af[2], bfr[NI];
#pragma unroll
      for (int mi = 0; mi < 2; ++mi) af[mi] = *(LAS const s16x8*)(sc + aoff + mi * 4096 + co);
#pragma unroll
      for (int ni = 0; ni < NI; ++ni) bfr[ni] = *(LAS const s16x8*)(sc + boff + ni * 4096 + co);
#pragma unroll
      for (int mi = 0; mi < 2; ++mi)
#pragma unroll
        for (int ni = 0; ni < NI; ++ni)
          acc[mi][ni] = __builtin_amdgcn_mfma_f32_32x32x16_bf16(af[mi], bfr[ni], acc[mi][ni], 0, 0, 0);
    }
    __syncthreads();
  }
#undef GEMM_STAGE
  epi(acc, smem, row0, col0, wr, wc, lane, tid);
}

template <int NI, class Epi>
__device__ __forceinline__ void gemm_phase(const bf16_t* A, int lda, const bf16_t* Bt, int ldb, int N, int K, const Epi& epi, char* smem) {
  constexpr int BN = NI * 64;
  const int nMt = NT / 128, nNt = N / BN, T = nMt * nNt;
  for (int t = obid(); t < T; t += gridDim.x) {
    const int s = (t & 7) * (T >> 3) + (t >> 3);
    const int grp = s / (8 * nNt), r = s % (8 * nNt);
    const int mt = grp * 8 + (r & 7), nt = r >> 3;
    gemm_tile<NI, Epi>(A, lda, Bt, ldb, K, mt * 128, nt * BN, epi, smem);
  }
}

__device__ __forceinline__ void prep_vectors(const Params& p, int odd) {
  const int tid_ = otid(); const int lane = tid_ & 63, w = tid_ >> 6;
  const bf16_t* P = p.R1;
  const int ldp = odd ? LDPO : LDPE;
  const int qcol = odd ? 2560 : 0, kcol = odd ? 3072 : 512;
  float* outk = p.out + (size_t)NT * DM + (odd ? (size_t)(524288 * 2 + 2097152 + 16384 + 128 + 2097152) : 0);
  const float qn = odd ? p.d_q_norm[lane] : 1.f, kn = odd ? p.d_k_norm[lane] : 1.f;
  const int i16 = lane & 15;
  const float inv = exp2f(-(float)i16 * (13.287712379549449f / 16.f));
  for (int row = obid() * 4 + w; row < NT; row += gridDim.x * 4) {
    const bf16_t* pr_ = P + (size_t)row * ldp;
    float v[10];
#pragma unroll
    for (int hv = 0; hv < 8; ++hv) v[hv] = bf2f(pr_[qcol + hv * 64 + lane]);
#pragma unroll
    for (int hv = 0; hv < 2; ++hv) v[8 + hv] = bf2f(pr_[kcol + hv * 64 + lane]);
    if (odd) {
#pragma unroll
      for (int hv = 0; hv < 10; ++hv) {
        const float ms = wave_sum(v[hv] * v[hv]) * (1.f / 64.f);
        v[hv] = v[hv] * rsqrtf(ms + 1e-6f) * (hv < 8 ? qn : kn);
      }
    }
    if (row < NPR) {
      outk[(size_t)row * 128 + lane] = v[8];
      outk[(size_t)row * 128 + 64 + lane] = v[9];
    } else {
      const int t = (row - NPR) & 2047;
      const float pos = (lane < 32) ? (float)(t >> 6) : (float)(t & 63);
      const float ang = pos * inv;
      const float cs = __cosf(ang), sn = __sinf(ang);
#pragma unroll
      for (int hv = 0; hv < 10; ++hv) {
        const float pr = __shfl_xor(v[hv], 16);
        v[hv] = ((lane & 16) == 0) ? (v[hv] * cs - pr * sn) : (pr * sn + v[hv] * cs);
      }
    }
#pragma unroll
    for (int hv = 0; hv < 8; ++hv) p.Qb[(size_t)row * 512 + hv * 64 + lane] = f2bf(v[hv] * (0.125f * LOG2E));
#pragma unroll
    for (int hv = 0; hv < 2; ++hv) p.Kb[(size_t)row * 128 + hv * 64 + lane] = f2bf(v[8 + hv]);
  }
}

__device__ __forceinline__ void prep_v(const Params& p, int odd, char* smem) {
  bf16_t* sT = (bf16_t*)smem;
  const bf16_t* P = p.R1;
  const int ldp = odd ? LDPO : LDPE;
  const int vcol = odd ? 3200 : 640;
  const float* cv = odd ? p.cache_d_v : p.cache_a_v;
  const float* ck = odd ? p.cache_d_k : p.cache_a_k;
  float* outv = p.out + (size_t)NT * DM + (odd ? (size_t)(524288 * 2 + 2097152 + 16384 + 128 + 2097152 + 524288) : (size_t)524288);
  const int tid = otid();
  const int nitems = 192 * 2 + 64 + 64;
  for (int it = obid(); it < nitems; it += gridDim.x) {
    if (it < 448) {
      bf16_t* dst; int dstride;
      if (it < 384) {
        const int tb = it >> 1, kv = it & 1, row0 = tb * 64;
#pragma unroll
        for (int i = 0; i < 16; ++i) {
          const int r = (tid >> 6) + 4 * i, d = tid & 63;
          const bf16_t raw = P[(size_t)(row0 + r) * ldp + vcol + kv * 64 + d];
          sT[d * 72 + r] = raw;
          if (row0 < NPR) outv[(size_t)(row0 + r) * 128 + kv * 64 + d] = bf2f(raw);
        }
        if (row0 < NPR) { const int b = row0 >> 8, pos0 = row0 & 255; dst = p.Vt + (size_t)((b * 2 + kv) * 64) * 256 + pos0; dstride = 256; }
        else { const int rr = row0 - NPR, b = rr >> 11, pos0 = rr & 2047; dst = p.Vt + 524288 + (size_t)((b * 2 + kv) * 64) * 2048 + pos0; dstride = 2048; }
      } else {
        const int j = it - 384, b = j >> 4, kv = (j >> 3) & 1, kb = j & 7;
#pragma unroll
        for (int i = 0; i < 16; ++i) {
          const int r = (tid >> 6) + 4 * i, d = tid & 63;
          sT[d * 72 + r] = f2bf(cv[((size_t)(b * 512 + kb * 64 + r) * 2 + kv) * 64 + d]);
        }
        dst = p.Vct + (size_t)((b * 2 + kv) * 64) * 512 + kb * 64; dstride = 512;
      }
      __syncthreads();
#pragma unroll
      for (int i = 0; i < 2; ++i) {
        const int id = tid + i * 256, d = id >> 3, ch = id & 7;
        *(uint4*)(dst + (size_t)d * dstride + ch * 8) = *(const uint4*)(sT + d * 72 + ch * 8);
      }
      __syncthreads();
    } else {
      const int j = it - 448;
#pragma unroll
      for (int i = 0; i < 16; ++i) {
        const int idx = j * 4096 + i * 256 + tid;
        p.Kc[idx] = f2bf(ck[idx]);
      }
    }
  }
}

__device__ __forceinline__ void attn_item(const Params& p, int odd, int item, char* smem) {
  bf16_t* Ks = (bf16_t*)smem;
  bf16_t* Vs = Ks + 64 * 72;
  const int tid = otid(), lane = tid & 63, g = tid >> 6, ql = lane & 31, h = lane >> 5;
  int b, kv, qb, L, seq_row0; bool sample;
  if (item < 512) { sample = true; b = item >> 7; kv = (item >> 6) & 1; qb = item & 63; L = 2048; seq_row0 = NPR + b * 2048; }
  else { const int it = item - 512; sample = false; b = it >> 4; kv = (it >> 3) & 1; qb = it & 7; L = 256; seq_row0 = b * 256; }
  const int t0 = qb * 32, q_row0 = seq_row0 + t0;
  const bf16_t* vbase = sample ? p.Vt + 524288 + (size_t)((b * 2 + kv) * 64) * 2048 : p.Vt + (size_t)((b * 2 + kv) * 64) * 256;
  const bf16_t* kbase = p.Kb + (size_t)seq_row0 * 128 + kv * 64;
  const bf16_t* kcb = p.Kc + (size_t)b * 512 * 128 + kv * 64;
  const bf16_t* vcb = p.Vct + (size_t)((b * 2 + kv) * 64) * 512;
  const bool band = sample && !odd;
  int lo = 0, hi = L >> 6;
  if (band) { lo = (t0 - 128) < 0 ? 0 : ((t0 - 128) >> 6); hi = (t0 + 160 + 63) >> 6; if (hi > 32) hi = 32; }
  const int nloc = hi - lo, ntiles = nloc + (sample ? 8 : 0);
  const int hq = kv * 4 + g;
  s16x8 qf[4];
#pragma unroll
  for (int kk = 0; kk < 4; ++kk) qf[kk] = *(const s16x8*)(p.Qb + (size_t)(q_row0 + ql) * 512 + hq * 64 + kk * 16 + h * 8);
  float m = -1e30f, lsum = 0.f;
  if (!odd) { m = p.a_sink[kv * 4 + g] * LOG2E; lsum = (h == 0) ? 1.f : 0.f; }
  f32x16 o0, o1;
#pragma unroll
  for (int r = 0; r < 16; ++r) { o0[r] = 0.f; o1[r] = 0.f; }
  u32x4 kr0, kr1, vr0, vr1;
  const int lr = tid >> 3, lch = tid & 7;
#define ATT_GL(ti_)                                                                                   \
  {                                                                                                   \
    const int ti__ = (ti_);                                                                           \
    const bf16_t* kp_; const bf16_t* vp_; size_t vst_;                                                \
    if (ti__ < nloc) { const int kt_ = lo + ti__; kp_ = kbase + (size_t)(kt_ * 64 + lr) * 128 + lch * 8; vp_ = vbase + (size_t)lr * L + kt_ * 64 + lch * 8; vst_ = (size_t)L; } \
    else { const int c_ = ti__ - nloc; kp_ = kcb + (size_t)(c_ * 64 + lr) * 128 + lch * 8; vp_ = vcb + (size_t)lr * 512 + c_ * 64 + lch * 8; vst_ = 512; } \
    kr0 = gload16(kp_); kr1 = gload16(kp_ + 32 * 128);                                                \
    vr0 = gload16(vp_); vr1 = gload16(vp_ + 32 * vst_);                                               \
  }
  ATT_GL(0);
  for (int ti = 0; ti < ntiles; ++ti) {
    vm_wait4(kr0, kr1, vr0, vr1);
    *(u32x4*)(Ks + lr * 72 + lch * 8) = kr0;
    *(u32x4*)(Ks + (lr + 32) * 72 + lch * 8) = kr1;
    *(u32x4*)(Vs + lr * 72 + lch * 8) = vr0;
    *(u32x4*)(Vs + (lr + 32) * 72 + lch * 8) = vr1;
    __syncthreads();
    if (ti + 1 < ntiles) ATT_GL(ti + 1);
    __builtin_amdgcn_sched_barrier(0);
    f32x16 s0, s1;
#pragma unroll
    for (int r = 0; r < 16; ++r) { s0[r] = 0.f; s1[r] = 0.f; }
#pragma unroll
    for (int kk = 0; kk < 4; ++kk) {
      const s16x8 a0 = *(const s16x8*)(Ks + ql * 72 + kk * 16 + h * 8);
      const s16x8 a1 = *(const s16x8*)(Ks + (32 + ql) * 72 + kk * 16 + h * 8);
      s0 = __builtin_amdgcn_mfma_f32_32x32x16_bf16(a0, qf[kk], s0, 0, 0, 0);
      s1 = __builtin_amdgcn_mfma_f32_32x32x16_bf16(a1, qf[kk], s1, 0, 0, 0);
    }
    if (band && ti < nloc) {
      const int kbase_pos = (lo + ti) * 64 + 4 * h - (t0 + ql);
#pragma unroll
      for (int r = 0; r < 16; ++r) {
        const int dlt = kbase_pos + (r & 3) + 8 * (r >> 2);
        if (dlt > 128 || dlt < -128) s0[r] = -1e30f;
        const int dl2 = dlt + 32;
        if (dl2 > 128 || dl2 < -128) s1[r] = -1e30f;
      }
    }
    float mx = -1e30f;
#pragma unroll
    for (int r = 0; r < 16; ++r) mx = fmaxf(mx, fmaxf(s0[r], s1[r]));
    mx = fmaxf(mx, __shfl_xor(mx, 32));
    const float mnew = fmaxf(m, mx);
    const float alpha = __builtin_amdgcn_exp2f(m - mnew);
    m = mnew;
    float ps = 0.f;
#pragma unroll
    for (int r = 0; r < 16; ++r) {
      s0[r] = __builtin_amdgcn_exp2f(s0[r] - mnew);
      s1[r] = __builtin_amdgcn_exp2f(s1[r] - mnew);
      ps += s0[r] + s1[r];
    }
    lsum = lsum * alpha + ps;
#pragma unroll
    for (int r = 0; r < 16; ++r) { o0[r] *= alpha; o1[r] *= alpha; }
#pragma unroll
    for (int ks = 0; ks < 4; ++ks) {
      const int kbk = ks >> 1, sp = ks & 1;
      s16x8 pf;
#pragma unroll
      for (int j = 0; j < 8; ++j) pf[j] = (short)f2bf(kbk == 0 ? s0[8 * sp + j] : s1[8 * sp + j]);
      const int keyoff = kbk * 32 + 16 * sp + 4 * h;
#pragma unroll
      for (int db = 0; db < 2; ++db) {
        const bf16_t* vp = Vs + (db * 32 + ql) * 72 + keyoff;
        const s16x4 lo4 = *(const s16x4*)(vp);
        const s16x4 hi4 = *(const s16x4*)(vp + 8);
        s16x8 vf;
        vf[0] = lo4[0]; vf[1] = lo4[1]; vf[2] = lo4[2]; vf[3] = lo4[3];
        vf[4] = hi4[0]; vf[5] = hi4[1]; vf[6] = hi4[2]; vf[7] = hi4[3];
        if (db == 0) o0 = __builtin_amdgcn_mfma_f32_32x32x16_bf16(vf, pf, o0, 0, 0, 0);
        else o1 = __builtin_amdgcn_mfma_f32_32x32x16_bf16(vf, pf, o1, 0, 0, 0);
      }
    }
    __syncthreads();
  }
  const float ltot = lsum + __shfl_xor(lsum, 32);
  const float inv = 1.f / ltot;
  bf16_t* cat = p.Hb + (size_t)(q_row0 + ql) * DM + (odd ? 512 : 0) + hq * 64;
#pragma unroll
  for (int rg = 0; rg < 4; ++rg) {
    uint2 w0, w1;
    w0.x = pk2(o0[rg * 4 + 0] * inv, o0[rg * 4 + 1] * inv); w0.y = pk2(o0[rg * 4 + 2] * inv, o0[rg * 4 + 3] * inv);
    w1.x = pk2(o1[rg * 4 + 0] * inv, o1[rg * 4 + 1] * inv); w1.y = pk2(o1[rg * 4 + 2] * inv, o1[rg * 4 + 3] * inv);
    *(uint2*)(cat + 8 * rg + 4 * h) = w0;
    *(uint2*)(cat + 32 + 8 * rg + 4 * h) = w1;
  }
}

__device__ __forceinline__ void mlstm_item(const Params& p, int item, char* smem) {
  bf16_t* sQ = (bf16_t*)smem;
  bf16_t* sK = sQ + 64 * 136;
  bf16_t* sKt = sK + 64 * 136;
  bf16_t* sVt = sKt + 128 * 72;
  bf16_t* sW = sVt + 32 * 72;
  bf16_t* sCt = sW + 64 * 72;
  float* sU = (float*)(sCt + 32 * 136);
  float* sM = sU + 64;
  float* sA = sM + 64;
  float* sWs = sA + 64;
  float* sCl = sWs + 64;
  float* sMisc = sCl + 64;
  const bf16_t* P = p.R1;
  const int ldp = LDPE;
  const float kscale = 0.08838834764831845f;
  const int tid = otid(), lane = tid & 63, w = tid >> 6, l15 = lane & 15, kg = lane >> 4;
  bool sample; int b, head, dir, slice, L, seq_row0;
  if (item < 160) { sample = true; const int s5 = item / 5; slice = item % 5; b = s5 >> 3; head = (s5 >> 1) & 3; dir = s5 & 1; L = 2048; seq_row0 = NPR + b * 2048; }
  else { const int it = item - 160; sample = false; const int s5 = it / 5; slice = it % 5; b = s5 >> 3; head = (s5 >> 1) & 3; dir = s5 & 1; L = 256; seq_row0 = b * 256; }
  const bool nsl = (slice == 4);
  const int nch = L >> 6;
  float m = 0.f;
  f32x4 cacc[2][2];
#pragma unroll
  for (int rb = 0; rb < 2; ++rb)
#pragma unroll
    for (int nb = 0; nb < 2; ++nb)
#pragma unroll
      for (int r = 0; r < 4; ++r) cacc[rb][nb][r] = 0.f;
  if (sample) {
    const size_t sidx = (size_t)((b * 2 + dir) * 4 + head);
    m = p.state_b_m[sidx];
#pragma unroll
    for (int rb = 0; rb < 2; ++rb)
#pragma unroll
      for (int nb = 0; nb < 2; ++nb)
#pragma unroll
        for (int r = 0; r < 4; ++r) {
          const int d = 32 * w + rb * 16 + 4 * kg + r, e = nb * 16 + l15;
          float v;
          if (!nsl) v = p.state_b_C[(sidx * 128 + d) * 128 + slice * 32 + e];
          else v = (e == 0) ? p.state_b_n[sidx * 128 + d] : 0.f;
          cacc[rb][nb][r] = v;
        }
  }
#pragma unroll
  for (int rb = 0; rb < 2; ++rb)
#pragma unroll
    for (int nb = 0; nb < 2; ++nb) {
      uint2 o; o.x = pk2(cacc[rb][nb][0], cacc[rb][nb][1]); o.y = pk2(cacc[rb][nb][2], cacc[rb][nb][3]);
      *(uint2*)(sCt + (nb * 16 + l15) * 136 + 32 * w + rb * 16 + 4 * kg) = o;
    }
  const float bias_i = p.b_gate_bias[(2 * dir) * 4 + head], bias_f = p.b_gate_bias[(2 * dir + 1) * 4 + head];
  float* NUM = p.Z + (size_t)dir * NT * 512;
  u32x4 pq[4], pk[4], pv;
  unsigned pgi, pgf;
#define ML_ISSUE(cc_)                                                                                         \
  {                                                                                                           \
    const int c__ = (cc_);                                                                                    \
    {                                                                                                         \
      const int pos_ = dir ? (L - 1 - (c__ * 64 + lane)) : (c__ * 64 + lane);                                 \
      const bf16_t* gp_ = P + (size_t)(seq_row0 + pos_) * ldp + 2304;                                         \
      pgi = gload2(gp_ + (2 * dir) * 4 + head);                                                               \
      pgf = gload2(gp_ + (2 * dir + 1) * 4 + head);                                                           \
    }                                                                                                         \
    _Pragma("unroll") for (int i = 0; i < 4; ++i) {                                                           \
      const int r_ = tid & 63, ch_ = (tid >> 6) + 4 * i;                                                      \
      const int pos_ = dir ? (L - 1 - (c__ * 64 + r_)) : (c__ * 64 + r_);                                     \
      const bf16_t* rp_ = P + (size_t)(seq_row0 + pos_) * ldp + head * 128 + ch_ * 8;                         \
      pq[i] = gload16(rp_ + 768);                                                                             \
      pk[i] = gload16(rp_ + 1280);                                                                            \
    }                                                                                                         \
    if (!nsl) {                                                                                               \
      const int r_ = tid & 63, ch_ = tid >> 6;                                                                \
      const int pos_ = dir ? (L - 1 - (c__ * 64 + r_)) : (c__ * 64 + r_);                                     \
      pv = gload16(P + (size_t)(seq_row0 + pos_) * ldp + 1792 + head * 128 + slice * 32 + ch_ * 8);          \
    }                                                                                                         \
  }
  pv = (u32x4){0u, 0u, 0u, 0u};
  ML_ISSUE(0);
  for (int c = 0; c < nch; ++c) {
    asm volatile("s_waitcnt vmcnt(0)" : "+v"(pgi), "+v"(pgf), "+v"(pq[0]), "+v"(pq[1]), "+v"(pq[2]), "+v"(pq[3]), "+v"(pk[0]), "+v"(pk[1]), "+v"(pk[2]), "+v"(pk[3]), "+v"(pv) : : "memory");
    {
      const float ig = bf2f((bf16_t)pgi) + bias_i;
      const float fr = bf2f((bf16_t)pgf) + bias_f;
      const float lf = fminf(fr, 0.f) - __logf(1.f + __expf(-fabsf(fr)));
      float bc = lf;
#pragma unroll
      for (int o = 1; o < 64; o <<= 1) { const float y = __shfl_up(bc, o); if (lane >= o) bc += y; }
      const float u = ig - bc;
      float pm = u;
#pragma unroll
      for (int o = 1; o < 64; o <<= 1) { const float y = __shfl_up(pm, o); if (lane >= o) pm = fmaxf(pm, y); }
      const float M = fmaxf(m, pm);
      const float Mlast = __shfl(M, 63), bclast = __shfl(bc, 63);
      if (w == 0) {
        sU[lane] = u; sM[lane] = M; sA[lane] = __expf(m - M);
        sWs[lane] = __expf(u - Mlast) * kscale;
        sCl[lane] = __expf(-(bc + M));
        if (lane == 0) { sMisc[0] = bclast + Mlast; sMisc[1] = __expf(m - Mlast); }
      }
    }
    __syncthreads();
#pragma unroll
    for (int i = 0; i < 4; ++i) {
      const int r = tid & 63, ch = (tid >> 6) + 4 * i;
      *(u32x4*)(sQ + r * 136 + ch * 8) = pq[i];
      *(u32x4*)(sK + r * 136 + ch * 8) = pk[i];
      const float ws = sWs[r];
#pragma unroll
      for (int j = 0; j < 4; ++j) {
        sKt[(ch * 8 + 2 * j) * 72 + r] = f2bf(bf2f((bf16_t)(pk[i][j] & 0xffffu)) * ws);
        sKt[(ch * 8 + 2 * j + 1) * 72 + r] = f2bf(bf2f((bf16_t)(pk[i][j] >> 16)) * ws);
      }
    }
    {
      const int r = tid & 63, ch = tid >> 6;
      if (!nsl) {
#pragma unroll
        for (int j = 0; j < 4; ++j) {
          sVt[(ch * 8 + 2 * j) * 72 + r] = (bf16_t)(pv[j] & 0xffffu);
          sVt[(ch * 8 + 2 * j + 1) * 72 + r] = (bf16_t)(pv[j] >> 16);
        }
      } else {
#pragma unroll
        for (int j = 0; j < 8; ++j) sVt[(ch * 8 + j) * 72 + r] = (ch == 0 && j == 0) ? (bf16_t)0x3F80 : (bf16_t)0;
      }
    }
    __builtin_amdgcn_sched_barrier(0);
    if (c + 1 < nch) ML_ISSUE(c + 1);
    __builtin_amdgcn_sched_barrier(0);
    __syncthreads();
    {
      const int wr = w >> 1, wc = w & 1, h = lane >> 5, l31 = lane & 31;
      f32x16 sacc;
#pragma unroll
      for (int r = 0; r < 16; ++r) sacc[r] = 0.f;
      if (!(wr == 0 && wc == 1)) {
#pragma unroll
        for (int kk = 0; kk < 8; ++kk) {
          const s16x8 a = *(const s16x8*)(sQ + (wr * 32 + l31) * 136 + kk * 16 + h * 8);
          const s16x8 bb = *(const s16x8*)(sK + (wc * 32 + l31) * 136 + kk * 16 + h * 8);
          sacc = __builtin_amdgcn_mfma_f32_32x32x16_bf16(a, bb, sacc, 0, 0, 0);
        }
      }
      const int s = wc * 32 + l31;
      const float us = sU[s];
#pragma unroll
      for (int r = 0; r < 16; ++r) {
        const int t = wr * 32 + (r & 3) + 8 * (r >> 2) + 4 * h;
        const float wv = (s <= t) ? __expf(us - sM[t]) * sacc[r] * kscale : 0.f;
        sW[t * 72 + s] = f2bf(wv);
      }
    }
    __syncthreads();
    {
      f32x4 a1[2], a2[2];
#pragma unroll
      for (int nb = 0; nb < 2; ++nb)
#pragma unroll
        for (int r = 0; r < 4; ++r) { a1[nb][r] = 0.f; a2[nb][r] = 0.f; }
#pragma unroll
      for (int kk = 0; kk < 4; ++kk) {
        const s16x8 a = *(const s16x8*)(sQ + (16 * w + l15) * 136 + kk * 32 + kg * 8);
#pragma unroll
        for (int nb = 0; nb < 2; ++nb) {
          const s16x8 bb = *(const s16x8*)(sCt + (nb * 16 + l15) * 136 + kk * 32 + kg * 8);
          a1[nb] = mfma16_safe(a, bb, a1[nb]);
        }
      }
#pragma unroll
      for (int kk = 0; kk < 2; ++kk) {
        const s16x8 a = *(const s16x8*)(sW + (16 * w + l15) * 72 + kk * 32 + kg * 8);
#pragma unroll
        for (int nb = 0; nb < 2; ++nb) {
          const s16x8 bb = *(const s16x8*)(sVt + (nb * 16 + l15) * 72 + kk * 32 + kg * 8);
          a2[nb] = mfma16_safe(a, bb, a2[nb]);
        }
      }
#pragma unroll
      for (int r = 0; r < 4; ++r) {
        const int t = 16 * w + 4 * kg + r;
        const int pos = dir ? (L - 1 - (c * 64 + t)) : (c * 64 + t);
        const size_t row = (size_t)(seq_row0 + pos);
        const float at = sA[t];
#pragma unroll
        for (int nb = 0; nb < 2; ++nb) {
          const float val = at * a1[nb][r] + a2[nb][r];
          const int e = nb * 16 + l15;
          if (!nsl) NUM[row * 512 + head * 128 + slice * 32 + e] = val;
          else if (e == 0) { p.DEN[((size_t)dir * NT + row) * 4 + head] = val; p.CL[((size_t)dir * NT + row) * 4 + head] = sCl[t]; }
        }
      }
      const float decay = sMisc[1];
#pragma unroll
      for (int rb = 0; rb < 2; ++rb)
#pragma unroll
        for (int nb = 0; nb < 2; ++nb)
#pragma unroll
          for (int r = 0; r < 4; ++r) cacc[rb][nb][r] *= decay;
#pragma unroll
      for (int kk = 0; kk < 2; ++kk)
#pragma unroll
        for (int rb = 0; rb < 2; ++rb) {
          const s16x8 a = *(const s16x8*)(sKt + (32 * w + rb * 16 + l15) * 72 + kk * 32 + kg * 8);
#pragma unroll
          for (int nb = 0; nb < 2; ++nb) {
            const s16x8 bb = *(const s16x8*)(sVt + (nb * 16 + l15) * 72 + kk * 32 + kg * 8);
            cacc[rb][nb] = mfma16_safe(a, bb, cacc[rb][nb]);
          }
        }
      m = sMisc[0];
    }
    __syncthreads();
#pragma unroll
    for (int rb = 0; rb < 2; ++rb)
#pragma unroll
      for (int nb = 0; nb < 2; ++nb) {
        uint2 o; o.x = pk2(cacc[rb][nb][0], cacc[rb][nb][1]); o.y = pk2(cacc[rb][nb][2], cacc[rb][nb][3]);
        *(uint2*)(sCt + (nb * 16 + l15) * 136 + 32 * w + rb * 16 + 4 * kg) = o;
      }
  }
  if (!sample) {
    float* oC = p.out + (size_t)NT * DM + 524288 * 2;
    float* oN = oC + 2097152;
    float* oM = oN + 16384;
    const size_t sidx = (size_t)((b * 2 + dir) * 4 + head);
#pragma unroll
    for (int rb = 0; rb < 2; ++rb)
#pragma unroll
      for (int nb = 0; nb < 2; ++nb)
#pragma unroll
        for (int r = 0; r < 4; ++r) {
          const int d = 32 * w + rb * 16 + 4 * kg + r, e = nb * 16 + l15;
          if (!nsl) oC[(sidx * 128 + d) * 128 + slice * 32 + e] = cacc[rb][nb][r];
          else if (e == 0) oN[sidx * 128 + d] = cacc[rb][nb][r];
        }
    if (nsl && tid == 0) oM[sidx] = m;
  }
  __syncthreads();
}

__device__ __forceinline__ void hgrn_pre(const Params& p, char* smem) {
  float* sTot = (float*)smem;
  const bf16_t* P = p.R1;
  const int ldp = LDPO;
  const int tid = otid(), d = tid & 127, half = tid >> 7;
  for (int it = obid(); it < 3072; it += gridDim.x) {
    const int dir = it / 1536, rem = it % 1536, gc = rem >> 2, head = rem & 3;
    const float lbv = 1.f / (1.f + __expf(p.c_lb_logits[head * 128 + d] - p.c_lb_logits[512 + head * 128 + d]));
    const int fcol = (dir ? 1024 : 512) + head * 128 + d;
    float Al[16], qv[16], kvv[16];
    float run = 0.f;
#pragma unroll
    for (int tt = 0; tt < 16; ++tt) {
      const int t = half * 16 + tt;
      const bf16_t* rp = P + (size_t)(gc * 32 + (dir ? 31 - t : t)) * ldp;
      const float fp = bf2f(rp[fcol]);
      const float cq = bf2f(rp[head * 128 + d]);
      const float f = lbv + (1.f - lbv) * sigmoidf_(fp);
      run += __logf(f);
      Al[tt] = run; kvv[tt] = 1.f - f; qv[tt] = cq * sigmoidf_(cq);
    }
    sTot[half * 128 + d] = run;
    __syncthreads();
    const float tot0 = sTot[d], tot1 = sTot[128 + d];
    const float Atot = tot0 + tot1, off = half ? tot0 : 0.f;
    const size_t base = (size_t)((dir * 384 + gc) * 4 + head) * 4096;
    bf16_t* hk = (dir ? p.HK1 : p.HK0) + (size_t)(gc * 4 + head) * 4096;
    unsigned kt[8];
#pragma unroll
    for (int tt = 0; tt < 16; ++tt) {
      const int t = half * 16 + tt;
      const float A = Al[tt] + off;
      p.HQ[base + t * 128 + d] = f2bf(qv[tt] * __expf(A - tot0));
      const bf16_t kb = f2bf(kvv[tt] * __expf(tot0 - A));
      hk[t * 128 + d] = kb;
      if (tt & 1) kt[tt >> 1] |= ((unsigned)kb << 16); else kt[tt >> 1] = (unsigned)kb;
    }
    {
      u32x4 w0 = {kt[0], kt[1], kt[2], kt[3]}, w1 = {kt[4], kt[5], kt[6], kt[7]};
      *(u32x4*)(p.HKt + base + d * 32 + half * 16) = w0;
      *(u32x4*)(p.HKt + base + d * 32 + half * 16 + 8) = w1;
    }
    if (half == 0) {
      float* ev = p.EV + (size_t)((dir * 384 + gc) * 4 + head) * 384;
      ev[d] = __expf(tot0); ev[128 + d] = __expf(Atot - tot0); ev[256 + d] = __expf(Atot);
    }
    __syncthreads();
  }
}

__device__ __forceinline__ void hgrn_item(const Params& p, int item, char* smem) {
  bf16_t* sQt = (bf16_t*)smem;
  bf16_t* sKt_ = sQt + 32 * 136;
  bf16_t* sK2t = sKt_ + 32 * 136;
  bf16_t* sVt = sK2t + 128 * 40;
  bf16_t* sAtt = sVt + 32 * 40;
  bf16_t* sSt = sAtt + 32 * 40;
  const bf16_t* P = p.R1;
  const int ldp = LDPO;
  const int tid = otid(), lane = tid & 63, w = tid >> 6, l15 = lane & 15, kg = lane >> 4;
  bool sample; int b, head, dir, slice, L, seq_row0;
  if (item < 128) { sample = true; const int s4 = item >> 2; slice = item & 3; b = s4 >> 3; head = (s4 >> 1) & 3; dir = s4 & 1; L = 2048; seq_row0 = NPR + b * 2048; }
  else { const int it = item - 128; sample = false; const int s4 = it >> 2; slice = it & 3; b = s4 >> 3; head = (s4 >> 1) & 3; dir = s4 & 1; L = 256; seq_row0 = b * 256; }
  const int nch = L >> 5, gc0 = seq_row0 >> 5;
  const bf16_t* HKd = dir ? p.HK1 : p.HK0;
  f32x4 sacc[2][2];
#pragma unroll
  for (int rb = 0; rb < 2; ++rb)
#pragma unroll
    for (int nb = 0; nb < 2; ++nb)
#pragma unroll
      for (int r = 0; r < 4; ++r) {
        float v = 0.f;
        if (sample) {
          const int dd = 32 * w + rb * 16 + 4 * kg + r, e = nb * 16 + l15;
          v = p.state_c_S[(((size_t)((b * 2 + dir) * 4 + head)) * 128 + dd) * 128 + slice * 32 + e];
        }
        sacc[rb][nb][r] = v;
      }
  float* O = p.Z + (size_t)dir * NT * 512;
  u32x4 rq[2], rk[2], rkt[2], rv, ev[3][2];
  rv = (u32x4){0u, 0u, 0u, 0u};
#define HG_ISSUE(cc_)                                                                                          \
  {                                                                                                            \
    const int gc_ = gc0 + (dir ? nch - 1 - (cc_) : (cc_));                                                     \
    const size_t base_ = (size_t)((dir * 384 + gc_) * 4 + head) * 4096;                                        \
    const size_t kb_ = (size_t)(gc_ * 4 + head) * 4096;                                                        \
    _Pragma("unroll") for (int i = 0; i < 2; ++i) {                                                            \
      const int id_ = tid + i * 256;                                                                           \
      rq[i] = gload16(p.HQ + base_ + id_ * 8);                                                                 \
      rk[i] = gload16(HKd + kb_ + id_ * 8);                                                                    \
      rkt[i] = gload16(p.HKt + base_ + id_ * 8);                                                               \
    }                                                                                                          \
    if (tid < 128) {                                                                                           \
      const int r_ = tid & 31, ch_ = tid >> 5;                                                                 \
      rv = gload16(P + (size_t)(gc_ * 32 + (dir ? 31 - r_ : r_)) * ldp + 1536 + head * 128 + slice * 32 + ch_ * 8); \
    }                                                                                                          \
    const float* evb_ = p.EV + (size_t)((dir * 384 + gc_) * 4 + head) * 384 + 32 * w + 4 * kg;                 \
    _Pragma("unroll") for (int x = 0; x < 3; ++x) {                                                            \
      ev[x][0] = gload16(evb_ + x * 128);                                                                      \
      ev[x][1] = gload16(evb_ + x * 128 + 16);                                                                 \
    }                                                                                                          \
  }
#define HG_WAIT() asm volatile("s_waitcnt vmcnt(0)" : "+v"(rq[0]), "+v"(rq[1]), "+v"(rk[0]), "+v"(rk[1]), "+v"(rkt[0]), "+v"(rkt[1]), "+v"(rv), "+v"(ev[0][0]), "+v"(ev[0][1]), "+v"(ev[1][0]), "+v"(ev[1][1]), "+v"(ev[2][0]), "+v"(ev[2][1]) : : "memory")
  f32x4 curE[2], cure2[2];
#define HG_STAGE()                                                                                             \
  {                                                                                                            \
    _Pragma("unroll") for (int i = 0; i < 2; ++i) {                                                            \
      const int id_ = tid + i * 256;                                                                           \
      *(u32x4*)(sQt + (id_ >> 4) * 136 + (id_ & 15) * 8) = rq[i];                                              \
      *(u32x4*)(sKt_ + (id_ >> 4) * 136 + (id_ & 15) * 8) = rk[i];                                             \
      *(u32x4*)(sK2t + (id_ >> 2) * 40 + (id_ & 3) * 8) = rkt[i];                                              \
    }                                                                                                          \
    if (tid < 128) {                                                                                           \
      const int r_ = tid & 31, ch_ = tid >> 5;                                                                 \
      _Pragma("unroll") for (int j = 0; j < 4; ++j) {                                                          \
        sVt[(ch_ * 8 + 2 * j) * 40 + r_] = (bf16_t)(rv[j] & 0xffffu);                                          \
        sVt[(ch_ * 8 + 2 * j + 1) * 40 + r_] = (bf16_t)(rv[j] >> 16);                                          \
      }                                                                                                        \
    }                                                                                                          \
    _Pragma("unroll") for (int rb = 0; rb < 2; ++rb) {                                                         \
      f32x4 e1_;                                                                                               \
      _Pragma("unroll") for (int r = 0; r < 4; ++r) {                                                          \
        e1_[r] = __uint_as_float(ev[0][rb][r]);                                                                \
        cure2[rb][r] = __uint_as_float(ev[1][rb][r]);                                                          \
        curE[rb][r] = __uint_as_float(ev[2][rb][r]);                                                           \
      }                                                                                                        \
      _Pragma("unroll") for (int nb = 0; nb < 2; ++nb) {                                                       \
        uint2 o_;                                                                                              \
        o_.x = pk2(sacc[rb][nb][0] * e1_[0], sacc[rb][nb][1] * e1_[1]);                                        \
        o_.y = pk2(sacc[rb][nb][2] * e1_[2], sacc[rb][nb][3] * e1_[3]);                                        \
        *(uint2*)(sSt + (nb * 16 + l15) * 136 + 32 * w + rb * 16 + 4 * kg) = o_;                               \
      }                                                                                                        \
    }                                                                                                          \
  }
  HG_ISSUE(0);
  HG_WAIT();
  HG_STAGE();
  __syncthreads();
  const int br = w >> 1, bcn = w & 1;
  for (int c = 0; c < nch; ++c) {
    if (c + 1 < nch) HG_ISSUE(c + 1);
    __builtin_amdgcn_sched_barrier(0);
    {
      f32x4 acc;
#pragma unroll
      for (int r = 0; r < 4; ++r) acc[r] = 0.f;
      if (!(br == 0 && bcn == 1)) {
#pragma unroll
        for (int kk = 0; kk < 4; ++kk) {
          const s16x8 a = *(const s16x8*)(sQt + (br * 16 + l15) * 136 + kk * 32 + kg * 8);
          const s16x8 bb = *(const s16x8*)(sKt_ + (bcn * 16 + l15) * 136 + kk * 32 + kg * 8);
          acc = mfma16_safe(a, bb, acc);
        }
      }
#pragma unroll
      for (int r = 0; r < 4; ++r) {
        const int t = br * 16 + 4 * kg + r, sidx = bcn * 16 + l15;
        sAtt[t * 40 + sidx] = (sidx <= t) ? f2bf(acc[r]) : (bf16_t)0;
      }
    }
    __syncthreads();
    {
      f32x4 oacc;
#pragma unroll
      for (int r = 0; r < 4; ++r) oacc[r] = 0.f;
#pragma unroll
      for (int kk = 0; kk < 4; ++kk) {
        const s16x8 a = *(const s16x8*)(sQt + (br * 16 + l15) * 136 + kk * 32 + kg * 8);
        const s16x8 bb = *(const s16x8*)(sSt + (bcn * 16 + l15) * 136 + kk * 32 + kg * 8);
        oacc = mfma16_safe(a, bb, oacc);
      }
      {
        const s16x8 a = *(const s16x8*)(sAtt + (br * 16 + l15) * 40 + kg * 8);
        const s16x8 bb = *(const s16x8*)(sVt + (bcn * 16 + l15) * 40 + kg * 8);
        oacc = mfma16_safe(a, bb, oacc);
      }
      const int gc = gc0 + (dir ? nch - 1 - c : c);
#pragma unroll
      for (int r = 0; r < 4; ++r) {
        const int t = br * 16 + 4 * kg + r, e = bcn * 16 + l15;
        O[(size_t)(gc * 32 + (dir ? 31 - t : t)) * 512 + head * 128 + slice * 32 + e] = oacc[r];
      }
#pragma unroll
      for (int rb = 0; rb < 2; ++rb) {
        const s16x8 a = *(const s16x8*)(sK2t + (32 * w + rb * 16 + l15) * 40 + kg * 8);
#pragma unroll
        for (int nb = 0; nb < 2; ++nb) {
          const s16x8 bb = *(const s16x8*)(sVt + (nb * 16 + l15) * 40 + kg * 8);
          f32x4 ds;
#pragma unroll
          for (int r = 0; r < 4; ++r) ds[r] = 0.f;
          ds = mfma16_safe(a, bb, ds);
#pragma unroll
          for (int r = 0; r < 4; ++r) sacc[rb][nb][r] = curE[rb][r] * sacc[rb][nb][r] + cure2[rb][r] * ds[r];
        }
      }
    }
    __syncthreads();
    if (c + 1 < nch) {
      HG_WAIT();
      HG_STAGE();
    }
    __syncthreads();
  }
  if (!sample) {
    float* oS = p.out + (size_t)NT * DM + 524288 * 2 + 2097152 + 16384 + 128;
#pragma unroll
    for (int rb = 0; rb < 2; ++rb)
#pragma unroll
      for (int nb = 0; nb < 2; ++nb)
#pragma unroll
        for (int r = 0; r < 4; ++r) {
          const int dd = 32 * w + rb * 16 + 4 * kg + r, e = nb * 16 + l15;
          oS[(((size_t)((b * 2 + dir) * 4 + head)) * 128 + dd) * 128 + slice * 32 + e] = sacc[rb][nb][r];
        }
  }
  __syncthreads();
}

__device__ __forceinline__ void combine_phase(const Params& p, int odd) {
  const int tid_ = otid(); const int lane = tid_ & 63, w = tid_ >> 6;
  const bf16_t* P = p.R1;
  const float* N0 = p.Z;
  const float* N1 = p.Z + (size_t)NT * 512;
  const float* gp = odd ? p.c_norm_g : p.b_norm_g;
  float g0[4], g1[4];
#pragma unroll
  for (int hd = 0; hd < 4; ++hd) { g0[hd] = gp[hd * 128 + lane]; g1[hd] = gp[hd * 128 + 64 + lane]; }
  const int ldp = odd ? LDPO : LDPE, gcol = odd ? 2048 : 2320, ocol = odd ? 0 : 512;
  for (int row = obid() * 4 + w; row < NT; row += gridDim.x * 4) {
    float a0[4], a1[4], b0[4], b1[4], gt0[4], gt1[4], i0[4], i1[4];
#pragma unroll
    for (int hd = 0; hd < 4; ++hd) {
      const size_t o = (size_t)row * 512 + hd * 128;
      a0[hd] = N0[o + lane]; a1[hd] = N0[o + 64 + lane]; b0[hd] = N1[o + lane]; b1[hd] = N1[o + 64 + lane];
      gt0[hd] = bf2f(P[(size_t)row * ldp + gcol + hd * 128 + lane]);
      gt1[hd] = bf2f(P[(size_t)row * ldp + gcol + hd * 128 + 64 + lane]);
      i0[hd] = 1.f; i1[hd] = 1.f;
      if (!odd) {
        const float d0 = p.DEN[((size_t)row) * 4 + hd], c0 = p.CL[((size_t)row) * 4 + hd];
        const float d1 = p.DEN[((size_t)NT + row) * 4 + hd], c1 = p.CL[((size_t)NT + row) * 4 + hd];
        i0[hd] = 1.f / fmaxf(fabsf(d0), c0); i1[hd] = 1.f / fmaxf(fabsf(d1), c1);
      }
    }
#pragma unroll
    for (int hd = 0; hd < 4; ++hd) {
      const float h0 = a0[hd] * i0[hd] + b0[hd] * i1[hd];
      const float h1 = a1[hd] * i0[hd] + b1[hd] * i1[hd];
      const float ms = wave_sum(h0 * h0 + h1 * h1) * (1.f / 128.f);
      const float rs = rsqrtf(ms + 1e-6f);
      const float m0 = odd ? gt0[hd] * sigmoidf_(gt0[hd]) : sigmoidf_(gt0[hd]);
      const float m1 = odd ? gt1[hd] * sigmoidf_(gt1[hd]) : sigmoidf_(gt1[hd]);
      p.Hb[(size_t)row * DM + ocol + hd * 128 + lane] = f2bf(m0 * h0 * rs * g0[hd]);
      p.Hb[(size_t)row * DM + ocol + hd * 128 + 64 + lane] = f2bf(m1 * h1 * rs * g1[hd]);
    }
  }
}

__device__ __forceinline__ void my_gsync(unsigned* bar, unsigned& epoch, unsigned nblocks) {
  asm volatile("s_waitcnt vmcnt(0) lgkmcnt(0)" ::: "memory");
  __syncthreads();
  epoch += 1;
  if (threadIdx.x == 0) {
    __builtin_amdgcn_fence(__ATOMIC_RELEASE, "agent");
    asm volatile("s_waitcnt vmcnt(0) lgkmcnt(0)" ::: "memory");
    const unsigned g = blockIdx.x & 31u;
    const unsigned gsize = (nblocks >> 5) + ((g < (nblocks & 31u)) ? 1u : 0u);
    const unsigned old = __hip_atomic_fetch_add(&bar[g * 64], 1u, __ATOMIC_RELAXED, __HIP_MEMORY_SCOPE_AGENT);
    if (old + 1 == epoch * gsize) {
      const unsigned ngroups = nblocks < 32u ? nblocks : 32u;
      const unsigned old2 = __hip_atomic_fetch_add(&bar[32 * 64], 1u, __ATOMIC_RELAXED, __HIP_MEMORY_SCOPE_AGENT);
      if (old2 + 1 == epoch * ngroups) __hip_atomic_store(&bar[33 * 64], epoch, __ATOMIC_RELAXED, __HIP_MEMORY_SCOPE_AGENT);
    }
    while (__hip_atomic_load(&bar[33 * 64], __ATOMIC_RELAXED, __HIP_MEMORY_SCOPE_AGENT) < epoch) __builtin_amdgcn_s_sleep(1);
    __builtin_amdgcn_fence(__ATOMIC_ACQUIRE, "agent");
  }
  __syncthreads();
  __builtin_amdgcn_fence(__ATOMIC_ACQUIRE, "agent");
}
#define XB_XCNT(j) (4096 + 64 * (j))
#define XB_XSUB(j) (5120 + 64 * (j))
#define XB_XGEN(j) (6144 + 64 * (j))
#define XB_TOP 7168
#define XB_TOPGEN 7232
__device__ __forceinline__ unsigned xb_ld(unsigned* q) { return __hip_atomic_load(q, __ATOMIC_RELAXED, __HIP_MEMORY_SCOPE_AGENT); }
__device__ __forceinline__ unsigned xb_add(unsigned* q) { return __hip_atomic_fetch_add(q, 1u, __ATOMIC_RELAXED, __HIP_MEMORY_SCOPE_AGENT); }
__device__ __forceinline__ void xb_st(unsigned* q, unsigned v) { __hip_atomic_store(q, v, __ATOMIC_RELAXED, __HIP_MEMORY_SCOPE_AGENT); }
__device__ __forceinline__ void xsync(unsigned* bar, unsigned& epoch, unsigned xcc, unsigned cntx, unsigned nxcc) {
  asm volatile("s_waitcnt vmcnt(0) lgkmcnt(0)" ::: "memory");
  __syncthreads();
  epoch += 1;
  if (threadIdx.x == 0) {
    const unsigned old = xb_add(&bar[XB_XSUB(xcc)]);
    if (old + 1 == epoch * cntx) {
      __builtin_amdgcn_fence(__ATOMIC_RELEASE, "agent");
      asm volatile("s_waitcnt vmcnt(0) lgkmcnt(0)" ::: "memory");
      const unsigned old2 = xb_add(&bar[XB_TOP]);
      if (old2 + 1 == epoch * nxcc) xb_st(&bar[XB_TOPGEN], epoch);
      else while (xb_ld(&bar[XB_TOPGEN]) < epoch) __builtin_amdgcn_s_sleep(1);
      xb_st(&bar[XB_XGEN(xcc)], epoch);
    } else {
      while (xb_ld(&bar[XB_XGEN(xcc)]) < epoch) __builtin_amdgcn_s_sleep(1);
    }
    __builtin_amdgcn_fence(__ATOMIC_ACQUIRE, "agent");
    asm volatile("s_waitcnt vmcnt(0) lgkmcnt(0)" ::: "memory");
  }
  __syncthreads();
}
#define GSYNC() xsync(p.bar, xepoch, xcc, cntx, nxcc)
__global__ void __launch_bounds__(256, 2) fwd_megakernel(Params p) {
  cg::grid_group grid = cg::this_grid();
  __shared__ __attribute__((aligned(16))) char smem[LDS_BYTES];
  const int G = gridDim.x;
  unsigned epoch = 0, xepoch = 0;
  if (p.njobs < 0) grid.sync();
  const unsigned xcc = (unsigned)__builtin_amdgcn_s_getreg((3 << 11) | 20) & 0xFu;
  if (threadIdx.x == 0) xb_add(&p.bar[XB_XCNT(xcc)]);
  my_gsync(p.bar, epoch, (unsigned)gridDim.x);
  const unsigned cntx = xb_ld(&p.bar[XB_XCNT(xcc)]);
  unsigned nxcc = 0;
#pragma unroll
  for (int jx = 0; jx < 16; ++jx) nxcc += (xb_ld(&p.bar[XB_XCNT(jx)]) != 0u) ? 1u : 0u;

  {
    const int nmod = 72, b_ = obid();
    if (G > 2 * nmod) {
      if (b_ < nmod) mod_item(p, b_, smem);
      else {
        for (int t = b_ - nmod; t < p.conv_tiles_l0; t += G - nmod) {
          int j = 0;
#pragma unroll 1
          for (int q = 1; q < p.njobs; ++q) if (t >= p.jobs[q].tile0) j = q;
          conv_tile(p.jobs[j], t - p.jobs[j].tile0, smem);
        }
      }
    } else {
      for (int it = b_; it < nmod + p.total_conv_tiles; it += G) {
        if (it < nmod) mod_item(p, it, smem);
        else {
          const int t = it - nmod;
          int j = 0;
#pragma unroll 1
          for (int q = 1; q < p.njobs; ++q) if (t >= p.jobs[q].tile0) j = q;
          conv_tile(p.jobs[j], t - p.jobs[j].tile0, smem);
        }
      }
    }
  }
  GSYNC();
  modulate_input_phase(p);
  GSYNC();

#pragma unroll 1
  for (int l = 0; l < 2; ++l) {
    const int odd = l;
#pragma unroll 1
    for (int j = 0; j < 2; ++j) {
      if (j == 1) {
        {
          EpiStoreBf16 epi{p.R1, odd ? LDPO : LDPE};
          gemm_phase<2, EpiStoreBf16>(p.Hb, DM, odd ? p.WtInO : p.WtInE, DM, odd ? LDPO : LDPE, DM, epi, smem);
        }
        GSYNC();
        prep_vectors(p, odd);
        prep_v(p, odd, smem);
        if (odd) hgrn_pre(p, smem);
        GSYNC();
        {
          const int nlong = odd ? 128 : 160, nshort = odd ? 512 : 640, natt = 768;
          const int b_ = obid();
          if (b_ < nlong && G > nlong) {
            if (!odd) mlstm_item(p, b_, smem); else hgrn_item(p, b_, smem);
          } else {
            const int first = (G > nlong) ? b_ - nlong : b_, stride = (G > nlong) ? G - nlong : G;
            const int lo_it = (G > nlong) ? 0 : -nlong;
            for (int it = first + lo_it; it < natt + nshort; it += stride) {
              if (it < 0) { if (!odd) mlstm_item(p, it + nlong, smem); else hgrn_item(p, it + nlong, smem); }
              else if (it < natt) attn_item(p, odd, it, smem);
              else if (!odd) mlstm_item(p, nlong + (it - natt), smem);
              else hgrn_item(p, nlong + (it - natt), smem);
            }
            if (!odd) {
              const int nx = p.total_conv_tiles - p.conv_tiles_l0;
              for (int x = first; x < nx; x += stride) {
                const int t = p.conv_tiles_l0 + x;
                int jj = 0;
#pragma unroll 1
                for (int q = 1; q < p.njobs; ++q) if (t >= p.jobs[q].tile0) jj = q;
                conv_tile(p.jobs[jj], t - p.jobs[jj].tile0, smem);
              }
            }
          }
        }
        GSYNC();
        combine_phase(p, odd);
        GSYNC();
        {
          EpiResid<2> epi{p.Z, p.out, p.out + (size_t)NPR * DM, modp(p, l, 0, 5), 1.f};
          gemm_phase<2, EpiResid<2>>(p.Hb, DM, odd ? p.WtOutO : p.WtOutE, DM, DM, DM, epi, smem);
        }
        GSYNC();
        ln_phase(p, p.ln_g + (size_t)(l * 3 + 1) * DM, p.ln_b + (size_t)(l * 3 + 1) * DM, true, l, 2);
        GSYNC();
      }
      const int j2 = j * 2;
      {
        EpiSwiglu epi{p.R1};
        gemm_phase<2, EpiSwiglu>(p.Hb, DM, p.Wt13p[l * 2 + j], DM, 5632, DM, epi, smem);
      }
      GSYNC();
      {
        const bool first = (l == 0 && j == 0);
        EpiResid<2> epi{p.Z, first ? p.x_prompt : p.out, first ? p.x_sample : p.out + (size_t)NPR * DM, modp(p, l, 0, 3 * j2 + 2), 0.5f};
        gemm_phase<2, EpiResid<2>>(p.R1, DFF, p.Wt2p[l * 2 + j], DFF, DM, DFF, epi, smem);
      }
      GSYNC();
      {
        const bool last = (l == 1 && j == 1);
        const int nl = (j == 0) ? l : l + 1, nj = (j == 0) ? 1 : 0;
        ln_phase(p, p.ln_g + (size_t)(l * 3 + j2) * DM, p.ln_b + (size_t)(l * 3 + j2) * DM, !last, last ? 0 : nl, last ? 0 : nj);
      }
      GSYNC();
    }
  }
}


template <int PH>
__global__ void __launch_bounds__(256, 2) k_phase(Params p, int l, int j) {
  __shared__ __attribute__((aligned(16))) char smem[LDS_BYTES];
  const int G = gridDim.x;
  const int odd = l;
  if (PH == 0) {
    const int nmod = 72;
    for (int it = obid(); it < nmod + p.total_conv_tiles; it += G) {
      if (it < nmod) mod_item(p, it, smem);
      else {
        const int t = it - nmod;
        int jj = 0;
#pragma unroll 1
        for (int q = 1; q < p.njobs; ++q) if (t >= p.jobs[q].tile0) jj = q;
        conv_tile(p.jobs[jj], t - p.jobs[jj].tile0, smem);
      }
    }
  } else if (PH == 1) {
    modulate_input_phase(p);
  } else if (PH == 2) {
    EpiStoreBf16 epi{p.R1, odd ? LDPO : LDPE};
    gemm_phase<2, EpiStoreBf16>(p.Hb, DM, odd ? p.WtInO : p.WtInE, DM, odd ? LDPO : LDPE, DM, epi, smem);
  } else if (PH == 3) {
    prep_vectors(p, odd);
    prep_v(p, odd, smem);
    if (odd) hgrn_pre(p, smem);
  } else if (PH == 4) {
    for (int it = obid(); it < 160 + 640 + 768; it += G) {
      if (it < 160) mlstm_item(p, it, smem);
      else if (it < 160 + 768) attn_item(p, 0, it - 160, smem);
      else mlstm_item(p, it - 768, smem);
    }
  } else if (PH == 5) {
    for (int it = obid(); it < 128 + 512 + 768; it += G) {
      if (it < 128) hgrn_item(p, it, smem);
      else if (it < 128 + 768) attn_item(p, 1, it - 128, smem);
      else hgrn_item(p, it - 768, smem);
    }
  } else if (PH == 6) {
    combine_phase(p, odd);
  } else if (PH == 7) {
    EpiResid<1> epi{p.Z, p.out, p.out + (size_t)NPR * DM, modp(p, l, 0, 5), 1.f};
    gemm_phase<1, EpiResid<1>>(p.Hb, DM, odd ? p.WtOutO : p.WtOutE, DM, DM, DM, epi, smem);
  } else if (PH == 8) {
    ln_phase(p, p.ln_g + (size_t)(l * 3 + 1) * DM, p.ln_b + (size_t)(l * 3 + 1) * DM, true, l, 2);
  } else if (PH == 9) {
    EpiSwiglu epi{p.R1};
    gemm_phase<2, EpiSwiglu>(p.Hb, DM, p.Wt13p[l * 2 + j], DM, 5632, DM, epi, smem);
  } else if (PH == 10) {
    const int j2 = j * 2;
    const bool first = (l == 0 && j == 0);
    EpiResid<1> epi{p.Z, first ? p.x_prompt : p.out, first ? p.x_sample : p.out + (size_t)NPR * DM, modp(p, l, 0, 3 * j2 + 2), 0.5f};
    gemm_phase<1, EpiResid<1>>(p.R1, DFF, p.Wt2p[l * 2 + j], DFF, DM, DFF, epi, smem);
  } else if (PH == 13) {
    for (size_t i = (size_t)obid() * 256 + otid(); i < (size_t)8192 * 512; i += (size_t)G * 256) p.SAVE[i] = p.Z[i];
  } else if (PH == 14) {
    bool bad = false;
    for (size_t i = (size_t)obid() * 256 + otid(); i < (size_t)8192 * 512; i += (size_t)G * 256) if (__float_as_uint(p.SAVE[i]) != __float_as_uint(p.Z[i])) bad = true;
    if (bad) { volatile int* q = (volatile int*)p.SAVE; while (q[0] != 0x7fffffff) { __builtin_amdgcn_s_sleep(10); } }
  } else if (PH == 11) {
    const int j2 = j * 2;
    const bool last = (l == 1 && j == 1);
    const int nl = (j == 0) ? l : l + 1, nj = (j == 0) ? 1 : 0;
    ln_phase(p, p.ln_g + (size_t)(l * 3 + j2) * DM, p.ln_b + (size_t)(l * 3 + j2) * DM, !last, last ? 0 : nl, last ? 0 : nj);
  }
}
extern "C" void kernel_launch(void* const* d_in, const int* in_sizes, int n_in, void* d_out, int out_size, void* d_ws,
                              size_t ws_size, hipStream_t stream) {
  static Params p;
  memset(&p, 0, sizeof(p));
  const float** ip = (const float**)&p.x_prompt;
  for (int i = 0; i < 30; ++i) ip[i] = (const float*)d_in[i];
  p.out = (float*)d_out;
  char* ws = (char*)d_ws;
  size_t off = 0;
  auto take = [&](size_t bytes) { char* r = ws + off; off += (bytes + 255) & ~(size_t)255; return r; };
  p.bar = (unsigned*)take(32768);
  char* l0_begin = ws + off;
  p.Wt13p[0] = (bf16_t*)take((size_t)5632 * 1024 * 2);
  p.Wt13p[1] = (bf16_t*)take((size_t)5632 * 1024 * 2);
  p.Wt2p[0] = (bf16_t*)take((size_t)1024 * DFF * 2);
  p.Wt2p[1] = (bf16_t*)take((size_t)1024 * DFF * 2);
  p.WtInE = (bf16_t*)take((size_t)LDPE * 1024 * 2);
  p.WtOutE = (bf16_t*)take((size_t)1024 * 1024 * 2);
  char* l0_end = ws + off;
  p.HQ = (bf16_t*)l0_begin;
  p.EV = (float*)(l0_begin + 25165824);
  p.HK0 = (bf16_t*)(l0_begin + 25165824 + 4718592);
  if (l0_begin + 25165824 + 4718592 + 12582912 > l0_end) fprintf(stderr, "layer-0 weight region too small for the HGRN buffers\n");
  p.Wt13p[2] = (bf16_t*)take((size_t)5632 * 1024 * 2);
  p.Wt13p[3] = (bf16_t*)take((size_t)5632 * 1024 * 2);
  p.Wt2p[2] = (bf16_t*)take((size_t)1024 * DFF * 2);
  p.Wt2p[3] = (bf16_t*)take((size_t)1024 * DFF * 2);
  p.WtInO = (bf16_t*)take((size_t)LDPO * 1024 * 2);
  p.WtOutO = (bf16_t*)take((size_t)1024 * 1024 * 2);
  p.HK1 = (bf16_t*)take((size_t)12582912);
  p.HKt = (bf16_t*)take((size_t)25165824);
  p.MOD = (float*)take((size_t)2 * 5 * 9216 * 4);
  p.Hb = (bf16_t*)take((size_t)NT * DM * 2);
  p.R1 = (bf16_t*)take((size_t)NT * LDPO * 2);
  p.Z = (float*)take((size_t)NT * DM * 4);
  p.Qb = (bf16_t*)take((size_t)NT * 512 * 2);
  p.Kb = (bf16_t*)take((size_t)NT * 128 * 2);
  p.Vt = (bf16_t*)take((size_t)(524288 + 1048576) * 2);
  p.Kc = (bf16_t*)take((size_t)262144 * 2);
  p.Vct = (bf16_t*)take((size_t)262144 * 2);
  p.DEN = (float*)take((size_t)2 * NT * 4 * 4);
  p.CL = (float*)take((size_t)2 * NT * 4 * 4);
  if (off > ws_size) fprintf(stderr, "workspace too small: need %zu have %zu\n", off, ws_size);
  int nj = 0, tiles = 0;
  auto add = [&](const float* src, bf16_t* dst, int K, int N, int Npad, int mode) {
    ConvJob& jb = p.jobs[nj++];
    jb.src = src; jb.dst = dst; jb.K = K; jb.N = N; jb.Npad = Npad; jb.mode = mode; jb.tile0 = tiles; jb.pad0 = 0;
    tiles += (K / 64) * (Npad / 64);
  };
  for (int lj = 0; lj < 2; ++lj) {
    add(p.ffn_w1 + (size_t)lj * 1024 * DFF, p.Wt13p[lj], 1024, DFF, DFF, 1);
    add(p.ffn_w3 + (size_t)lj * 1024 * DFF, p.Wt13p[lj], 1024, DFF, DFF, 2);
    add(p.ffn_w2 + (size_t)lj * DFF * 1024, p.Wt2p[lj], DFF, 1024, 1024, 0);
  }
  add(p.w_in_even, p.WtInE, 1024, 2832, LDPE, 0);
  add(p.w_out_even, p.WtOutE, 1024, 1024, 1024, 0);
  p.conv_tiles_l0 = tiles;
  for (int lj = 2; lj < 4; ++lj) {
    add(p.ffn_w1 + (size_t)lj * 1024 * DFF, p.Wt13p[lj], 1024, DFF, DFF, 1);
    add(p.ffn_w3 + (size_t)lj * 1024 * DFF, p.Wt13p[lj], 1024, DFF, DFF, 2);
    add(p.ffn_w2 + (size_t)lj * DFF * 1024, p.Wt2p[lj], DFF, 1024, 1024, 0);
  }
  add(p.w_in_odd, p.WtInO, 1024, LDPO, LDPO, 0);
  add(p.w_out_odd, p.WtOutO, 1024, 1024, 1024, 0);
  p.njobs = nj; p.total_conv_tiles = tiles;
  static int grid_blocks = 0;
  if (!grid_blocks) {
    int dev = 0, cus = 0, per_cu = 0;
    hipGetDevice(&dev);
    hipDeviceGetAttribute(&cus, hipDeviceAttributeMultiprocessorCount, dev);
    hipOccupancyMaxActiveBlocksPerMultiprocessor(&per_cu, fwd_megakernel, 256, 0);
    per_cu = 2;
    grid_blocks = cus * per_cu;
  }
  hipMemsetAsync(p.bar, 0, 32768, stream);
#if MULTI_LAUNCH
  const dim3 g(512), b(256);
  k_phase<0><<<g, b, 0, stream>>>(p, 0, 0);
  k_phase<1><<<g, b, 0, stream>>>(p, 0, 0);
  for (int l = 0; l < 2; ++l)
    for (int j = 0; j < 2; ++j) {
      if (j == 1) {
        k_phase<2><<<g, b, 0, stream>>>(p, l, j);
        k_phase<3><<<g, b, 0, stream>>>(p, l, j);
        if (l == 0) k_phase<4><<<g, b, 0, stream>>>(p, l, j); else k_phase<5><<<g, b, 0, stream>>>(p, l, j);
        k_phase<6><<<g, b, 0, stream>>>(p, l, j);
        k_phase<7><<<g, b, 0, stream>>>(p, l, j);
        k_phase<8><<<g, b, 0, stream>>>(p, l, j);
      }
      k_phase<9><<<g, b, 0, stream>>>(p, l, j);
      k_phase<10><<<g, b, 0, stream>>>(p, l, j);
      k_phase<11><<<g, b, 0, stream>>>(p, l, j);
    }
#else
  void* args[] = {&p};
  hipError_t e = hipLaunchCooperativeKernel((void*)fwd_megakernel, dim3(grid_blocks), dim3(256), args, 0, stream);
  if (e != hipSuccess) fprintf(stderr, "cooperative launch failed: %s (grid %d)\n", hipGetErrorString(e), grid_blocks);
#endif
}
```

```cpp
#define MULTI_LAUNCH 0
#include <hip/hip_runtime.h>
#include <hip/hip_cooperative_groups.h>
#include <cstdint>
#include <cstring>
#include <cstdio>
namespace cg = cooperative_groups;

typedef unsigned short bf16_t;
typedef short s16x8 __attribute__((ext_vector_type(8)));
typedef short s16x4 __attribute__((ext_vector_type(4)));
typedef float f32x4 __attribute__((ext_vector_type(4)));
typedef float f32x16 __attribute__((ext_vector_type(16)));
typedef unsigned u32x4 __attribute__((ext_vector_type(4)));

#define NT 12288
#define NPR 4096
#define DM 1024
#define DFF 2816
#define LDPE 2944
#define LDPO 3328
#define ALPHA_F 1.4142135623730951f
#define LOG2E 1.4426950408889634f
#define LDS_BYTES 77824

struct ConvJob { const float* src; bf16_t* dst; int K, N, Npad, mode, tile0, pad0; };

struct Params {
  const float *x_prompt, *x_sample, *c, *cache_a_k, *cache_a_v, *state_b_C, *state_b_n, *state_b_m, *state_c_S,
      *cache_d_k, *cache_d_v, *c_ctx, *ada_w, *ada_b, *ln_g, *ln_b, *ffn_w1, *ffn_w3, *ffn_w2, *w_in_even,
      *w_out_even, *a_sink, *b_gate_bias, *b_norm_g, *w_in_odd, *w_out_odd, *c_lb_logits, *c_norm_g, *d_q_norm,
      *d_k_norm;
  float* out;
  bf16_t *Wt13p[4], *Wt2p[4], *WtInE, *WtInO, *WtOutE, *WtOutO;
  bf16_t *HQ, *HK0, *HK1, *HKt; float* EV;
  float* MOD;
  bf16_t* Hb;
  bf16_t* R1;
  float* Z;
  bf16_t *Qb, *Kb, *Vt, *Kc, *Vct;
  float *DEN, *CL;
  ConvJob jobs[16];
  int njobs, total_conv_tiles, conv_tiles_l0, pad1;
  float* SAVE;
  unsigned* bar;
};

__device__ __forceinline__ int otid() { int t = threadIdx.x; asm volatile("" : "+v"(t)); return t; }
__device__ __forceinline__ int obid() { int t = blockIdx.x; asm volatile("" : "+s"(t)); return t; }
__device__ __forceinline__ u32x4 gload16(const void* ptr) {
  u32x4 r;
  asm volatile("global_load_dwordx4 %0, %1, off" : "=v"(r) : "v"(ptr) : "memory");
  return r;
}
__device__ __forceinline__ unsigned gload2(const void* ptr) {
  unsigned r;
  asm volatile("global_load_ushort %0, %1, off" : "=v"(r) : "v"(ptr) : "memory");
  return r;
}
__device__ __forceinline__ void vm_wait4(u32x4& a, u32x4& b, u32x4& c, u32x4& d) {
  asm volatile("s_waitcnt vmcnt(0)" : "+v"(a), "+v"(b), "+v"(c), "+v"(d) : : "memory");
}
__device__ __forceinline__ void vm_wait2(u32x4& a, u32x4& b) {
  asm volatile("s_waitcnt vmcnt(0)" : "+v"(a), "+v"(b) : : "memory");
}
__device__ __forceinline__ f32x4 mfma16_safe(s16x8 a, s16x8 b, f32x4 c) {
  asm volatile("s_nop 4\n\tv_mfma_f32_16x16x32_bf16 %0, %1, %2, %0\n\ts_nop 7\n\ts_nop 7" : "+v"(c) : "v"(a), "v"(b));
  return c;
}
__device__ __forceinline__ float bf2f(bf16_t v) { return __uint_as_float(((unsigned)v) << 16); }
__device__ __forceinline__ unsigned pk2(float a, float b) {
  unsigned r;
  asm("v_cvt_pk_bf16_f32 %0, %1, %2" : "=v"(r) : "v"(a), "v"(b));
  return r;
}
__device__ __forceinline__ bf16_t f2bf(float f) { return (bf16_t)(pk2(f, f) & 0xffffu); }
__device__ __forceinline__ float wave_sum(float v) {
#pragma unroll
  for (int o = 32; o > 0; o >>= 1) v += __shfl_xor(v, o);
  return v;
}
__device__ __forceinline__ int mod_index(int row) { return row < NPR ? 0 : 1 + ((row - NPR) >> 11); }
__device__ __forceinline__ const float* modp(const Params& p, int l, int mi, int part) {
  return p.MOD + ((size_t)((l * 5 + mi) * 9 + part)) * DM;
}
__device__ __forceinline__ float sigmoidf_(float x) { return __builtin_amdgcn_rcpf(1.f + __expf(-x)); }

__device__ __forceinline__ void conv_tile(const ConvJob& jb, int t, char* smem) {
  float* sT = (float*)smem;
  const int nkt = jb.K >> 6;
  const int kt = t % nkt, nt = t / nkt;
  const int k0 = kt * 64, n0 = nt * 64;
  const int tid = otid();
#pragma unroll
  for (int i = 0; i < 4; ++i) {
    const int r = (tid >> 4) + 16 * i, c4 = (tid & 15) * 4, n = n0 + c4;
    float4 v = make_float4(0.f, 0.f, 0.f, 0.f);
    if (n < jb.N) v = *(const float4*)(jb.src + (size_t)(k0 + r) * jb.N + n);
    sT[r * 65 + c4 + 0] = v.x; sT[r * 65 + c4 + 1] = v.y; sT[r * 65 + c4 + 2] = v.z; sT[r * 65 + c4 + 3] = v.w;
  }
  __syncthreads();
#pragma unroll
  for (int i = 0; i < 2; ++i) {
    const int id = tid + i * 256, nl = id >> 3, ch = id & 7;
    const int n = n0 + nl;
    int drow = n;
    if (jb.mode == 1) drow = (n >> 5) * 64 + (n & 31);
    else if (jb.mode == 2) drow = (n >> 5) * 64 + 32 + (n & 31);
    uint4 w;
    w.x = pk2(sT[(ch * 8 + 0) * 65 + nl], sT[(ch * 8 + 1) * 65 + nl]);
    w.y = pk2(sT[(ch * 8 + 2) * 65 + nl], sT[(ch * 8 + 3) * 65 + nl]);
    w.z = pk2(sT[(ch * 8 + 4) * 65 + nl], sT[(ch * 8 + 5) * 65 + nl]);
    w.w = pk2(sT[(ch * 8 + 6) * 65 + nl], sT[(ch * 8 + 7) * 65 + nl]);
    if (n < jb.Npad) *(uint4*)(jb.dst + (size_t)drow * jb.K + k0 + ch * 8) = w;
  }
  __syncthreads();
}

__device__ __forceinline__ void mod_item(const Params& p, int item, char* smem) {
  float* sv = (float*)smem;
  float4* red = (float4*)(smem + 20480);
  const int l = item / 36, cgp = item % 36, tid = otid();
  for (int idx = tid; idx < 5120; idx += 256) {
    const int n = idx >> 10, k = idx & 1023;
    const float v = (n == 0) ? p.c_ctx[k] : p.c[(n - 1) * 1024 + k];
    sv[idx] = v * sigmoidf_(v);
  }
  __syncthreads();
  const int kq = tid >> 6, cl = tid & 63, col = cgp * 256 + cl * 4;
  const float* W = p.ada_w + (size_t)l * 1024 * 9216 + col;
  float4 acc[5];
#pragma unroll
  for (int n = 0; n < 5; ++n) acc[n] = make_float4(0.f, 0.f, 0.f, 0.f);
  for (int kb = 0; kb < 256; kb += 8) {
    float4 w[8];
#pragma unroll
    for (int u = 0; u < 8; ++u) w[u] = *(const float4*)(W + (size_t)(kq * 256 + kb + u) * 9216);
#pragma unroll
    for (int u = 0; u < 8; ++u) {
#pragma unroll
      for (int n = 0; n < 5; ++n) {
        const float s = sv[n * 1024 + kq * 256 + kb + u];
        acc[n].x += s * w[u].x; acc[n].y += s * w[u].y; acc[n].z += s * w[u].z; acc[n].w += s * w[u].w;
      }
    }
  }
#pragma unroll
  for (int n = 0; n < 5; ++n) red[(kq * 5 + n) * 64 + cl] = acc[n];
  __syncthreads();
  for (int idx = tid; idx < 320; idx += 256) {
    const int n = idx >> 6, c2 = idx & 63;
    float4 s = red[(0 * 5 + n) * 64 + c2];
#pragma unroll
    for (int q = 1; q < 4; ++q) {
      const float4 t = red[(q * 5 + n) * 64 + c2];
      s.x += t.x; s.y += t.y; s.z += t.z; s.w += t.w;
    }
    const int cc = cgp * 256 + c2 * 4;
    const float4 b = *(const float4*)(p.ada_b + (size_t)l * 9216 + cc);
    s.x += b.x; s.y += b.y; s.z += b.z; s.w += b.w;
    *(float4*)(p.MOD + (size_t)(l * 5 + n) * 9216 + cc) = s;
  }
  __syncthreads();
}

__device__ __forceinline__ void modulate_input_phase(const Params& p) {
  const int tid_ = otid(); const int lane = tid_ & 63, w = tid_ >> 6;
  for (int row = obid() * 4 + w; row < NT; row += gridDim.x * 4) {
    const float* xr = row < NPR ? p.x_prompt + (size_t)row * DM : p.x_sample + (size_t)(row - NPR) * DM;
    const int mi = mod_index(row);
    const float* sh = modp(p, 0, mi, 0);
    const float* sc = modp(p, 0, mi, 1);
#pragma unroll
    for (int i = 0; i < 4; ++i) {
      const int c = lane * 4 + 256 * i;
      const float4 x = *(const float4*)(xr + c);
      const float4 s = *(const float4*)(sc + c);
      const float4 h = *(const float4*)(sh + c);
      uint2 o;
      o.x = pk2(x.x * (1.f + s.x) + h.x, x.y * (1.f + s.y) + h.y);
      o.y = pk2(x.z * (1.f + s.z) + h.z, x.w * (1.f + s.w) + h.w);
      *(uint2*)(p.Hb + (size_t)row * DM + c) = o;
    }
  }
}

__device__ __forceinline__ void ln_phase(const Params& p, const float* g, const float* b, bool write_h, int nl, int nj) {
  const int tid_ = otid(); const int lane = tid_ & 63, w = tid_ >> 6;
  float* X = p.out;
  float4 gg[4], bb[4];
#pragma unroll
  for (int i = 0; i < 4; ++i) { gg[i] = *(const float4*)(g + lane * 4 + 256 * i); bb[i] = *(const float4*)(b + lane * 4 + 256 * i); }
  for (int row0 = (obid() * 4 + w) * 2; row0 < NT; row0 += gridDim.x * 8) {
    float4 v[2][4], s4[4], h4[4];
#pragma unroll
    for (int r = 0; r < 2; ++r)
#pragma unroll
      for (int i = 0; i < 4; ++i) v[r][i] = *(const float4*)(p.Z + (size_t)(row0 + r) * DM + lane * 4 + 256 * i);
    const int mi = mod_index(row0);
    const float* sh = modp(p, nl, mi, 3 * nj);
    const float* sc = modp(p, nl, mi, 3 * nj + 1);
    if (write_h) {
#pragma unroll
      for (int i = 0; i < 4; ++i) { s4[i] = *(const float4*)(sc + lane * 4 + 256 * i); h4[i] = *(const float4*)(sh + lane * 4 + 256 * i); }
    }
    float s0 = 0.f, s1 = 0.f;
#pragma unroll
    for (int i = 0; i < 4; ++i) {
      s0 += (v[0][i].x + v[0][i].y) + (v[0][i].z + v[0][i].w);
      s1 += (v[1][i].x + v[1][i].y) + (v[1][i].z + v[1][i].w);
    }
#pragma unroll
    for (int o = 32; o > 0; o >>= 1) { s0 += __shfl_xor(s0, o); s1 += __shfl_xor(s1, o); }
    const float mu0 = s0 * (1.f / 1024.f), mu1 = s1 * (1.f / 1024.f);
    float q0 = 0.f, q1 = 0.f;
#pragma unroll
    for (int i = 0; i < 4; ++i) {
      v[0][i].x -= mu0; v[0][i].y -= mu0; v[0][i].z -= mu0; v[0][i].w -= mu0;
      v[1][i].x -= mu1; v[1][i].y -= mu1; v[1][i].z -= mu1; v[1][i].w -= mu1;
      q0 += (v[0][i].x * v[0][i].x + v[0][i].y * v[0][i].y) + (v[0][i].z * v[0][i].z + v[0][i].w * v[0][i].w);
      q1 += (v[1][i].x * v[1][i].x + v[1][i].y * v[1][i].y) + (v[1][i].z * v[1][i].z + v[1][i].w * v[1][i].w);
    }
#pragma unroll
    for (int o = 32; o > 0; o >>= 1) { q0 += __shfl_xor(q0, o); q1 += __shfl_xor(q1, o); }
    const float rs[2] = {rsqrtf(q0 * (1.f / 1024.f) + 1e-5f), rsqrtf(q1 * (1.f / 1024.f) + 1e-5f)};
#pragma unroll
    for (int r = 0; r < 2; ++r)
#pragma unroll
      for (int i = 0; i < 4; ++i) {
        const int c = lane * 4 + 256 * i;
        float4 y;
        y.x = v[r][i].x * rs[r] * gg[i].x + bb[i].x; y.y = v[r][i].y * rs[r] * gg[i].y + bb[i].y;
        y.z = v[r][i].z * rs[r] * gg[i].z + bb[i].z; y.w = v[r][i].w * rs[r] * gg[i].w + bb[i].w;
        *(float4*)(X + (size_t)(row0 + r) * DM + c) = y;
        if (write_h) {
          uint2 o;
          o.x = pk2(y.x * (1.f + s4[i].x) + h4[i].x, y.y * (1.f + s4[i].y) + h4[i].y);
          o.y = pk2(y.z * (1.f + s4[i].z) + h4[i].z, y.w * (1.f + s4[i].w) + h4[i].w);
          *(uint2*)(p.Hb + (size_t)(row0 + r) * DM + c) = o;
        }
      }
  }
}

__device__ __forceinline__ void stage_acc(const f32x16 (&acc)[2][2], float* sA, int wr, int wc, int lane) {
#pragma unroll
  for (int mi = 0; mi < 2; ++mi)
#pragma unroll
    for (int ni = 0; ni < 2; ++ni)
#pragma unroll
      for (int r = 0; r < 16; ++r) {
        const int row = wr * 64 + mi * 32 + (r & 3) + 8 * (r >> 2) + 4 * (lane >> 5), col = wc * 64 + ni * 32 + (lane & 31);
        sA[row * 132 + col] = acc[mi][ni][r];
      }
}
struct EpiSwiglu {
  bf16_t* G;
  __device__ __forceinline__ void operator()(const f32x16 (&acc)[2][2], char* smem, int row0, int col0, int wr, int wc, int lane, int tid) const {
    float* sA = (float*)smem;
#pragma unroll
    for (int mi = 0; mi < 2; ++mi)
#pragma unroll
      for (int r = 0; r < 16; ++r) {
        const int row = wr * 64 + mi * 32 + (r & 3) + 8 * (r >> 2) + 4 * (lane >> 5);
        const float a = acc[mi][0][r], bb = acc[mi][1][r];
        sA[row * 68 + wc * 32 + (lane & 31)] = a * sigmoidf_(a) * bb;
      }
    __syncthreads();
    const int n0 = (col0 >> 7) * 64;
#pragma unroll
    for (int i = 0; i < 4; ++i) {
      const int idx = tid + i * 256, row = idx >> 3, c8 = (idx & 7) * 8;
      const float4 v0 = *(const float4*)(sA + row * 68 + c8), v1 = *(const float4*)(sA + row * 68 + c8 + 4);
      uint4 o; o.x = pk2(v0.x, v0.y); o.y = pk2(v0.z, v0.w); o.z = pk2(v1.x, v1.y); o.w = pk2(v1.z, v1.w);
      *(uint4*)(G + (size_t)(row0 + row) * DFF + n0 + c8) = o;
    }
    __syncthreads();
  }
};
template <int NI>
struct EpiResid {
  float* Z; const float* r0; const float* r1; const float* gate_base; float gs;
  __device__ __forceinline__ void operator()(const f32x16 (&acc)[2][NI], char* smem, int row0, int col0, int wr, int wc, int lane, int tid) const {
    float* sA = (float*)smem;
    stage_acc(acc, sA, wr, wc, lane);
    __syncthreads();
    const float* gate = gate_base + (size_t)mod_index(row0) * 9 * DM;
    const float* rbase = (row0 < NPR) ? r0 : r1 - (size_t)NPR * DM;
    const int c4 = (tid & 31) * 4;
    float4 gv = *(const float4*)(gate + col0 + c4);
    gv.x *= gs; gv.y *= gs; gv.z *= gs; gv.w *= gs;
#pragma unroll
    for (int i = 0; i < 16; ++i) {
      const int row = (tid >> 5) + i * 8;
      const float4 a = *(const float4*)(sA + row * 132 + c4);
      const size_t o = (size_t)(row0 + row) * DM + col0 + c4;
      const float4 x = *(const float4*)(rbase + o);
      float4 z;
      z.x = ALPHA_F * x.x + gv.x * a.x; z.y = ALPHA_F * x.y + gv.y * a.y; z.z = ALPHA_F * x.z + gv.z * a.z; z.w = ALPHA_F * x.w + gv.w * a.w;
      *(float4*)(Z + o) = z;
    }
    __syncthreads();
  }
};
struct EpiStoreBf16 {
  bf16_t* P; int ld;
  __device__ __forceinline__ void operator()(const f32x16 (&acc)[2][2], char* smem, int row0, int col0, int wr, int wc, int lane, int tid) const {
    float* sA = (float*)smem;
    stage_acc(acc, sA, wr, wc, lane);
    __syncthreads();
#pragma unroll
    for (int i = 0; i < 8; ++i) {
      const int idx = tid + i * 256, row = idx >> 4, c8 = (idx & 15) * 8;
      const float4 v0 = *(const float4*)(sA + row * 132 + c8), v1 = *(const float4*)(sA + row * 132 + c8 + 4);
      uint4 o; o.x = pk2(v0.x, v0.y); o.y = pk2(v0.z, v0.w); o.z = pk2(v1.x, v1.y); o.w = pk2(v1.z, v1.w);
      *(uint4*)(P + (size_t)(row0 + row) * ld + col0 + c8) = o;
    }
    __syncthreads();
  }
};

#define LAS __attribute__((address_space(3)))
template <int NI, class Epi>
__device__ __forceinline__ void gemm_tile(const bf16_t* __restrict__ A, int lda, const bf16_t* __restrict__ Bt, int ldb,
                                          int K, int row0, int col0, const Epi& epi, char* smem) {
  static_assert(NI == 2, "LDS-DMA tile is 128 x 128");
  constexpr int STAGE_B = 32768;
  const int tid = otid(), lane = tid & 63, w = tid >> 6, wr = w >> 1, wc = w & 1, h = lane >> 5;
  LAS char* lds = (LAS char*)smem;
  const int lrow = lane >> 3;
  const int c0 = (lane & 7) ^ (lane >> 4), c1 = (lane & 7) ^ (4 + (lane >> 4));
  const bf16_t* Ag[4];
  const bf16_t* Bg[4];
#pragma unroll
  for (int i = 0; i < 4; ++i) {
    const int row = (w * 4 + i) * 8 + lrow, c = (i & 1) ? c1 : c0;
    Ag[i] = A + (size_t)(row0 + row) * lda + c * 8;
    Bg[i] = Bt + (size_t)(col0 + row) * ldb + c * 8;
  }
#define GEMM_STAGE(buf_, k0_)                                                                                              \
  {                                                                                                                        \
    _Pragma("unroll") for (int i = 0; i < 4; ++i) {                                                                        \
      __builtin_amdgcn_global_load_lds((const __attribute__((address_space(1))) unsigned*)(Ag[i] + (k0_)),                 \
                                       (LAS unsigned*)(lds + (buf_) * STAGE_B + (w * 4 + i) * 1024), 16, 0, 0);            \
      __builtin_amdgcn_global_load_lds((const __attribute__((address_space(1))) unsigned*)(Bg[i] + (k0_)),                 \
                                       (LAS unsigned*)(lds + (buf_) * STAGE_B + 16384 + (w * 4 + i) * 1024), 16, 0, 0);    \
    }                                                                                                                      \
  }
  f32x16 acc[2][NI];
#pragma unroll
  for (int mi = 0; mi < 2; ++mi)
#pragma unroll
    for (int ni = 0; ni < NI; ++ni)
#pragma unroll
      for (int r = 0; r < 16; ++r) acc[mi][ni][r] = 0.f;
  const int nk = K >> 6;
  GEMM_STAGE(0, 0);
  __syncthreads();
  const int sw = ((lane & 31) >> 1) & 7;
  const int aoff = (wr * 64 + (lane & 31)) * 128;
  const int boff = 16384 + (wc * 64 + (lane & 31)) * 128;
  for (int kt = 0; kt < nk; ++kt) {
    const int cur = kt & 1;
    if (kt + 1 < nk) GEMM_STAGE(cur ^ 1, (kt + 1) * 64);
    LAS const char* sc = lds + cur * STAGE_B;
#pragma unroll
    for (int kk = 0; kk < 4; ++kk) {
      const int co = ((kk * 2 + h) ^ sw) * 16;
      s16x8 af[2], bfr[NI];
#pragma unroll
      for (int mi = 0; mi < 2; ++mi) af[mi] = *(LAS const s16x8*)(sc + aoff + mi * 4096 + co);
#pragma unroll
      for (int ni = 0; ni < NI; ++ni) bfr[ni] = *(LAS const s16x8*)(sc + boff + ni * 4096 + co);
#pragma unroll
      for (int mi = 0; mi < 2; ++mi)
#pragma unroll
        for (int ni = 0; ni < NI; ++ni)
          acc[mi][ni] = __builtin_amdgcn_mfma_f32_32x32x16_bf16(af[mi], bfr[ni], acc[mi][ni], 0, 0, 0);
    }
    __syncthreads();
  }
#undef GEMM_STAGE
  epi(acc, smem, row0, col0, wr, wc, lane, tid);
}

template <int NI, class Epi>
__device__ __forceinline__ void gemm_phase(const bf16_t* A, int lda, const bf16_t* Bt, int ldb, int N, int K, const Epi& epi, char* smem) {
  constexpr int BN = NI * 64;
  const int nMt = NT / 128, nNt = N / BN, T = nMt * nNt;
  for (int t = obid(); t < T; t += gridDim.x) {
    const int s = (t & 7) * (T >> 3) + (t >> 3);
    const int grp = s / (8 * nNt), r = s % (8 * nNt);
    const int mt = grp * 8 + (r & 7), nt = r >> 3;
    gemm_tile<NI, Epi>(A, lda, Bt, ldb, K, mt * 128, nt * BN, epi, smem);
  }
}

__device__ __forceinline__ void prep_vectors(const Params& p, int odd) {
  const int tid_ = otid(); const int lane = tid_ & 63, w = tid_ >> 6;
  const bf16_t* P = p.R1;
  const int ldp = odd ? LDPO : LDPE;
  const int qcol = odd ? 2560 : 0, kcol = odd ? 3072 : 512;
  float* outk = p.out + (size_t)NT * DM + (odd ? (size_t)(524288 * 2 + 2097152 + 16384 + 128 + 2097152) : 0);
  const float qn = odd ? p.d_q_norm[lane] : 1.f, kn = odd ? p.d_k_norm[lane] : 1.f;
  const int i16 = lane & 15;
  const float inv = exp2f(-(float)i16 * (13.287712379549449f / 16.f));
  for (int row = obid() * 4 + w; row < NT; row += gridDim.x * 4) {
    const bf16_t* pr_ = P + (size_t)row * ldp;
    float v[10];
#pragma unroll
    for (int hv = 0; hv < 8; ++hv) v[hv] = bf2f(pr_[qcol + hv * 64 + lane]);
#pragma unroll
    for (int hv = 0; hv < 2; ++hv) v[8 + hv] = bf2f(pr_[kcol + hv * 64 + lane]);
    if (odd) {
#pragma unroll
      for (int hv = 0; hv < 10; ++hv) {
        const float ms = wave_sum(v[hv] * v[hv]) * (1.f / 64.f);
        v[hv] = v[hv] * rsqrtf(ms + 1e-6f) * (hv < 8 ? qn : kn);
      }
    }
    if (row < NPR) {
      outk[(size_t)row * 128 + lane] = v[8];
      outk[(size_t)row * 128 + 64 + lane] = v[9];
    } else {
      const int t = (row - NPR) & 2047;
      const float pos = (lane < 32) ? (float)(t >> 6) : (float)(t & 63);
      const float ang = pos * inv;
      const float cs = __cosf(ang), sn = __sinf(ang);
#pragma unroll
      for (int hv = 0; hv < 10; ++hv) {
        const float pr = __shfl_xor(v[hv], 16);
        v[hv] = ((lane & 16) == 0) ? (v[hv] * cs - pr * sn) : (pr * sn + v[hv] * cs);
      }
    }
#pragma unroll
    for (int hv = 0; hv < 8; ++hv) p.Qb[(size_t)row * 512 + hv * 64 + lane] = f2bf(v[hv] * (0.125f * LOG2E));
#pragma unroll
    for (int hv = 0; hv < 2; ++hv) p.Kb[(size_t)row * 128 + hv * 64 + lane] = f2bf(v[8 + hv]);
  }
}

__device__ __forceinline__ void prep_v(const Params& p, int odd, char* smem) {
  bf16_t* sT = (bf16_t*)smem;
  const bf16_t* P = p.R1;
  const int ldp = odd ? LDPO : LDPE;
  const int vcol = odd ? 3200 : 640;
  const float* cv = odd ? p.cache_d_v : p.cache_a_v;
  const float* ck = odd ? p.cache_d_k : p.cache_a_k;
  float* outv = p.out + (size_t)NT * DM + (odd ? (size_t)(524288 * 2 + 2097152 + 16384 + 128 + 2097152 + 524288) : (size_t)524288);
  const int tid = otid();
  const int nitems = 192 * 2 + 64 + 64;
  for (int it = obid(); it < nitems; it += gridDim.x) {
    if (it < 448) {
      bf16_t* dst; int dstride;
      if (it < 384) {
        const int tb = it >> 1, kv = it & 1, row0 = tb * 64;
#pragma unroll
        for (int i = 0; i < 16; ++i) {
          const int r = (tid >> 6) + 4 * i, d = tid & 63;
          const bf16_t raw = P[(size_t)(row0 + r) * ldp + vcol + kv * 64 + d];
          sT[d * 72 + r] = raw;
          if (row0 < NPR) outv[(size_t)(row0 + r) * 128 + kv * 64 + d] = bf2f(raw);
        }
        if (row0 < NPR) { const int b = row0 >> 8, pos0 = row0 & 255; dst = p.Vt + (size_t)((b * 2 + kv) * 64) * 256 + pos0; dstride = 256; }
        else { const int rr = row0 - NPR, b = rr >> 11, pos0 = rr & 2047; dst = p.Vt + 524288 + (size_t)((b * 2 + kv) * 64) * 2048 + pos0; dstride = 2048; }
      } else {
        const int j = it - 384, b = j >> 4, kv = (j >> 3) & 1, kb = j & 7;
#pragma unroll
        for (int i = 0; i < 16; ++i) {
          const int r = (tid >> 6) + 4 * i, d = tid & 63;
          sT[d * 72 + r] = f2bf(cv[((size_t)(b * 512 + kb * 64 + r) * 2 + kv) * 64 + d]);
        }
        dst = p.Vct + (size_t)((b * 2 + kv) * 64) * 512 + kb * 64; dstride = 512;
      }
      __syncthreads();
#pragma unroll
      for (int i = 0; i < 2; ++i) {
        const int id = tid + i * 256, d = id >> 3, ch = id & 7;
        *(uint4*)(dst + (size_t)d * dstride + ch * 8) = *(const uint4*)(sT + d * 72 + ch * 8);
      }
      __syncthreads();
    } else {
      const int j = it - 448;
#pragma unroll
      for (int i = 0; i < 16; ++i) {
        const int idx = j * 4096 + i * 256 + tid;
        p.Kc[idx] = f2bf(ck[idx]);
      }
    }
  }
}

__device__ __forceinline__ void attn_item(const Params& p, int odd, int item, char* smem) {
  bf16_t* Ks = (bf16_t*)smem;
  bf16_t* Vs = Ks + 64 * 72;
  const int tid = otid(), lane = tid & 63, g = tid >> 6, ql = lane & 31, h = lane >> 5;
  int b, kv, qb, L, seq_row0; bool sample;
  if (item < 512) { sample = true; b = item >> 7; kv = (item >> 6) & 1; qb = item & 63; L = 2048; seq_row0 = NPR + b * 2048; }
  else { const int it = item - 512; sample = false; b = it >> 4; kv = (it >> 3) & 1; qb = it & 7; L = 256; seq_row0 = b * 256; }
  const int t0 = qb * 32, q_row0 = seq_row0 + t0;
  const bf16_t* vbase = sample ? p.Vt + 524288 + (size_t)((b * 2 + kv) * 64) * 2048 : p.Vt + (size_t)((b * 2 + kv) * 64) * 256;
  const bf16_t* kbase = p.Kb + (size_t)seq_row0 * 128 + kv * 64;
  const bf16_t* kcb = p.Kc + (size_t)b * 512 * 128 + kv * 64;
  const bf16_t* vcb = p.Vct + (size_t)((b * 2 + kv) * 64) * 512;
  const bool band = sample && !odd;
  int lo = 0, hi = L >> 6;
  if (band) { lo = (t0 - 128) < 0 ? 0 : ((t0 - 128) >> 6); hi = (t0 + 160 + 63) >> 6; if (hi > 32) hi = 32; }
  const int nloc = hi - lo, ntiles = nloc + (sample ? 8 : 0);
  const int hq = kv * 4 + g;
  s16x8 qf[4];
#pragma unroll
  for (int kk = 0; kk < 4; ++kk) qf[kk] = *(const s16x8*)(p.Qb + (size_t)(q_row0 + ql) * 512 + hq * 64 + kk * 16 + h * 8);
  float m = -1e30f, lsum = 0.f;
  if (!odd) { m = p.a_sink[kv * 4 + g] * LOG2E; lsum = (h == 0) ? 1.f : 0.f; }
  f32x16 o0, o1;
#pragma unroll
  for (int r = 0; r < 16; ++r) { o0[r] = 0.f; o1[r] = 0.f; }
  u32x4 kr0, kr1, vr0, vr1;
  const int lr = tid >> 3, lch = tid & 7;
#define ATT_GL(ti_)                                                                                   \
  {                                                                                                   \
    const int ti__ = (ti_);                                                                           \
    const bf16_t* kp_; const bf16_t* vp_; size_t vst_;                                                \
    if (ti__ < nloc) { const int kt_ = lo + ti__; kp_ = kbase + (size_t)(kt_ * 64 + lr) * 128 + lch * 8; vp_ = vbase + (size_t)lr * L + kt_ * 64 + lch * 8; vst_ = (size_t)L; } \
    else { const int c_ = ti__ - nloc; kp_ = kcb + (size_t)(c_ * 64 + lr) * 128 + lch * 8; vp_ = vcb + (size_t)lr * 512 + c_ * 64 + lch * 8; vst_ = 512; } \
    kr0 = gload16(kp_); kr1 = gload16(kp_ + 32 * 128);                                                \
    vr0 = gload16(vp_); vr1 = gload16(vp_ + 32 * vst_);                                               \
  }
  ATT_GL(0);
  for (int ti = 0; ti < ntiles; ++ti) {
    vm_wait4(kr0, kr1, vr0, vr1);
    *(u32x4*)(Ks + lr * 72 + lch * 8) = kr0;
    *(u32x4*)(Ks + (lr + 32) * 72 + lch * 8) = kr1;
    *(u32x4*)(Vs + lr * 72 + lch * 8) = vr0;
    *(u32x4*)(Vs + (lr + 32) * 72 + lch * 8) = vr1;
    __syncthreads();
    if (ti + 1 < ntiles) ATT_GL(ti + 1);
    __builtin_amdgcn_sched_barrier(0);
    f32x16 s0, s1;
#pragma unroll
    for (int r = 0; r < 16; ++r) { s0[r] = 0.f; s1[r] = 0.f; }
#pragma unroll
    for (int kk = 0; kk < 4; ++kk) {
      const s16x8 a0 = *(const s16x8*)(Ks + ql * 72 + kk * 16 + h * 8);
      const s16x8 a1 = *(const s16x8*)(Ks + (32 + ql) * 72 + kk * 16 + h * 8);
      s0 = __builtin_amdgcn_mfma_f32_32x32x16_bf16(a0, qf[kk], s0, 0, 0, 0);
      s1 = __builtin_amdgcn_mfma_f32_32x32x16_bf16(a1, qf[kk], s1, 0, 0, 0);
    }
    if (band && ti < nloc) {
      const int kbase_pos = (lo + ti) * 64 + 4 * h - (t0 + ql);
#pragma unroll
      for (int r = 0; r < 16; ++r) {
        const int dlt = kbase_pos + (r & 3) + 8 * (r >> 2);
        if (dlt > 128 || dlt < -128) s0[r] = -1e30f;
        const int dl2 = dlt + 32;
        if (dl2 > 128 || dl2 < -128) s1[r] = -1e30f;
      }
    }
    float mx = -1e30f;
#pragma unroll
    for (int r = 0; r < 16; ++r) mx = fmaxf(mx, fmaxf(s0[r], s1[r]));
    mx = fmaxf(mx, __shfl_xor(mx, 32));
    const float mnew = fmaxf(m, mx);
    const float alpha = __builtin_amdgcn_exp2f(m - mnew);
    m = mnew;
    float ps = 0.f;
#pragma unroll
    for (int r = 0; r < 16; ++r) {
      s0[r] = __builtin_amdgcn_exp2f(s0[r] - mnew);
      s1[r] = __builtin_amdgcn_exp2f(s1[r] - mnew);
      ps += s0[r] + s1[r];
    }
    lsum = lsum * alpha + ps;
#pragma unroll
    for (int r = 0; r < 16; ++r) { o0[r] *= alpha; o1[r] *= alpha; }
#pragma unroll
    for (int ks = 0; ks < 4; ++ks) {
      const int kbk = ks >> 1, sp = ks & 1;
      s16x8 pf;
#pragma unroll
      for (int j = 0; j < 8; ++j) pf[j] = (short)f2bf(kbk == 0 ? s0[8 * sp + j] : s1[8 * sp + j]);
      const int keyoff = kbk * 32 + 16 * sp + 4 * h;
#pragma unroll
      for (int db = 0; db < 2; ++db) {
        const bf16_t* vp = Vs + (db * 32 + ql) * 72 + keyoff;
        const s16x4 lo4 = *(const s16x4*)(vp);
        const s16x4 hi4 = *(const s16x4*)(vp + 8);
        s16x8 vf;
        vf[0] = lo4[0]; vf[1] = lo4[1]; vf[2] = lo4[2]; vf[3] = lo4[3];
        vf[4] = hi4[0]; vf[5] = hi4[1]; vf[6] = hi4[2]; vf[7] = hi4[3];
        if (db == 0) o0 = __builtin_amdgcn_mfma_f32_32x32x16_bf16(vf, pf, o0, 0, 0, 0);
        else o1 = __builtin_amdgcn_mfma_f32_32x32x16_bf16(vf, pf, o1, 0, 0, 0);
      }
    }
    __syncthreads();
  }
  const float ltot = lsum + __shfl_xor(lsum, 32);
  const float inv = __builtin_amdgcn_rcpf(ltot);
  bf16_t* cat = p.Hb + (size_t)(q_row0 + ql) * DM + (odd ? 512 : 0) + hq * 64;
#pragma unroll
  for (int rg = 0; rg < 4; ++rg) {
    uint2 w0, w1;
    w0.x = pk2(o0[rg * 4 + 0] * inv, o0[rg * 4 + 1] * inv); w0.y = pk2(o0[rg * 4 + 2] * inv, o0[rg * 4 + 3] * inv);
    w1.x = pk2(o1[rg * 4 + 0] * inv, o1[rg * 4 + 1] * inv); w1.y = pk2(o1[rg * 4 + 2] * inv, o1[rg * 4 + 3] * inv);
    *(uint2*)(cat + 8 * rg + 4 * h) = w0;
    *(uint2*)(cat + 32 + 8 * rg + 4 * h) = w1;
  }
}

__device__ __forceinline__ void mlstm_item(const Params& p, int item, char* smem) {
  bf16_t* sQ = (bf16_t*)smem;
  bf16_t* sK = sQ + 64 * 136;
  bf16_t* sKt = sK + 64 * 136;
  bf16_t* sVt = sKt + 128 * 72;
  bf16_t* sW = sVt + 32 * 72;
  bf16_t* sCt = sW + 64 * 72;
  float* sU = (float*)(sCt + 32 * 136);
  float* sM = sU + 64;
  float* sA = sM + 64;
  float* sWs = sA + 64;
  float* sCl = sWs + 64;
  float* sMisc = sCl + 64;
  const bf16_t* P = p.R1;
  const int ldp = LDPE;
  const float kscale = 0.08838834764831845f;
  const int tid = otid(), lane = tid & 63, w = tid >> 6, l15 = lane & 15, kg = lane >> 4;
  bool sample; int b, head, dir, slice, L, seq_row0;
  if (item < 160) { sample = true; const int s5 = item / 5; slice = item % 5; b = s5 >> 3; head = (s5 >> 1) & 3; dir = s5 & 1; L = 2048; seq_row0 = NPR + b * 2048; }
  else { const int it = item - 160; sample = false; const int s5 = it / 5; slice = it % 5; b = s5 >> 3; head = (s5 >> 1) & 3; dir = s5 & 1; L = 256; seq_row0 = b * 256; }
  const bool nsl = (slice == 4);
  const int nch = L >> 6;
  float m = 0.f;
  f32x4 cacc[2][2];
#pragma unroll
  for (int rb = 0; rb < 2; ++rb)
#pragma unroll
    for (int nb = 0; nb < 2; ++nb)
#pragma unroll
      for (int r = 0; r < 4; ++r) cacc[rb][nb][r] = 0.f;
  if (sample) {
    const size_t sidx = (size_t)((b * 2 + dir) * 4 + head);
    m = p.state_b_m[sidx];
#pragma unroll
    for (int rb = 0; rb < 2; ++rb)
#pragma unroll
      for (int nb = 0; nb < 2; ++nb)
#pragma unroll
        for (int r = 0; r < 4; ++r) {
          const int d = 32 * w + rb * 16 + 4 * kg + r, e = nb * 16 + l15;
          float v;
          if (!nsl) v = p.state_b_C[(sidx * 128 + d) * 128 + slice * 32 + e];
          else v = (e == 0) ? p.state_b_n[sidx * 128 + d] : 0.f;
          cacc[rb][nb][r] = v;
        }
  }
#pragma unroll
  for (int rb = 0; rb < 2; ++rb)
#pragma unroll
    for (int nb = 0; nb < 2; ++nb) {
      uint2 o; o.x = pk2(cacc[rb][nb][0], cacc[rb][nb][1]); o.y = pk2(cacc[rb][nb][2], cacc[rb][nb][3]);
      *(uint2*)(sCt + (nb * 16 + l15) * 136 + 32 * w + rb * 16 + 4 * kg) = o;
    }
  const float bias_i = p.b_gate_bias[(2 * dir) * 4 + head], bias_f = p.b_gate_bias[(2 * dir + 1) * 4 + head];
  float* NUM = p.Z + (size_t)dir * NT * 512;
  u32x4 pq[4], pk[4], pv;
  unsigned pgi, pgf;
#define ML_ISSUE(cc_)                                                                                         \
  {                                                                                                           \
    const int c__ = (cc_);                                                                                    \
    {                                                                                                         \
      const int pos_ = dir ? (L - 1 - (c__ * 64 + lane)) : (c__ * 64 + lane);                                 \
      const bf16_t* gp_ = P + (size_t)(seq_row0 + pos_) * ldp + 2304;                                         \
      pgi = gload2(gp_ + (2 * dir) * 4 + head);                                                               \
      pgf = gload2(gp_ + (2 * dir + 1) * 4 + head);                                                           \
    }                                                                                                         \
    _Pragma("unroll") for (int i = 0; i < 4; ++i) {                                                           \
      const int r_ = tid & 63, ch_ = (tid >> 6) + 4 * i;                                                      \
      const int pos_ = dir ? (L - 1 - (c__ * 64 + r_)) : (c__ * 64 + r_);                                     \
      const bf16_t* rp_ = P + (size_t)(seq_row0 + pos_) * ldp + head * 128 + ch_ * 8;                         \
      pq[i] = gload16(rp_ + 768);                                                                             \
      pk[i] = gload16(rp_ + 1280);                                                                            \
    }                                                                                                         \
    if (!nsl) {                                                                                               \
      const int r_ = tid & 63, ch_ = tid >> 6;                                                                \
      const int pos_ = dir ? (L - 1 - (c__ * 64 + r_)) : (c__ * 64 + r_);                                     \
      pv = gload16(P + (size_t)(seq_row0 + pos_) * ldp + 1792 + head * 128 + slice * 32 + ch_ * 8);          \
    }                                                                                                         \
  }
  pv = (u32x4){0u, 0u, 0u, 0u};
  ML_ISSUE(0);
  for (int c = 0; c < nch; ++c) {
    asm volatile("s_waitcnt vmcnt(0)" : "+v"(pgi), "+v"(pgf), "+v"(pq[0]), "+v"(pq[1]), "+v"(pq[2]), "+v"(pq[3]), "+v"(pk[0]), "+v"(pk[1]), "+v"(pk[2]), "+v"(pk[3]), "+v"(pv) : : "memory");
    {
      const float ig = bf2f((bf16_t)pgi) + bias_i;
      const float fr = bf2f((bf16_t)pgf) + bias_f;
      const float lf = fminf(fr, 0.f) - __logf(1.f + __expf(-fabsf(fr)));
      float bc = lf;
#pragma unroll
      for (int o = 1; o < 64; o <<= 1) { const float y = __shfl_up(bc, o); if (lane >= o) bc += y; }
      const float u = ig - bc;
      float pm = u;
#pragma unroll
      for (int o = 1; o < 64; o <<= 1) { const float y = __shfl_up(pm, o); if (lane >= o) pm = fmaxf(pm, y); }
      const float M = fmaxf(m, pm);
      const float Mlast = __shfl(M, 63), bclast = __shfl(bc, 63);
      if (w == 0) {
        sU[lane] = u; sM[lane] = M; sA[lane] = __expf(m - M);
        sWs[lane] = __expf(u - Mlast) * kscale;
        sCl[lane] = __expf(-(bc + M));
        if (lane == 0) { sMisc[0] = bclast + Mlast; sMisc[1] = __expf(m - Mlast); }
      }
    }
    __syncthreads();
#pragma unroll
    for (int i = 0; i < 4; ++i) {
      const int r = tid & 63, ch = (tid >> 6) + 4 * i;
      *(u32x4*)(sQ + r * 136 + ch * 8) = pq[i];
      *(u32x4*)(sK + r * 136 + ch * 8) = pk[i];
      const float ws = sWs[r];
#pragma unroll
      for (int j = 0; j < 4; ++j) {
        sKt[(ch * 8 + 2 * j) * 72 + r] = f2bf(bf2f((bf16_t)(pk[i][j] & 0xffffu)) * ws);
        sKt[(ch * 8 + 2 * j + 1) * 72 + r] = f2bf(bf2f((bf16_t)(pk[i][j] >> 16)) * ws);
      }
    }
    {
      const int r = tid & 63, ch = tid >> 6;
      if (!nsl) {
#pragma unroll
        for (int j = 0; j < 4; ++j) {
          sVt[(ch * 8 + 2 * j) * 72 + r] = (bf16_t)(pv[j] & 0xffffu);
          sVt[(ch * 8 + 2 * j + 1) * 72 + r] = (bf16_t)(pv[j] >> 16);
        }
      } else {
#pragma unroll
        for (int j = 0; j < 8; ++j) sVt[(ch * 8 + j) * 72 + r] = (ch == 0 && j == 0) ? (bf16_t)0x3F80 : (bf16_t)0;
      }
    }
    __builtin_amdgcn_sched_barrier(0);
    if (c + 1 < nch) ML_ISSUE(c + 1);
    __builtin_amdgcn_sched_barrier(0);
    __syncthreads();
    {
      const int wr = w >> 1, wc = w & 1, h = lane >> 5, l31 = lane & 31;
      f32x16 sacc;
#pragma unroll
      for (int r = 0; r < 16; ++r) sacc[r] = 0.f;
      if (!(wr == 0 && wc == 1)) {
#pragma unroll
        for (int kk = 0; kk < 8; ++kk) {
          const s16x8 a = *(const s16x8*)(sQ + (wr * 32 + l31) * 136 + kk * 16 + h * 8);
          const s16x8 bb = *(const s16x8*)(sK + (wc * 32 + l31) * 136 + kk * 16 + h * 8);
          sacc = __builtin_amdgcn_mfma_f32_32x32x16_bf16(a, bb, sacc, 0, 0, 0);
        }
      }
      const int s = wc * 32 + l31;
      const float us = sU[s];
#pragma unroll
      for (int r = 0; r < 16; ++r) {
        const int t = wr * 32 + (r & 3) + 8 * (r >> 2) + 4 * h;
        const float wv = (s <= t) ? __expf(us - sM[t]) * sacc[r] * kscale : 0.f;
        sW[t * 72 + s] = f2bf(wv);
      }
    }
    __syncthreads();
    {
      f32x4 a1[2], a2[2];
#pragma unroll
      for (int nb = 0; nb < 2; ++nb)
#pragma unroll
        for (int r = 0; r < 4; ++r) { a1[nb][r] = 0.f; a2[nb][r] = 0.f; }
#pragma unroll
      for (int kk = 0; kk < 4; ++kk) {
        const s16x8 a = *(const s16x8*)(sQ + (16 * w + l15) * 136 + kk * 32 + kg * 8);
#pragma unroll
        for (int nb = 0; nb < 2; ++nb) {
          const s16x8 bb = *(const s16x8*)(sCt + (nb * 16 + l15) * 136 + kk * 32 + kg * 8);
          a1[nb] = mfma16_safe(a, bb, a1[nb]);
        }
      }
#pragma unroll
      for (int kk = 0; kk < 2; ++kk) {
        const s16x8 a = *(const s16x8*)(sW + (16 * w + l15) * 72 + kk * 32 + kg * 8);
#pragma unroll
        for (int nb = 0; nb < 2; ++nb) {
          const s16x8 bb = *(const s16x8*)(sVt + (nb * 16 + l15) * 72 + kk * 32 + kg * 8);
          a2[nb] = mfma16_safe(a, bb, a2[nb]);
        }
      }
#pragma unroll
      for (int r = 0; r < 4; ++r) {
        const int t = 16 * w + 4 * kg + r;
        const int pos = dir ? (L - 1 - (c * 64 + t)) : (c * 64 + t);
        const size_t row = (size_t)(seq_row0 + pos);
        const float at = sA[t];
#pragma unroll
        for (int nb = 0; nb < 2; ++nb) {
          const float val = at * a1[nb][r] + a2[nb][r];
          const int e = nb * 16 + l15;
          if (!nsl) NUM[row * 512 + head * 128 + slice * 32 + e] = val;
          else if (e == 0) { p.DEN[((size_t)dir * NT + row) * 4 + head] = val; p.CL[((size_t)dir * NT + row) * 4 + head] = sCl[t]; }
        }
      }
      const float decay = sMisc[1];
#pragma unroll
      for (int rb = 0; rb < 2; ++rb)
#pragma unroll
        for (int nb = 0; nb < 2; ++nb)
#pragma unroll
          for (int r = 0; r < 4; ++r) cacc[rb][nb][r] *= decay;
#pragma unroll
      for (int kk = 0; kk < 2; ++kk)
#pragma unroll
        for (int rb = 0; rb < 2; ++rb) {
          const s16x8 a = *(const s16x8*)(sKt + (32 * w + rb * 16 + l15) * 72 + kk * 32 + kg * 8);
#pragma unroll
          for (int nb = 0; nb < 2; ++nb) {
            const s16x8 bb = *(const s16x8*)(sVt + (nb * 16 + l15) * 72 + kk * 32 + kg * 8);
            cacc[rb][nb] = mfma16_safe(a, bb, cacc[rb][nb]);
          }
        }
      m = sMisc[0];
    }
    __syncthreads();
#pragma unroll
    for (int rb = 0; rb < 2; ++rb)
#pragma unroll
      for (int nb = 0; nb < 2; ++nb) {
        uint2 o; o.x = pk2(cacc[rb][nb][0], cacc[rb][nb][1]); o.y = pk2(cacc[rb][nb][2], cacc[rb][nb][3]);
        *(uint2*)(sCt + (nb * 16 + l15) * 136 + 32 * w + rb * 16 + 4 * kg) = o;
      }
  }
  if (!sample) {
    float* oC = p.out + (size_t)NT * DM + 524288 * 2;
    float* oN = oC + 2097152;
    float* oM = oN + 16384;
    const size_t sidx = (size_t)((b * 2 + dir) * 4 + head);
#pragma unroll
    for (int rb = 0; rb < 2; ++rb)
#pragma unroll
      for (int nb = 0; nb < 2; ++nb)
#pragma unroll
        for (int r = 0; r < 4; ++r) {
          const int d = 32 * w + rb * 16 + 4 * kg + r, e = nb * 16 + l15;
          if (!nsl) oC[(sidx * 128 + d) * 128 + slice * 32 + e] = cacc[rb][nb][r];
          else if (e == 0) oN[sidx * 128 + d] = cacc[rb][nb][r];
        }
    if (nsl && tid == 0) oM[sidx] = m;
  }
  __syncthreads();
}

__device__ __forceinline__ void hgrn_pre(const Params& p, char* smem) {
  float* sTot = (float*)smem;
  const bf16_t* P = p.R1;
  const int ldp = LDPO;
  const int tid = otid(), d = tid & 127, half = tid >> 7;
  for (int it = obid(); it < 3072; it += gridDim.x) {
    const int dir = it / 1536, rem = it % 1536, gc = rem >> 2, head = rem & 3;
    const float lbv = __builtin_amdgcn_rcpf(1.f + __expf(p.c_lb_logits[head * 128 + d] - p.c_lb_logits[512 + head * 128 + d]));
    const int fcol = (dir ? 1024 : 512) + head * 128 + d;
    float Al[16], qv[16], kvv[16];
    float run = 0.f;
#pragma unroll
    for (int tt = 0; tt < 16; ++tt) {
      const int t = half * 16 + tt;
      const bf16_t* rp = P + (size_t)(gc * 32 + (dir ? 31 - t : t)) * ldp;
      const float fp = bf2f(rp[fcol]);
      const float cq = bf2f(rp[head * 128 + d]);
      const float f = lbv + (1.f - lbv) * sigmoidf_(fp);
      run += __logf(f);
      Al[tt] = run; kvv[tt] = 1.f - f; qv[tt] = cq * sigmoidf_(cq);
    }
    sTot[half * 128 + d] = run;
    __syncthreads();
    const float tot0 = sTot[d], tot1 = sTot[128 + d];
    const float Atot = tot0 + tot1, off = half ? tot0 : 0.f;
    const size_t base = (size_t)((dir * 384 + gc) * 4 + head) * 4096;
    bf16_t* hk = (dir ? p.HK1 : p.HK0) + (size_t)(gc * 4 + head) * 4096;
    unsigned kt[8];
#pragma unroll
    for (int tt = 0; tt < 16; ++tt) {
      const int t = half * 16 + tt;
      const float A = Al[tt] + off;
      p.HQ[base + t * 128 + d] = f2bf(qv[tt] * __expf(A - tot0));
      const bf16_t kb = f2bf(kvv[tt] * __expf(tot0 - A));
      hk[t * 128 + d] = kb;
      if (tt & 1) kt[tt >> 1] |= ((unsigned)kb << 16); else kt[tt >> 1] = (unsigned)kb;
    }
    {
      u32x4 w0 = {kt[0], kt[1], kt[2], kt[3]}, w1 = {kt[4], kt[5], kt[6], kt[7]};
      *(u32x4*)(p.HKt + base + d * 32 + half * 16) = w0;
      *(u32x4*)(p.HKt + base + d * 32 + half * 16 + 8) = w1;
    }
    if (half == 0) {
      float* ev = p.EV + (size_t)((dir * 384 + gc) * 4 + head) * 384;
      ev[d] = __expf(tot0); ev[128 + d] = __expf(Atot - tot0); ev[256 + d] = __expf(Atot);
    }
    __syncthreads();
  }
}

__device__ __forceinline__ void hgrn_item(const Params& p, int item, char* smem) {
  bf16_t* sQt = (bf16_t*)smem;
  bf16_t* sKt_ = sQt + 32 * 136;
  bf16_t* sK2t = sKt_ + 32 * 136;
  bf16_t* sVt = sK2t + 128 * 40;
  bf16_t* sAtt = sVt + 32 * 40;
  bf16_t* sSt = sAtt + 32 * 40;
  const bf16_t* P = p.R1;
  const int ldp = LDPO;
  const int tid = otid(), lane = tid & 63, w = tid >> 6, l15 = lane & 15, kg = lane >> 4;
  bool sample; int b, head, dir, slice, L, seq_row0;
  if (item < 128) { sample = true; const int s4 = item >> 2; slice = item & 3; b = s4 >> 3; head = (s4 >> 1) & 3; dir = s4 & 1; L = 2048; seq_row0 = NPR + b * 2048; }
  else { const int it = item - 128; sample = false; const int s4 = it >> 2; slice = it & 3; b = s4 >> 3; head = (s4 >> 1) & 3; dir = s4 & 1; L = 256; seq_row0 = b * 256; }
  const int nch = L >> 5, gc0 = seq_row0 >> 5;
  const bf16_t* HKd = dir ? p.HK1 : p.HK0;
  f32x4 sacc[2][2];
#pragma unroll
  for (int rb = 0; rb < 2; ++rb)
#pragma unroll
    for (int nb = 0; nb < 2; ++nb)
#pragma unroll
      for (int r = 0; r < 4; ++r) {
        float v = 0.f;
        if (sample) {
          const int dd = 32 * w + rb * 16 + 4 * kg + r, e = nb * 16 + l15;
          v = p.state_c_S[(((size_t)((b * 2 + dir) * 4 + head)) * 128 + dd) * 128 + slice * 32 + e];
        }
        sacc[rb][nb][r] = v;
      }
  float* O = p.Z + (size_t)dir * NT * 512;
  u32x4 rq[2], rk[2], rkt[2], rv, ev[3][2];
  rv = (u32x4){0u, 0u, 0u, 0u};
#define HG_ISSUE(cc_)                                                                                          \
  {                                                                                                            \
    const int gc_ = gc0 + (dir ? nch - 1 - (cc_) : (cc_));                                                     \
    const size_t base_ = (size_t)((dir * 384 + gc_) * 4 + head) * 4096;                                        \
    const size_t kb_ = (size_t)(gc_ * 4 + head) * 4096;                                                        \
    _Pragma("unroll") for (int i = 0; i < 2; ++i) {                                                            \
      const int id_ = tid + i * 256;                                                                           \
      rq[i] = gload16(p.HQ + base_ + id_ * 8);                                                                 \
      rk[i] = gload16(HKd + kb_ + id_ * 8);                                                                    \
      rkt[i] = gload16(p.HKt + base_ + id_ * 8);                                                               \
    }                                                                                                          \
    if (tid < 128) {                                                                                           \
      const int r_ = tid & 31, ch_ = tid >> 5;                                                                 \
      rv = gload16(P + (size_t)(gc_ * 32 + (dir ? 31 - r_ : r_)) * ldp + 1536 + head * 128 + slice * 32 + ch_ * 8); \
    }                                                                                                          \
    const float* evb_ = p.EV + (size_t)((dir * 384 + gc_) * 4 + head) * 384 + 32 * w + 4 * kg;                 \
    _Pragma("unroll") for (int x = 0; x < 3; ++x) {                                                            \
      ev[x][0] = gload16(evb_ + x * 128);                                                                      \
      ev[x][1] = gload16(evb_ + x * 128 + 16);                                                                 \
    }                                                                                                          \
  }
#define HG_WAIT() asm volatile("s_waitcnt vmcnt(0)" : "+v"(rq[0]), "+v"(rq[1]), "+v"(rk[0]), "+v"(rk[1]), "+v"(rkt[0]), "+v"(rkt[1]), "+v"(rv), "+v"(ev[0][0]), "+v"(ev[0][1]), "+v"(ev[1][0]), "+v"(ev[1][1]), "+v"(ev[2][0]), "+v"(ev[2][1]) : : "memory")
  f32x4 curE[2], cure2[2];
#define HG_STAGE()                                                                                             \
  {                                                                                                            \
    _Pragma("unroll") for (int i = 0; i < 2; ++i) {                                                            \
      const int id_ = tid + i * 256;                                                                           \
      *(u32x4*)(sQt + (id_ >> 4) * 136 + (id_ & 15) * 8) = rq[i];                                              \
      *(u32x4*)(sKt_ + (id_ >> 4) * 136 + (id_ & 15) * 8) = rk[i];                                             \
      *(u32x4*)(sK2t + (id_ >> 2) * 40 + (id_ & 3) * 8) = rkt[i];                                              \
    }                                                                                                          \
    if (tid < 128) {                                                                                           \
      const int r_ = tid & 31, ch_ = tid >> 5;                                                                 \
      _Pragma("unroll") for (int j = 0; j < 4; ++j) {                                                          \
        sVt[(ch_ * 8 + 2 * j) * 40 + r_] = (bf16_t)(rv[j] & 0xffffu);                                          \
        sVt[(ch_ * 8 + 2 * j + 1) * 40 + r_] = (bf16_t)(rv[j] >> 16);                                          \
      }                                                                                                        \
    }                                                                                                          \
    _Pragma("unroll") for (int rb = 0; rb < 2; ++rb) {                                                         \
      f32x4 e1_;                                                                                               \
      _Pragma("unroll") for (int r = 0; r < 4; ++r) {                                                          \
        e1_[r] = __uint_as_float(ev[0][rb][r]);                                                                \
        cure2[rb][r] = __uint_as_float(ev[1][rb][r]);                                                          \
        curE[rb][r] = __uint_as_float(ev[2][rb][r]);                                                           \
      }                                                                                                        \
      _Pragma("unroll") for (int nb = 0; nb < 2; ++nb) {                                                       \
        uint2 o_;                                                                                              \
        o_.x = pk2(sacc[rb][nb][0] * e1_[0], sacc[rb][nb][1] * e1_[1]);                                        \
        o_.y = pk2(sacc[rb][nb][2] * e1_[2], sacc[rb][nb][3] * e1_[3]);                                        \
        *(uint2*)(sSt + (nb * 16 + l15) * 136 + 32 * w + rb * 16 + 4 * kg) = o_;                               \
      }                                                                                                        \
    }                                                                                                          \
  }
  HG_ISSUE(0);
  HG_WAIT();
  HG_STAGE();
  __syncthreads();
  const int br = w >> 1, bcn = w & 1;
  for (int c = 0; c < nch; ++c) {
    if (c + 1 < nch) HG_ISSUE(c + 1);
    __builtin_amdgcn_sched_barrier(0);
    {
      f32x4 acc;
#pragma unroll
      for (int r = 0; r < 4; ++r) acc[r] = 0.f;
      if (!(br == 0 && bcn == 1)) {
#pragma unroll
        for (int kk = 0; kk < 4; ++kk) {
          const s16x8 a = *(const s16x8*)(sQt + (br * 16 + l15) * 136 + kk * 32 + kg * 8);
          const s16x8 bb = *(const s16x8*)(sKt_ + (bcn * 16 + l15) * 136 + kk * 32 + kg * 8);
          acc = mfma16_safe(a, bb, acc);
        }
      }
#pragma unroll
      for (int r = 0; r < 4; ++r) {
        const int t = br * 16 + 4 * kg + r, sidx = bcn * 16 + l15;
        sAtt[t * 40 + sidx] = (sidx <= t) ? f2bf(acc[r]) : (bf16_t)0;
      }
    }
    __syncthreads();
    {
      f32x4 oacc;
#pragma unroll
      for (int r = 0; r < 4; ++r) oacc[r] = 0.f;
#pragma unroll
      for (int kk = 0; kk < 4; ++kk) {
        const s16x8 a = *(const s16x8*)(sQt + (br * 16 + l15) * 136 + kk * 32 + kg * 8);
        const s16x8 bb = *(const s16x8*)(sSt + (bcn * 16 + l15) * 136 + kk * 32 + kg * 8);
        oacc = mfma16_safe(a, bb, oacc);
      }
      {
        const s16x8 a = *(const s16x8*)(sAtt + (br * 16 + l15) * 40 + kg * 8);
        const s16x8 bb = *(const s16x8*)(sVt + (bcn * 16 + l15) * 40 + kg * 8);
        oacc = mfma16_safe(a, bb, oacc);
      }
      const int gc = gc0 + (dir ? nch - 1 - c : c);
#pragma unroll
      for (int r = 0; r < 4; ++r) {
        const int t = br * 16 + 4 * kg + r, e = bcn * 16 + l15;
        O[(size_t)(gc * 32 + (dir ? 31 - t : t)) * 512 + head * 128 + slice * 32 + e] = oacc[r];
      }
#pragma unroll
      for (int rb = 0; rb < 2; ++rb) {
        const s16x8 a = *(const s16x8*)(sK2t + (32 * w + rb * 16 + l15) * 40 + kg * 8);
#pragma unroll
        for (int nb = 0; nb < 2; ++nb) {
          const s16x8 bb = *(const s16x8*)(sVt + (nb * 16 + l15) * 40 + kg * 8);
          f32x4 ds;
#pragma unroll
          for (int r = 0; r < 4; ++r) ds[r] = 0.f;
          ds = mfma16_safe(a, bb, ds);
#pragma unroll
          for (int r = 0; r < 4; ++r) sacc[rb][nb][r] = curE[rb][r] * sacc[rb][nb][r] + cure2[rb][r] * ds[r];
        }
      }
    }
    __syncthreads();
    if (c + 1 < nch) {
      HG_WAIT();
      HG_STAGE();
    }
    __syncthreads();
  }
  if (!sample) {
    float* oS = p.out + (size_t)NT * DM + 524288 * 2 + 2097152 + 16384 + 128;
#pragma unroll
    for (int rb = 0; rb < 2; ++rb)
#pragma unroll
      for (int nb = 0; nb < 2; ++nb)
#pragma unroll
        for (int r = 0; r < 4; ++r) {
          const int dd = 32 * w + rb * 16 + 4 * kg + r, e = nb * 16 + l15;
          oS[(((size_t)((b * 2 + dir) * 4 + head)) * 128 + dd) * 128 + slice * 32 + e] = sacc[rb][nb][r];
        }
  }
  __syncthreads();
}

__device__ __forceinline__ void combine_phase(const Params& p, int odd) {
  const int tid_ = otid(); const int lane = tid_ & 63, w = tid_ >> 6;
  const bf16_t* P = p.R1;
  const float* N0 = p.Z;
  const float* N1 = p.Z + (size_t)NT * 512;
  const float* gp = odd ? p.c_norm_g : p.b_norm_g;
  float g0[4], g1[4];
#pragma unroll
  for (int hd = 0; hd < 4; ++hd) { g0[hd] = gp[hd * 128 + lane]; g1[hd] = gp[hd * 128 + 64 + lane]; }
  const int ldp = odd ? LDPO : LDPE, gcol = odd ? 2048 : 2320, ocol = odd ? 0 : 512;
  for (int row = obid() * 4 + w; row < NT; row += gridDim.x * 4) {
    float a0[4], a1[4], b0[4], b1[4], gt0[4], gt1[4], i0[4], i1[4];
#pragma unroll
    for (int hd = 0; hd < 4; ++hd) {
      const size_t o = (size_t)row * 512 + hd * 128;
      a0[hd] = N0[o + lane]; a1[hd] = N0[o + 64 + lane]; b0[hd] = N1[o + lane]; b1[hd] = N1[o + 64 + lane];
      gt0[hd] = bf2f(P[(size_t)row * ldp + gcol + hd * 128 + lane]);
      gt1[hd] = bf2f(P[(size_t)row * ldp + gcol + hd * 128 + 64 + lane]);
      i0[hd] = 1.f; i1[hd] = 1.f;
      if (!odd) {
        const float d0 = p.DEN[((size_t)row) * 4 + hd], c0 = p.CL[((size_t)row) * 4 + hd];
        const float d1 = p.DEN[((size_t)NT + row) * 4 + hd], c1 = p.CL[((size_t)NT + row) * 4 + hd];
        i0[hd] = __builtin_amdgcn_rcpf(fmaxf(fabsf(d0), c0)); i1[hd] = __builtin_amdgcn_rcpf(fmaxf(fabsf(d1), c1));
      }
    }
#pragma unroll
    for (int hd = 0; hd < 4; ++hd) {
      const float h0 = a0[hd] * i0[hd] + b0[hd] * i1[hd];
      const float h1 = a1[hd] * i0[hd] + b1[hd] * i1[hd];
      const float ms = wave_sum(h0 * h0 + h1 * h1) * (1.f / 128.f);
      const float rs = rsqrtf(ms + 1e-6f);
      const float m0 = odd ? gt0[hd] * sigmoidf_(gt0[hd]) : sigmoidf_(gt0[hd]);
      const float m1 = odd ? gt1[hd] * sigmoidf_(gt1[hd]) : sigmoidf_(gt1[hd]);
      p.Hb[(size_t)row * DM + ocol + hd * 128 + lane] = f2bf(m0 * h0 * rs * g0[hd]);
      p.Hb[(size_t)row * DM + ocol + hd * 128 + 64 + lane] = f2bf(m1 * h1 * rs * g1[hd]);
    }
  }
}

__device__ __forceinline__ void my_gsync(unsigned* bar, unsigned& epoch, unsigned nblocks) {
  asm volatile("s_waitcnt vmcnt(0) lgkmcnt(0)" ::: "memory");
  __syncthreads();
  epoch += 1;
  if (threadIdx.x == 0) {
    __builtin_amdgcn_fence(__ATOMIC_RELEASE, "agent");
    asm volatile("s_waitcnt vmcnt(0) lgkmcnt(0)" ::: "memory");
    const unsigned g = blockIdx.x & 31u;
    const unsigned gsize = (nblocks >> 5) + ((g < (nblocks & 31u)) ? 1u : 0u);
    const unsigned old = __hip_atomic_fetch_add(&bar[g * 64], 1u, __ATOMIC_RELAXED, __HIP_MEMORY_SCOPE_AGENT);
    if (old + 1 == epoch * gsize) {
      const unsigned ngroups = nblocks < 32u ? nblocks : 32u;
      const unsigned old2 = __hip_atomic_fetch_add(&bar[32 * 64], 1u, __ATOMIC_RELAXED, __HIP_MEMORY_SCOPE_AGENT);
      if (old2 + 1 == epoch * ngroups) __hip_atomic_store(&bar[33 * 64], epoch, __ATOMIC_RELAXED, __HIP_MEMORY_SCOPE_AGENT);
    }
    while (__hip_atomic_load(&bar[33 * 64], __ATOMIC_RELAXED, __HIP_MEMORY_SCOPE_AGENT) < epoch) __builtin_amdgcn_s_sleep(1);
    __builtin_amdgcn_fence(__ATOMIC_ACQUIRE, "agent");
  }
  __syncthreads();
  __builtin_amdgcn_fence(__ATOMIC_ACQUIRE, "agent");
}
#define XB_XCNT(j) (4096 + 64 * (j))
#define XB_XSUB(j) (5120 + 64 * (j))
#define XB_XGEN(j) (6144 + 64 * (j))
#define XB_TOP 7168
#define XB_TOPGEN 7232
__device__ __forceinline__ unsigned xb_ld(unsigned* q) { return __hip_atomic_load(q, __ATOMIC_RELAXED, __HIP_MEMORY_SCOPE_AGENT); }
__device__ __forceinline__ unsigned xb_add(unsigned* q) { return __hip_atomic_fetch_add(q, 1u, __ATOMIC_RELAXED, __HIP_MEMORY_SCOPE_AGENT); }
__device__ __forceinline__ void xb_st(unsigned* q, unsigned v) { __hip_atomic_store(q, v, __ATOMIC_RELAXED, __HIP_MEMORY_SCOPE_AGENT); }
__device__ __forceinline__ void xsync(unsigned* bar, unsigned& epoch, unsigned xcc, unsigned cntx, unsigned nxcc) {
  asm volatile("s_waitcnt vmcnt(0) lgkmcnt(0)" ::: "memory");
  __syncthreads();
  epoch += 1;
  if (threadIdx.x == 0) {
    const unsigned old = xb_add(&bar[XB_XSUB(xcc)]);
    if (old + 1 == epoch * cntx) {
      __builtin_amdgcn_fence(__ATOMIC_RELEASE, "agent");
      asm volatile("s_waitcnt vmcnt(0) lgkmcnt(0)" ::: "memory");
      const unsigned old2 = xb_add(&bar[XB_TOP]);
      if (old2 + 1 == epoch * nxcc) xb_st(&bar[XB_TOPGEN], epoch);
      else while (xb_ld(&bar[XB_TOPGEN]) < epoch) __builtin_amdgcn_s_sleep(1);
      xb_st(&bar[XB_XGEN(xcc)], epoch);
    } else {
      while (xb_ld(&bar[XB_XGEN(xcc)]) < epoch) __builtin_amdgcn_s_sleep(1);
    }
    __builtin_amdgcn_fence(__ATOMIC_ACQUIRE, "agent");
    asm volatile("s_waitcnt vmcnt(0) lgkmcnt(0)" ::: "memory");
  }
  __syncthreads();
}
#define GSYNC() xsync(p.bar, xepoch, xcc, cntx, nxcc)
__global__ void __launch_bounds__(256, 2) fwd_megakernel(Params p) {
  cg::grid_group grid = cg::this_grid();
  __shared__ __attribute__((aligned(16))) char smem[LDS_BYTES];
  const int G = gridDim.x;
  unsigned epoch = 0, xepoch = 0;
  if (p.njobs < 0) grid.sync();
  const unsigned xcc = (unsigned)__builtin_amdgcn_s_getreg((3 << 11) | 20) & 0xFu;
  if (threadIdx.x == 0) xb_add(&p.bar[XB_XCNT(xcc)]);
  my_gsync(p.bar, epoch, (unsigned)gridDim.x);
  const unsigned cntx = xb_ld(&p.bar[XB_XCNT(xcc)]);
  unsigned nxcc = 0;
#pragma unroll
  for (int jx = 0; jx < 16; ++jx) nxcc += (xb_ld(&p.bar[XB_XCNT(jx)]) != 0u) ? 1u : 0u;

  {
    const int nmod = 72, b_ = obid();
    if (G > 2 * nmod) {
      if (b_ < nmod) mod_item(p, b_, smem);
      else {
        for (int t = b_ - nmod; t < p.conv_tiles_l0; t += G - nmod) {
          int j = 0;
#pragma unroll 1
          for (int q = 1; q < p.njobs; ++q) if (t >= p.jobs[q].tile0) j = q;
          conv_tile(p.jobs[j], t - p.jobs[j].tile0, smem);
        }
      }
    } else {
      for (int it = b_; it < nmod + p.total_conv_tiles; it += G) {
        if (it < nmod) mod_item(p, it, smem);
        else {
          const int t = it - nmod;
          int j = 0;
#pragma unroll 1
          for (int q = 1; q < p.njobs; ++q) if (t >= p.jobs[q].tile0) j = q;
          conv_tile(p.jobs[j], t - p.jobs[j].tile0, smem);
        }
      }
    }
  }
  GSYNC();
  modulate_input_phase(p);
  GSYNC();

#pragma unroll 1
  for (int l = 0; l < 2; ++l) {
    const int odd = l;
#pragma unroll 1
    for (int j = 0; j < 2; ++j) {
      if (j == 1) {
        {
          EpiStoreBf16 epi{p.R1, odd ? LDPO : LDPE};
          gemm_phase<2, EpiStoreBf16>(p.Hb, DM, odd ? p.WtInO : p.WtInE, DM, odd ? LDPO : LDPE, DM, epi, smem);
        }
        GSYNC();
        prep_vectors(p, odd);
        prep_v(p, odd, smem);
        if (odd) hgrn_pre(p, smem);
        GSYNC();
        {
          const int nlong = odd ? 128 : 160, nshort = odd ? 512 : 640, natt = 768;
          const int b_ = obid();
          if (b_ < nlong && G > nlong) {
            if (!odd) mlstm_item(p, b_, smem); else hgrn_item(p, b_, smem);
          } else {
            const int first = (G > nlong) ? b_ - nlong : b_, stride = (G > nlong) ? G - nlong : G;
            const int lo_it = (G > nlong) ? 0 : -nlong;
            for (int it = first + lo_it; it < natt + nshort; it += stride) {
              if (it < 0) { if (!odd) mlstm_item(p, it + nlong, smem); else hgrn_item(p, it + nlong, smem); }
              else if (it < natt) attn_item(p, odd, it, smem);
              else if (!odd) mlstm_item(p, nlong + (it - natt), smem);
              else hgrn_item(p, nlong + (it - natt), smem);
            }
            if (!odd) {
              const int nx = p.total_conv_tiles - p.conv_tiles_l0;
              for (int x = first; x < nx; x += stride) {
                const int t = p.conv_tiles_l0 + x;
                int jj = 0;
#pragma unroll 1
                for (int q = 1; q < p.njobs; ++q) if (t >= p.jobs[q].tile0) jj = q;
                conv_tile(p.jobs[jj], t - p.jobs[jj].tile0, smem);
              }
            }
          }
        }
        GSYNC();
        combine_phase(p, odd);
        GSYNC();
        {
          EpiResid<2> epi{p.Z, p.out, p.out + (size_t)NPR * DM, modp(p, l, 0, 5), 1.f};
          gemm_phase<2, EpiResid<2>>(p.Hb, DM, odd ? p.WtOutO : p.WtOutE, DM, DM, DM, epi, smem);
        }
        GSYNC();
        ln_phase(p, p.ln_g + (size_t)(l * 3 + 1) * DM, p.ln_b + (size_t)(l * 3 + 1) * DM, true, l, 2);
        GSYNC();
      }
      const int j2 = j * 2;
      {
        EpiSwiglu epi{p.R1};
        gemm_phase<2, EpiSwiglu>(p.Hb, DM, p.Wt13p[l * 2 + j], DM, 5632, DM, epi, smem);
      }
      GSYNC();
      {
        const bool first = (l == 0 && j == 0);
        EpiResid<2> epi{p.Z, first ? p.x_prompt : p.out, first ? p.x_sample : p.out + (size_t)NPR * DM, modp(p, l, 0, 3 * j2 + 2), 0.5f};
        gemm_phase<2, EpiResid<2>>(p.R1, DFF, p.Wt2p[l * 2 + j], DFF, DM, DFF, epi, smem);
      }
      GSYNC();
      {
        const bool last = (l == 1 && j == 1);
        const int nl = (j == 0) ? l : l + 1, nj = (j == 0) ? 1 : 0;
        ln_phase(p, p.ln_g + (size_t)(l * 3 + j2) * DM, p.ln_b + (size_t)(l * 3 + j2) * DM, !last, last ? 0 : nl, last ? 0 : nj);
      }
      GSYNC();
    }
  }
}


template <int PH>
__global__ void __launch_bounds__(256, 2) k_phase(Params p, int l, int j) {
  __shared__ __attribute__((aligned(16))) char smem[LDS_BYTES];
  const int G = gridDim.x;
  const int odd = l;
  if (PH == 0) {
    const int nmod = 72;
    for (int it = obid(); it < nmod + p.total_conv_tiles; it += G) {
      if (it < nmod) mod_item(p, it, smem);
      else {
        const int t = it - nmod;
        int jj = 0;
#pragma unroll 1
        for (int q = 1; q < p.njobs; ++q) if (t >= p.jobs[q].tile0) jj = q;
        conv_tile(p.jobs[jj], t - p.jobs[jj].tile0, smem);
      }
    }
  } else if (PH == 1) {
    modulate_input_phase(p);
  } else if (PH == 2) {
    EpiStoreBf16 epi{p.R1, odd ? LDPO : LDPE};
    gemm_phase<2, EpiStoreBf16>(p.Hb, DM, odd ? p.WtInO : p.WtInE, DM, odd ? LDPO : LDPE, DM, epi, smem);
  } else if (PH == 3) {
    prep_vectors(p, odd);
    prep_v(p, odd, smem);
    if (odd) hgrn_pre(p, smem);
  } else if (PH == 4) {
    for (int it = obid(); it < 160 + 640 + 768; it += G) {
      if (it < 160) mlstm_item(p, it, smem);
      else if (it < 160 + 768) attn_item(p, 0, it - 160, smem);
      else mlstm_item(p, it - 768, smem);
    }
  } else if (PH == 5) {
    for (int it = obid(); it < 128 + 512 + 768; it += G) {
      if (it < 128) hgrn_item(p, it, smem);
      else if (it < 128 + 768) attn_item(p, 1, it - 128, smem);
      else hgrn_item(p, it - 768, smem);
    }
  } else if (PH == 6) {
    combine_phase(p, odd);
  } else if (PH == 7) {
    EpiResid<1> epi{p.Z, p.out, p.out + (size_t)NPR * DM, modp(p, l, 0, 5), 1.f};
    gemm_phase<1, EpiResid<1>>(p.Hb, DM, odd ? p.WtOutO : p.WtOutE, DM, DM, DM, epi, smem);
  } else if (PH == 8) {
    ln_phase(p, p.ln_g + (size_t)(l * 3 + 1) * DM, p.ln_b + (size_t)(l * 3 + 1) * DM, true, l, 2);
  } else if (PH == 9) {
    EpiSwiglu epi{p.R1};
    gemm_phase<2, EpiSwiglu>(p.Hb, DM, p.Wt13p[l * 2 + j], DM, 5632, DM, epi, smem);
  } else if (PH == 10) {
    const int j2 = j * 2;
    const bool first = (l == 0 && j == 0);
    EpiResid<1> epi{p.Z, first ? p.x_prompt : p.out, first ? p.x_sample : p.out + (size_t)NPR * DM, modp(p, l, 0, 3 * j2 + 2), 0.5f};
    gemm_phase<1, EpiResid<1>>(p.R1, DFF, p.Wt2p[l * 2 + j], DFF, DM, DFF, epi, smem);
  } else if (PH == 13) {
    for (size_t i = (size_t)obid() * 256 + otid(); i < (size_t)8192 * 512; i += (size_t)G * 256) p.SAVE[i] = p.Z[i];
  } else if (PH == 14) {
    bool bad = false;
    for (size_t i = (size_t)obid() * 256 + otid(); i < (size_t)8192 * 512; i += (size_t)G * 256) if (__float_as_uint(p.SAVE[i]) != __float_as_uint(p.Z[i])) bad = true;
    if (bad) { volatile int* q = (volatile int*)p.SAVE; while (q[0] != 0x7fffffff) { __builtin_amdgcn_s_sleep(10); } }
  } else if (PH == 11) {
    const int j2 = j * 2;
    const bool last = (l == 1 && j == 1);
    const int nl = (j == 0) ? l : l + 1, nj = (j == 0) ? 1 : 0;
    ln_phase(p, p.ln_g + (size_t)(l * 3 + j2) * DM, p.ln_b + (size_t)(l * 3 + j2) * DM, !last, last ? 0 : nl, last ? 0 : nj);
  }
}
extern "C" void kernel_launch(void* const* d_in, const int* in_sizes, int n_in, void* d_out, int out_size, void* d_ws,
                              size_t ws_size, hipStream_t stream) {
  static Params p;
  memset(&p, 0, sizeof(p));
  const float** ip = (const float**)&p.x_prompt;
  for (int i = 0; i < 30; ++i) ip[i] = (const float*)d_in[i];
  p.out = (float*)d_out;
  char* ws = (char*)d_ws;
  size_t off = 0;
  auto take = [&](size_t bytes) { char* r = ws + off; off += (bytes + 255) & ~(size_t)255; return r; };
  p.bar = (unsigned*)take(32768);
  char* l0_begin = ws + off;
  p.Wt13p[0] = (bf16_t*)take((size_t)5632 * 1024 * 2);
  p.Wt13p[1] = (bf16_t*)take((size_t)5632 * 1024 * 2);
  p.Wt2p[0] = (bf16_t*)take((size_t)1024 * DFF * 2);
  p.Wt2p[1] = (bf16_t*)take((size_t)1024 * DFF * 2);
  p.WtInE = (bf16_t*)take((size_t)LDPE * 1024 * 2);
  p.WtOutE = (bf16_t*)take((size_t)1024 * 1024 * 2);
  char* l0_end = ws + off;
  p.HQ = (bf16_t*)l0_begin;
  p.EV = (float*)(l0_begin + 25165824);
  p.HK0 = (bf16_t*)(l0_begin + 25165824 + 4718592);
  if (l0_begin + 25165824 + 4718592 + 12582912 > l0_end) fprintf(stderr, "layer-0 weight region too small for the HGRN buffers\n");
  p.Wt13p[2] = (bf16_t*)take((size_t)5632 * 1024 * 2);
  p.Wt13p[3] = (bf16_t*)take((size_t)5632 * 1024 * 2);
  p.Wt2p[2] = (bf16_t*)take((size_t)1024 * DFF * 2);
  p.Wt2p[3] = (bf16_t*)take((size_t)1024 * DFF * 2);
  p.WtInO = (bf16_t*)take((size_t)LDPO * 1024 * 2);
  p.WtOutO = (bf16_t*)take((size_t)1024 * 1024 * 2);
  p.HK1 = (bf16_t*)take((size_t)12582912);
  p.HKt = (bf16_t*)take((size_t)25165824);
  p.MOD = (float*)take((size_t)2 * 5 * 9216 * 4);
  p.Hb = (bf16_t*)take((size_t)NT * DM * 2);
  p.R1 = (bf16_t*)take((size_t)NT * LDPO * 2);
  p.Z = (float*)take((size_t)NT * DM * 4);
  p.Qb = (bf16_t*)take((size_t)NT * 512 * 2);
  p.Kb = (bf16_t*)take((size_t)NT * 128 * 2);
  p.Vt = (bf16_t*)take((size_t)(524288 + 1048576) * 2);
  p.Kc = (bf16_t*)take((size_t)262144 * 2);
  p.Vct = (bf16_t*)take((size_t)262144 * 2);
  p.DEN = (float*)take((size_t)2 * NT * 4 * 4);
  p.CL = (float*)take((size_t)2 * NT * 4 * 4);
  if (off > ws_size) fprintf(stderr, "workspace too small: need %zu have %zu\n", off, ws_size);
  int nj = 0, tiles = 0;
  auto add = [&](const float* src, bf16_t* dst, int K, int N, int Npad, int mode) {
    ConvJob& jb = p.jobs[nj++];
    jb.src = src; jb.dst = dst; jb.K = K; jb.N = N; jb.Npad = Npad; jb.mode = mode; jb.tile0 = tiles; jb.pad0 = 0;
    tiles += (K / 64) * (Npad / 64);
  };
  for (int lj = 0; lj < 2; ++lj) {
    add(p.ffn_w1 + (size_t)lj * 1024 * DFF, p.Wt13p[lj], 1024, DFF, DFF, 1);
    add(p.ffn_w3 + (size_t)lj * 1024 * DFF, p.Wt13p[lj], 1024, DFF, DFF, 2);
    add(p.ffn_w2 + (size_t)lj * DFF * 1024, p.Wt2p[lj], DFF, 1024, 1024, 0);
  }
  add(p.w_in_even, p.WtInE, 1024, 2832, LDPE, 0);
  add(p.w_out_even, p.WtOutE, 1024, 1024, 1024, 0);
  p.conv_tiles_l0 = tiles;
  for (int lj = 2; lj < 4; ++lj) {
    add(p.ffn_w1 + (size_t)lj * 1024 * DFF, p.Wt13p[lj], 1024, DFF, DFF, 1);
    add(p.ffn_w3 + (size_t)lj * 1024 * DFF, p.Wt13p[lj], 1024, DFF, DFF, 2);
    add(p.ffn_w2 + (size_t)lj * DFF * 1024, p.Wt2p[lj], DFF, 1024, 1024, 0);
  }
  add(p.w_in_odd, p.WtInO, 1024, LDPO, LDPO, 0);
  add(p.w_out_odd, p.WtOutO, 1024, 1024, 1024, 0);
  p.njobs = nj; p.total_conv_tiles = tiles;
  static int grid_blocks = 0;
  if (!grid_blocks) {
    int dev = 0, cus = 0, per_cu = 0;
    hipGetDevice(&dev);
    hipDeviceGetAttribute(&cus, hipDeviceAttributeMultiprocessorCount, dev);
    hipOccupancyMaxActiveBlocksPerMultiprocessor(&per_cu, fwd_megakernel, 256, 0);
    per_cu = 2;
    grid_blocks = cus * per_cu;
  }
  hipMemsetAsync(p.bar, 0, 32768, stream);
#if MULTI_LAUNCH
  const dim3 g(512), b(256);
  k_phase<0><<<g, b, 0, stream>>>(p, 0, 0);
  k_phase<1><<<g, b, 0, stream>>>(p, 0, 0);
  for (int l = 0; l < 2; ++l)
    for (int j = 0; j < 2; ++j) {
      if (j == 1) {
        k_phase<2><<<g, b, 0, stream>>>(p, l, j);
        k_phase<3><<<g, b, 0, stream>>>(p, l, j);
        if (l == 0) k_phase<4><<<g, b, 0, stream>>>(p, l, j); else k_phase<5><<<g, b, 0, stream>>>(p, l, j);
        k_phase<6><<<g, b, 0, stream>>>(p, l, j);
        k_phase<7><<<g, b, 0, stream>>>(p, l, j);
        k_phase<8><<<g, b, 0, stream>>>(p, l, j);
      }
      k_phase<9><<<g, b, 0, stream>>>(p, l, j);
      k_phase<10><<<g, b, 0, stream>>>(p, l, j);
      k_phase<11><<<g, b, 0, stream>>>(p, l, j);
    }
#else
  void* args[] = {&p};
  hipError_t e = hipLaunchCooperativeKernel((void*)fwd_megakernel, dim3(grid_blocks), dim3(256), args, 0, stream);
  if (e != hipSuccess) fprintf(stderr, "cooperative launch failed: %s (grid %d)\n", hipGetErrorString(e), grid_blocks);
#endif
}
```

```cpp
#define MULTI_LAUNCH 0
#include <hip/hip_runtime.h>
#include <hip/hip_cooperative_groups.h>
#include <cstdint>
#include <cstring>
#include <cstdio>
namespace cg = cooperative_groups;

typedef unsigned short bf16_t;
typedef short s16x8 __attribute__((ext_vector_type(8)));
typedef short s16x4 __attribute__((ext_vector_type(4)));
typedef float f32x4 __attribute__((ext_vector_type(4)));
typedef float f32x16 __attribute__((ext_vector_type(16)));
typedef unsigned u32x4 __attribute__((ext_vector_type(4)));

#define NT 12288
#define NPR 4096
#define DM 1024
#define DFF 2816
#define LDPE 2944
#define LDPO 3328
#define ALPHA_F 1.4142135623730951f
#define LOG2E 1.4426950408889634f
#define LDS_BYTES 77824

struct ConvJob { const float* src; bf16_t* dst; int K, N, Npad, mode, tile0, pad0; };

struct Params {
  const float *x_prompt, *x_sample, *c, *cache_a_k, *cache_a_v, *state_b_C, *state_b_n, *state_b_m, *state_c_S,
      *cache_d_k, *cache_d_v, *c_ctx, *ada_w, *ada_b, *ln_g, *ln_b, *ffn_w1, *ffn_w3, *ffn_w2, *w_in_even,
      *w_out_even, *a_sink, *b_gate_bias, *b_norm_g, *w_in_odd, *w_out_odd, *c_lb_logits, *c_norm_g, *d_q_norm,
      *d_k_norm;
  float* out;
  bf16_t *Wt13p[4], *Wt2p[4], *WtInE, *WtInO, *WtOutE, *WtOutO;
  bf16_t *HQ, *HK0, *HK1, *HKt; float* EV;
  float* MOD;
  bf16_t* Hb;
  bf16_t* R1;
  float* Z;
  bf16_t *Qb, *Kb, *Vt, *Kc, *Vct;
  float *DEN, *CL;
  ConvJob jobs[16];
  int njobs, total_conv_tiles, conv_tiles_l0, pad1;
  float* SAVE;
  unsigned* bar;
};

__device__ __forceinline__ int otid() { int t = threadIdx.x; asm volatile("" : "+v"(t)); return t; }
__device__ __forceinline__ int obid() { int t = blockIdx.x; asm volatile("" : "+s"(t)); return t; }
__device__ __forceinline__ u32x4 gload16(const void* ptr) {
  u32x4 r;
  asm volatile("global_load_dwordx4 %0, %1, off" : "=v"(r) : "v"(ptr) : "memory");
  return r;
}
__device__ __forceinline__ unsigned gload2(const void* ptr) {
  unsigned r;
  asm volatile("global_load_ushort %0, %1, off" : "=v"(r) : "v"(ptr) : "memory");
  return r;
}
__device__ __forceinline__ void vm_wait4(u32x4& a, u32x4& b, u32x4& c, u32x4& d) {
  asm volatile("s_waitcnt vmcnt(0)" : "+v"(a), "+v"(b), "+v"(c), "+v"(d) : : "memory");
}
__device__ __forceinline__ void vm_wait2(u32x4& a, u32x4& b) {
  asm volatile("s_waitcnt vmcnt(0)" : "+v"(a), "+v"(b) : : "memory");
}
__device__ __forceinline__ f32x4 mfma16_safe(s16x8 a, s16x8 b, f32x4 c) {
  asm volatile("s_nop 4\n\tv_mfma_f32_16x16x32_bf16 %0, %1, %2, %0\n\ts_nop 7\n\ts_nop 7" : "+v"(c) : "v"(a), "v"(b));
  return c;
}
__device__ __forceinline__ float bf2f(bf16_t v) { return __uint_as_float(((unsigned)v) << 16); }
__device__ __forceinline__ unsigned pk2(float a, float b) {
  unsigned r;
  asm("v_cvt_pk_bf16_f32 %0, %1, %2" : "=v"(r) : "v"(a), "v"(b));
  return r;
}
__device__ __forceinline__ bf16_t f2bf(float f) { return (bf16_t)(pk2(f, f) & 0xffffu); }
__device__ __forceinline__ float wave_sum(float v) {
#pragma unroll
  for (int o = 32; o > 0; o >>= 1) v += __shfl_xor(v, o);
  return v;
}
__device__ __forceinline__ int mod_index(int row) { return row < NPR ? 0 : 1 + ((row - NPR) >> 11); }
__device__ __forceinline__ const float* modp(const Params& p, int l, int mi, int part) {
  return p.MOD + ((size_t)((l * 5 + mi) * 9 + part)) * DM;
}
__device__ __forceinline__ float sigmoidf_(float x) { return __builtin_amdgcn_rcpf(1.f + __expf(-x)); }

__device__ __forceinline__ void conv_tile(const ConvJob& jb, int t, char* smem) {
  float* sT = (float*)smem;
  const int nkt = jb.K >> 6;
  const int kt = t % nkt, nt = t / nkt;
  const int k0 = kt * 64, n0 = nt * 64;
  const int tid = otid();
#pragma unroll
  for (int i = 0; i < 4; ++i) {
    const int r = (tid >> 4) + 16 * i, c4 = (tid & 15) * 4, n = n0 + c4;
    float4 v = make_float4(0.f, 0.f, 0.f, 0.f);
    if (n < jb.N) v = *(const float4*)(jb.src + (size_t)(k0 + r) * jb.N + n);
    sT[r * 65 + c4 + 0] = v.x; sT[r * 65 + c4 + 1] = v.y; sT[r * 65 + c4 + 2] = v.z; sT[r * 65 + c4 + 3] = v.w;
  }
  __syncthreads();
#pragma unroll
  for (int i = 0; i < 2; ++i) {
    const int id = tid + i * 256, nl = id >> 3, ch = id & 7;
    const int n = n0 + nl;
    int drow = n;
    if (jb.mode == 1) drow = (n >> 5) * 64 + (n & 31);
    else if (jb.mode == 2) drow = (n >> 5) * 64 + 32 + (n & 31);
    uint4 w;
    w.x = pk2(sT[(ch * 8 + 0) * 65 + nl], sT[(ch * 8 + 1) * 65 + nl]);
    w.y = pk2(sT[(ch * 8 + 2) * 65 + nl], sT[(ch * 8 + 3) * 65 + nl]);
    w.z = pk2(sT[(ch * 8 + 4) * 65 + nl], sT[(ch * 8 + 5) * 65 + nl]);
    w.w = pk2(sT[(ch * 8 + 6) * 65 + nl], sT[(ch * 8 + 7) * 65 + nl]);
    if (n < jb.Npad) *(uint4*)(jb.dst + (size_t)drow * jb.K + k0 + ch * 8) = w;
  }
  __syncthreads();
}

__device__ __forceinline__ void mod_item(const Params& p, int item, char* smem) {
  float* sv = (float*)smem;
  float4* red = (float4*)(smem + 20480);
  const int l = item / 36, cgp = item % 36, tid = otid();
  for (int idx = tid; idx < 5120; idx += 256) {
    const int n = idx >> 10, k = idx & 1023;
    const float v = (n == 0) ? p.c_ctx[k] : p.c[(n - 1) * 1024 + k];
    sv[idx] = v * sigmoidf_(v);
  }
  __syncthreads();
  const int kq = tid >> 6, cl = tid & 63, col = cgp * 256 + cl * 4;
  const float* W = p.ada_w + (size_t)l * 1024 * 9216 + col;
  float4 acc[5];
#pragma unroll
  for (int n = 0; n < 5; ++n) acc[n] = make_float4(0.f, 0.f, 0.f, 0.f);
  for (int kb = 0; kb < 256; kb += 8) {
    float4 w[8];
#pragma unroll
    for (int u = 0; u < 8; ++u) w[u] = *(const float4*)(W + (size_t)(kq * 256 + kb + u) * 9216);
#pragma unroll
    for (int u = 0; u < 8; ++u) {
#pragma unroll
      for (int n = 0; n < 5; ++n) {
        const float s = sv[n * 1024 + kq * 256 + kb + u];
        acc[n].x += s * w[u].x; acc[n].y += s * w[u].y; acc[n].z += s * w[u].z; acc[n].w += s * w[u].w;
      }
    }
  }
#pragma unroll
  for (int n = 0; n < 5; ++n) red[(kq * 5 + n) * 64 + cl] = acc[n];
  __syncthreads();
  for (int idx = tid; idx < 320; idx += 256) {
    const int n = idx >> 6, c2 = idx & 63;
    float4 s = red[(0 * 5 + n) * 64 + c2];
#pragma unroll
    for (int q = 1; q < 4; ++q) {
      const float4 t = red[(q * 5 + n) * 64 + c2];
      s.x += t.x; s.y += t.y; s.z += t.z; s.w += t.w;
    }
    const int cc = cgp * 256 + c2 * 4;
    const float4 b = *(const float4*)(p.ada_b + (size_t)l * 9216 + cc);
    s.x += b.x; s.y += b.y; s.z += b.z; s.w += b.w;
    *(float4*)(p.MOD + (size_t)(l * 5 + n) * 9216 + cc) = s;
  }
  __syncthreads();
}

__device__ __forceinline__ void modulate_input_phase(const Params& p) {
  const int tid_ = otid(); const int lane = tid_ & 63, w = tid_ >> 6;
  for (int row = obid() * 4 + w; row < NT; row += gridDim.x * 4) {
    const float* xr = row < NPR ? p.x_prompt + (size_t)row * DM : p.x_sample + (size_t)(row - NPR) * DM;
    const int mi = mod_index(row);
    const float* sh = modp(p, 0, mi, 0);
    const float* sc = modp(p, 0, mi, 1);
#pragma unroll
    for (int i = 0; i < 4; ++i) {
      const int c = lane * 4 + 256 * i;
      const float4 x = *(const float4*)(xr + c);
      const float4 s = *(const float4*)(sc + c);
      const float4 h = *(const float4*)(sh + c);
      uint2 o;
      o.x = pk2(x.x * (1.f + s.x) + h.x, x.y * (1.f + s.y) + h.y);
      o.y = pk2(x.z * (1.f + s.z) + h.z, x.w * (1.f + s.w) + h.w);
      *(uint2*)(p.Hb + (size_t)row * DM + c) = o;
    }
  }
}

__device__ __forceinline__ void ln_phase(const Params& p, const float* g, const float* b, bool write_h, int nl, int nj) {
  const int tid_ = otid(); const int lane = tid_ & 63, w = tid_ >> 6;
  float* X = p.out;
  float4 gg[4], bb[4];
#pragma unroll
  for (int i = 0; i < 4; ++i) { gg[i] = *(const float4*)(g + lane * 4 + 256 * i); bb[i] = *(const float4*)(b + lane * 4 + 256 * i); }
  for (int row0 = (obid() * 4 + w) * 2; row0 < NT; row0 += gridDim.x * 8) {
    float4 v[2][4], s4[4], h4[4];
#pragma unroll
    for (int r = 0; r < 2; ++r)
#pragma unroll
      for (int i = 0; i < 4; ++i) v[r][i] = *(const float4*)(p.Z + (size_t)(row0 + r) * DM + lane * 4 + 256 * i);
    const int mi = mod_index(row0);
    const float* sh = modp(p, nl, mi, 3 * nj);
    const float* sc = modp(p, nl, mi, 3 * nj + 1);
    if (write_h) {
#pragma unroll
      for (int i = 0; i < 4; ++i) { s4[i] = *(const float4*)(sc + lane * 4 + 256 * i); h4[i] = *(const float4*)(sh + lane * 4 + 256 * i); }
    }
    float s0 = 0.f, s1 = 0.f;
#pragma unroll
    for (int i = 0; i < 4; ++i) {
      s0 += (v[0][i].x + v[0][i].y) + (v[0][i].z + v[0][i].w);
      s1 += (v[1][i].x + v[1][i].y) + (v[1][i].z + v[1][i].w);
    }
#pragma unroll
    for (int o = 32; o > 0; o >>= 1) { s0 += __shfl_xor(s0, o); s1 += __shfl_xor(s1, o); }
    const float mu0 = s0 * (1.f / 1024.f), mu1 = s1 * (1.f / 1024.f);
    float q0 = 0.f, q1 = 0.f;
#pragma unroll
    for (int i = 0; i < 4; ++i) {
      v[0][i].x -= mu0; v[0][i].y -= mu0; v[0][i].z -= mu0; v[0][i].w -= mu0;
      v[1][i].x -= mu1; v[1][i].y -= mu1; v[1][i].z -= mu1; v[1][i].w -= mu1;
      q0 += (v[0][i].x * v[0][i].x + v[0][i].y * v[0][i].y) + (v[0][i].z * v[0][i].z + v[0][i].w * v[0][i].w);
      q1 += (v[1][i].x * v[1][i].x + v[1][i].y * v[1][i].y) + (v[1][i].z * v[1][i].z + v[1][i].w * v[1][i].w);
    }
#pragma unroll
    for (int o = 32; o > 0; o >>= 1) { q0 += __shfl_xor(q0, o); q1 += __shfl_xor(q1, o); }
    const float rs[2] = {rsqrtf(q0 * (1.f / 1024.f) + 1e-5f), rsqrtf(q1 * (1.f / 1024.f) + 1e-5f)};
#pragma unroll
    for (int r = 0; r < 2; ++r)
#pragma unroll
      for (int i = 0; i < 4; ++i) {
        const int c = lane * 4 + 256 * i;
        float4 y;
        y.x = v[r][i].x * rs[r] * gg[i].x + bb[i].x; y.y = v[r][i].y * rs[r] * gg[i].y + bb[i].y;
        y.z = v[r][i].z * rs[r] * gg[i].z + bb[i].z; y.w = v[r][i].w * rs[r] * gg[i].w + bb[i].w;
        *(float4*)(X + (size_t)(row0 + r) * DM + c) = y;
        if (write_h) {
          uint2 o;
          o.x = pk2(y.x * (1.f + s4[i].x) + h4[i].x, y.y * (1.f + s4[i].y) + h4[i].y);
          o.y = pk2(y.z * (1.f + s4[i].z) + h4[i].z, y.w * (1.f + s4[i].w) + h4[i].w);
          *(uint2*)(p.Hb + (size_t)(row0 + r) * DM + c) = o;
        }
      }
  }
}

__device__ __forceinline__ void stage_acc(const f32x16 (&acc)[2][2], float* sA, int wr, int wc, int lane) {
#pragma unroll
  for (int mi = 0; mi < 2; ++mi)
#pragma unroll
    for (int ni = 0; ni < 2; ++ni)
#pragma unroll
      for (int r = 0; r < 16; ++r) {
        const int row = wr * 64 + mi * 32 + (r & 3) + 8 * (r >> 2) + 4 * (lane >> 5), col = wc * 64 + ni * 32 + (lane & 31);
        sA[row * 132 + col] = acc[mi][ni][r];
      }
}
struct EpiSwiglu {
  bf16_t* G;
  __device__ __forceinline__ void operator()(const f32x16 (&acc)[2][2], char* smem, int row0, int col0, int wr, int wc, int lane, int tid) const {
    float* sA = (float*)smem;
#pragma unroll
    for (int mi = 0; mi < 2; ++mi)
#pragma unroll
      for (int r = 0; r < 16; ++r) {
        const int row = wr * 64 + mi * 32 + (r & 3) + 8 * (r >> 2) + 4 * (lane >> 5);
        const float a = acc[mi][0][r], bb = acc[mi][1][r];
        sA[row * 68 + wc * 32 + (lane & 31)] = a * sigmoidf_(a) * bb;
      }
    __syncthreads();
    const int n0 = (col0 >> 7) * 64;
#pragma unroll
    for (int i = 0; i < 4; ++i) {
      const int idx = tid + i * 256, row = idx >> 3, c8 = (idx & 7) * 8;
      const float4 v0 = *(const float4*)(sA + row * 68 + c8), v1 = *(const float4*)(sA + row * 68 + c8 + 4);
      uint4 o; o.x = pk2(v0.x, v0.y); o.y = pk2(v0.z, v0.w); o.z = pk2(v1.x, v1.y); o.w = pk2(v1.z, v1.w);
      *(uint4*)(G + (size_t)(row0 + row) * DFF + n0 + c8) = o;
    }
    __syncthreads();
  }
};
template <int NI>
struct EpiResid {
  float* Z; const float* r0; const float* r1; const float* gate_base; float gs;
  __device__ __forceinline__ void operator()(const f32x16 (&acc)[2][NI], char* smem, int row0, int col0, int wr, int wc, int lane, int tid) const {
    float* sA = (float*)smem;
    stage_acc(acc, sA, wr, wc, lane);
    __syncthreads();
    const float* gate = gate_base + (size_t)mod_index(row0) * 9 * DM;
    const float* rbase = (row0 < NPR) ? r0 : r1 - (size_t)NPR * DM;
    const int c4 = (tid & 31) * 4;
    float4 gv = *(const float4*)(gate + col0 + c4);
    gv.x *= gs; gv.y *= gs; gv.z *= gs; gv.w *= gs;
#pragma unroll
    for (int i = 0; i < 16; ++i) {
      const int row = (tid >> 5) + i * 8;
      const float4 a = *(const float4*)(sA + row * 132 + c4);
      const size_t o = (size_t)(row0 + row) * DM + col0 + c4;
      const float4 x = *(const float4*)(rbase + o);
      float4 z;
      z.x = ALPHA_F * x.x + gv.x * a.x; z.y = ALPHA_F * x.y + gv.y * a.y; z.z = ALPHA_F * x.z + gv.z * a.z; z.w = ALPHA_F * x.w + gv.w * a.w;
      *(float4*)(Z + o) = z;
    }
    __syncthreads();
  }
};
struct EpiStoreBf16 {
  bf16_t* P; int ld;
  __device__ __forceinline__ void operator()(const f32x16 (&acc)[2][2], char* smem, int row0, int col0, int wr, int wc, int lane, int tid) const {
    float* sA = (float*)smem;
    stage_acc(acc, sA, wr, wc, lane);
    __syncthreads();
#pragma unroll
    for (int i = 0; i < 8; ++i) {
      const int idx = tid + i * 256, row = idx >> 4, c8 = (idx & 15) * 8;
      const float4 v0 = *(const float4*)(sA + row * 132 + c8), v1 = *(const float4*)(sA + row * 132 + c8 + 4);
      uint4 o; o.x = pk2(v0.x, v0.y); o.y = pk2(v0.z, v0.w); o.z = pk2(v1.x, v1.y); o.w = pk2(v1.z, v1.w);
      *(uint4*)(P + (size_t)(row0 + row) * ld + col0 + c8) = o;
    }
    __syncthreads();
  }
};

#define LAS __attribute__((address_space(3)))
template <int NI, class Epi>
__device__ __forceinline__ void gemm_tile(const bf16_t* __restrict__ A, int lda, const bf16_t* __restrict__ Bt, int ldb,
                                          int K, int row0, int col0, const Epi& epi, char* smem) {
  static_assert(NI == 2, "LDS-DMA tile is 128 x 128");
  constexpr int STAGE_B = 32768;
  const int tid = otid(), lane = tid & 63, w = tid >> 6, wr = w >> 1, wc = w & 1, h = lane >> 5;
  LAS char* lds = (LAS char*)smem;
  const int lrow = lane >> 3;
  const int c0 = (lane & 7) ^ (lane >> 4), c1 = (lane & 7) ^ (4 + (lane >> 4));
  const bf16_t* Ag[4];
  const bf16_t* Bg[4];
#pragma unroll
  for (int i = 0; i < 4; ++i) {
    const int row = (w * 4 + i) * 8 + lrow, c = (i & 1) ? c1 : c0;
    Ag[i] = A + (size_t)(row0 + row) * lda + c * 8;
    Bg[i] = Bt + (size_t)(col0 + row) * ldb + c * 8;
  }
#define GEMM_STAGE(buf_, k0_)                                                                                              \
  {                                                                                                                        \
    _Pragma("unroll") for (int i = 0; i < 4; ++i) {                                                                        \
      __builtin_amdgcn_global_load_lds((const __attribute__((address_space(1))) unsigned*)(Ag[i] + (k0_)),                 \
                                       (LAS unsigned*)(lds + (buf_) * STAGE_B + (w * 4 + i) * 1024), 16, 0, 0);            \
      __builtin_amdgcn_global_load_lds((const __attribute__((address_space(1))) unsigned*)(Bg[i] + (k0_)),                 \
                                       (LAS unsigned*)(lds + (buf_) * STAGE_B + 16384 + (w * 4 + i) * 1024), 16, 0, 0);    \
    }                                                                                                                      \
  }
  f32x16 acc[2][NI];
#pragma unroll
  for (int mi = 0; mi < 2; ++mi)
#pragma unroll
    for (int ni = 0; ni < NI; ++ni)
#pragma unroll
      for (int r = 0; r < 16; ++r) acc[mi][ni][r] = 0.f;
  const int nk = K >> 6;
  GEMM_STAGE(0, 0);
  __syncthreads();
  const int sw = ((lane & 31) >> 1) & 7;
  const int aoff = (wr * 64 + (lane & 31)) * 128;
  const int boff = 16384 + (wc * 64 + (lane & 31)) * 128;
  for (int kt = 0; kt < nk; ++kt) {
    const int cur = kt & 1;
    if (kt + 1 < nk) GEMM_STAGE(cur ^ 1, (kt + 1) * 64);
    LAS const char* sc = lds + cur * STAGE_B;
#pragma unroll
    for (int kk = 0; kk < 4; ++kk) {
      const int co = ((kk * 2 + h) ^ sw) * 16;
      s16x8 af[2], bfr[NI];
#pragma unroll
      for (int mi = 0; mi < 2; ++mi) af[mi] = *(LAS const s16x8*)(sc + aoff + mi * 4096 + co);
#pragma unroll
      for (int ni = 0; ni < NI; ++ni) bfr[ni] = *(LAS const s16x8*)(sc + boff + ni * 4096 + co);
#pragma unroll
      for (int mi = 0; mi < 2; ++mi)
#pragma unroll
        for (int ni = 0; ni < NI; ++ni)
          acc[mi][ni] = __builtin_amdgcn_mfma_f32_32x32x16_bf16(af[mi], bfr[ni], acc[mi][ni], 0, 0, 0);
    }
    __syncthreads();
  }
#undef GEMM_STAGE
  epi(acc, smem, row0, col0, wr, wc, lane, tid);
}

template <int NI, class Epi>
__device__ __forceinline__ void gemm_phase(const bf16_t* A, int lda, const bf16_t* Bt, int ldb, int N, int K, const Epi& epi, char* smem) {
  constexpr int BN = NI * 64;
  const int nMt = NT / 128, nNt = N / BN, T = nMt * nNt;
  for (int t = obid(); t < T; t += gridDim.x) {
    const int s = (t & 7) * (T >> 3) + (t >> 3);
    const int grp = s / (8 * nNt), r = s % (8 * nNt);
    const int mt = grp * 8 + (r & 7), nt = r >> 3;
    gemm_tile<NI, Epi>(A, lda, Bt, ldb, K, mt * 128, nt * BN, epi, smem);
  }
}

__device__ __forceinline__ void prep_vectors(const Params& p, int odd) {
  const int tid_ = otid(); const int lane = tid_ & 63, w = tid_ >> 6;
  const bf16_t* P = p.R1;
  const int ldp = odd ? LDPO : LDPE;
  const int qcol = odd ? 2560 : 0, kcol = odd ? 3072 : 512;
  float* outk = p.out + (size_t)NT * DM + (odd ? (size_t)(524288 * 2 + 2097152 + 16384 + 128 + 2097152) : 0);
  const float qn = odd ? p.d_q_norm[lane] : 1.f, kn = odd ? p.d_k_norm[lane] : 1.f;
  const int i16 = lane & 15;
  const float inv = exp2f(-(float)i16 * (13.287712379549449f / 16.f));
  for (int row = obid() * 4 + w; row < NT; row += gridDim.x * 4) {
    const bf16_t* pr_ = P + (size_t)row * ldp;
    float v[10];
#pragma unroll
    for (int hv = 0; hv < 8; ++hv) v[hv] = bf2f(pr_[qcol + hv * 64 + lane]);
#pragma unroll
    for (int hv = 0; hv < 2; ++hv) v[8 + hv] = bf2f(pr_[kcol + hv * 64 + lane]);
    if (odd) {
#pragma unroll
      for (int hv = 0; hv < 10; ++hv) {
        const float ms = wave_sum(v[hv] * v[hv]) * (1.f / 64.f);
        v[hv] = v[hv] * rsqrtf(ms + 1e-6f) * (hv < 8 ? qn : kn);
      }
    }
    if (row < NPR) {
      outk[(size_t)row * 128 + lane] = v[8];
      outk[(size_t)row * 128 + 64 + lane] = v[9];
    } else {
      const int t = (row - NPR) & 2047;
      const float pos = (lane < 32) ? (float)(t >> 6) : (float)(t & 63);
      const float ang = pos * inv;
      const float cs = __cosf(ang), sn = __sinf(ang);
#pragma unroll
      for (int hv = 0; hv < 10; ++hv) {
        const float pr = __shfl_xor(v[hv], 16);
        v[hv] = ((lane & 16) == 0) ? (v[hv] * cs - pr * sn) : (pr * sn + v[hv] * cs);
      }
    }
#pragma unroll
    for (int hv = 0; hv < 8; ++hv) p.Qb[(size_t)row * 512 + hv * 64 + lane] = f2bf(v[hv] * (0.125f * LOG2E));
#pragma unroll
    for (int hv = 0; hv < 2; ++hv) p.Kb[(size_t)row * 128 + hv * 64 + lane] = f2bf(v[8 + hv]);
  }
}

__device__ __forceinline__ void prep_v(const Params& p, int odd, char* smem) {
  bf16_t* sT = (bf16_t*)smem;
  const bf16_t* P = p.R1;
  const int ldp = odd ? LDPO : LDPE;
  const int vcol = odd ? 3200 : 640;
  const float* cv = odd ? p.cache_d_v : p.cache_a_v;
  const float* ck = odd ? p.cache_d_k : p.cache_a_k;
  float* outv = p.out + (size_t)NT * DM + (odd ? (size_t)(524288 * 2 + 2097152 + 16384 + 128 + 2097152 + 524288) : (size_t)524288);
  const int tid = otid();
  const int nitems = 192 * 2 + 64 + 64;
  for (int it = obid(); it < nitems; it += gridDim.x) {
    if (it < 448) {
      bf16_t* dst; int dstride;
      if (it < 384) {
        const int tb = it >> 1, kv = it & 1, row0 = tb * 64;
#pragma unroll
        for (int i = 0; i < 16; ++i) {
          const int r = (tid >> 6) + 4 * i, d = tid & 63;
          const bf16_t raw = P[(size_t)(row0 + r) * ldp + vcol + kv * 64 + d];
          sT[d * 72 + r] = raw;
          if (row0 < NPR) outv[(size_t)(row0 + r) * 128 + kv * 64 + d] = bf2f(raw);
        }
        if (row0 < NPR) { const int b = row0 >> 8, pos0 = row0 & 255; dst = p.Vt + (size_t)((b * 2 + kv) * 64) * 256 + pos0; dstride = 256; }
        else { const int rr = row0 - NPR, b = rr >> 11, pos0 = rr & 2047; dst = p.Vt + 524288 + (size_t)((b * 2 + kv) * 64) * 2048 + pos0; dstride = 2048; }
      } else {
        const int j = it - 384, b = j >> 4, kv = (j >> 3) & 1, kb = j & 7;
#pragma unroll
        for (int i = 0; i < 16; ++i) {
          const int r = (tid >> 6) + 4 * i, d = tid & 63;
          sT[d * 72 + r] = f2bf(cv[((size_t)(b * 512 + kb * 64 + r) * 2 + kv) * 64 + d]);
        }
        dst = p.Vct + (size_t)((b * 2 + kv) * 64) * 512 + kb * 64; dstride = 512;
      }
      __syncthreads();
#pragma unroll
      for (int i = 0; i < 2; ++i) {
        const int id = tid + i * 256, d = id >> 3, ch = id & 7;
        *(uint4*)(dst + (size_t)d * dstride + ch * 8) = *(const uint4*)(sT + d * 72 + ch * 8);
      }
      __syncthreads();
    } else {
      const int j = it - 448;
#pragma unroll
      for (int i = 0; i < 16; ++i) {
        const int idx = j * 4096 + i * 256 + tid;
        p.Kc[idx] = f2bf(ck[idx]);
      }
    }
  }
}

__device__ __forceinline__ void attn_item(const Params& p, int odd, int item, char* smem) {
  bf16_t* Ks = (bf16_t*)smem;
  bf16_t* Vs = Ks + 64 * 72;
  const int tid = otid(), lane = tid & 63, g = tid >> 6, ql = lane & 31, h = lane >> 5;
  int b, kv, qb, L, seq_row0; bool sample;
  if (item < 512) { sample = true; b = item >> 7; kv = (item >> 6) & 1; qb = item & 63; L = 2048; seq_row0 = NPR + b * 2048; }
  else { const int it = item - 512; sample = false; b = it >> 4; kv = (it >> 3) & 1; qb = it & 7; L = 256; seq_row0 = b * 256; }
  const int t0 = qb * 32, q_row0 = seq_row0 + t0;
  const bf16_t* vbase = sample ? p.Vt + 524288 + (size_t)((b * 2 + kv) * 64) * 2048 : p.Vt + (size_t)((b * 2 + kv) * 64) * 256;
  const bf16_t* kbase = p.Kb + (size_t)seq_row0 * 128 + kv * 64;
  const bf16_t* kcb = p.Kc + (size_t)b * 512 * 128 + kv * 64;
  const bf16_t* vcb = p.Vct + (size_t)((b * 2 + kv) * 64) * 512;
  const bool band = sample && !odd;
  int lo = 0, hi = L >> 6;
  if (band) { lo = (t0 - 128) < 0 ? 0 : ((t0 - 128) >> 6); hi = (t0 + 160 + 63) >> 6; if (hi > 32) hi = 32; }
  const int nloc = hi - lo, ntiles = nloc + (sample ? 8 : 0);
  const int hq = kv * 4 + g;
  s16x8 qf[4];
#pragma unroll
  for (int kk = 0; kk < 4; ++kk) qf[kk] = *(const s16x8*)(p.Qb + (size_t)(q_row0 + ql) * 512 + hq * 64 + kk * 16 + h * 8);
  float m = -1e30f, lsum = 0.f;
  if (!odd) { m = p.a_sink[kv * 4 + g] * LOG2E; lsum = (h == 0) ? 1.f : 0.f; }
  f32x16 o0, o1;
#pragma unroll
  for (int r = 0; r < 16; ++r) { o0[r] = 0.f; o1[r] = 0.f; }
  u32x4 kr0, kr1, vr0, vr1;
  const int lr = tid >> 3, lch = tid & 7;
#define ATT_GL(ti_)                                                                                   \
  {                                                                                                   \
    const int ti__ = (ti_);                                                                           \
    const bf16_t* kp_; const bf16_t* vp_; size_t vst_;                                                \
    if (ti__ < nloc) { const int kt_ = lo + ti__; kp_ = kbase + (size_t)(kt_ * 64 + lr) * 128 + lch * 8; vp_ = vbase + (size_t)lr * L + kt_ * 64 + lch * 8; vst_ = (size_t)L; } \
    else { const int c_ = ti__ - nloc; kp_ = kcb + (size_t)(c_ * 64 + lr) * 128 + lch * 8; vp_ = vcb + (size_t)lr * 512 + c_ * 64 + lch * 8; vst_ = 512; } \
    kr0 = gload16(kp_); kr1 = gload16(kp_ + 32 * 128);                                                \
    vr0 = gload16(vp_); vr1 = gload16(vp_ + 32 * vst_);                                               \
  }
  ATT_GL(0);
  for (int ti = 0; ti < ntiles; ++ti) {
    vm_wait4(kr0, kr1, vr0, vr1);
    *(u32x4*)(Ks + lr * 72 + lch * 8) = kr0;
    *(u32x4*)(Ks + (lr + 32) * 72 + lch * 8) = kr1;
    *(u32x4*)(Vs + lr * 72 + lch * 8) = vr0;
    *(u32x4*)(Vs + (lr + 32) * 72 + lch * 8) = vr1;
    __syncthreads();
    if (ti + 1 < ntiles) ATT_GL(ti + 1);
    __builtin_amdgcn_sched_barrier(0);
    f32x16 s0, s1;
#pragma unroll
    for (int r = 0; r < 16; ++r) { s0[r] = 0.f; s1[r] = 0.f; }
#pragma unroll
    for (int kk = 0; kk < 4; ++kk) {
      const s16x8 a0 = *(const s16x8*)(Ks + ql * 72 + kk * 16 + h * 8);
      const s16x8 a1 = *(const s16x8*)(Ks + (32 + ql) * 72 + kk * 16 + h * 8);
      s0 = __builtin_amdgcn_mfma_f32_32x32x16_bf16(a0, qf[kk], s0, 0, 0, 0);
      s1 = __builtin_amdgcn_mfma_f32_32x32x16_bf16(a1, qf[kk], s1, 0, 0, 0);
    }
    if (band && ti < nloc) {
      const int kbase_pos = (lo + ti) * 64 + 4 * h - (t0 + ql);
#pragma unroll
      for (int r = 0; r < 16; ++r) {
        const int dlt = kbase_pos + (r & 3) + 8 * (r >> 2);
        if (dlt > 128 || dlt < -128) s0[r] = -1e30f;
        const int dl2 = dlt + 32;
        if (dl2 > 128 || dl2 < -128) s1[r] = -1e30f;
      }
    }
    float mx = -1e30f;
#pragma unroll
    for (int r = 0; r < 16; ++r) mx = fmaxf(mx, fmaxf(s0[r], s1[r]));
    mx = fmaxf(mx, __shfl_xor(mx, 32));
    const float mnew = fmaxf(m, mx);
    const float alpha = __builtin_amdgcn_exp2f(m - mnew);
    m = mnew;
    float ps = 0.f;
#pragma unroll
    for (int r = 0; r < 16; ++r) {
      s0[r] = __builtin_amdgcn_exp2f(s0[r] - mnew);
      s1[r] = __builtin_amdgcn_exp2f(s1[r] - mnew);
      ps += s0[r] + s1[r];
    }
    lsum = lsum * alpha + ps;
#pragma unroll
    for (int r = 0; r < 16; ++r) { o0[r] *= alpha; o1[r] *= alpha; }
#pragma unroll
    for (int ks = 0; ks < 4; ++ks) {
      const int kbk = ks >> 1, sp = ks & 1;
      s16x8 pf;
#pragma unroll
      for (int j = 0; j < 8; ++j) pf[j] = (short)f2bf(kbk == 0 ? s0[8 * sp + j] : s1[8 * sp + j]);
      const int keyoff = kbk * 32 + 16 * sp + 4 * h;
#pragma unroll
      for (int db = 0; db < 2; ++db) {
        const bf16_t* vp = Vs + (db * 32 + ql) * 72 + keyoff;
        const s16x4 lo4 = *(const s16x4*)(vp);
        const s16x4 hi4 = *(const s16x4*)(vp + 8);
        s16x8 vf;
        vf[0] = lo4[0]; vf[1] = lo4[1]; vf[2] = lo4[2]; vf[3] = lo4[3];
        vf[4] = hi4[0]; vf[5] = hi4[1]; vf[6] = hi4[2]; vf[7] = hi4[3];
        if (db == 0) o0 = __builtin_amdgcn_mfma_f32_32x32x16_bf16(vf, pf, o0, 0, 0, 0);
        else o1 = __builtin_amdgcn_mfma_f32_32x32x16_bf16(vf, pf, o1, 0, 0, 0);
      }
    }
    __syncthreads();
  }
  const float ltot = lsum + __shfl_xor(lsum, 32);
  const float inv = __builtin_amdgcn_rcpf(ltot);
  bf16_t* cat = p.Hb + (size_t)(q_row0 + ql) * DM + (odd ? 512 : 0) + hq * 64;
#pragma unroll
  for (int rg = 0; rg < 4; ++rg) {
    uint2 w0, w1;
    w0.x = pk2(o0[rg * 4 + 0] * inv, o0[rg * 4 + 1] * inv); w0.y = pk2(o0[rg * 4 + 2] * inv, o0[rg * 4 + 3] * inv);
    w1.x = pk2(o1[rg * 4 + 0] * inv, o1[rg * 4 + 1] * inv); w1.y = pk2(o1[rg * 4 + 2] * inv, o1[rg * 4 + 3] * inv);
    *(uint2*)(cat + 8 * rg + 4 * h) = w0;
    *(uint2*)(cat + 32 + 8 * rg + 4 * h) = w1;
  }
}

__device__ __forceinline__ void mlstm_item(const Params& p, int item, char* smem) {
  bf16_t* sQ = (bf16_t*)smem;
  bf16_t* sK = sQ + 64 * 136;
  bf16_t* sKt = sK + 64 * 136;
  bf16_t* sVt = sKt + 128 * 72;
  bf16_t* sW = sVt + 32 * 72;
  bf16_t* sCt = sW + 64 * 72;
  float* sU = (float*)(sCt + 32 * 136);
  float* sM = sU + 64;
  float* sA = sM + 64;
  float* sWs = sA + 64;
  float* sCl = sWs + 64;
  float* sMisc = sCl + 64;
  const bf16_t* P = p.R1;
  const int ldp = LDPE;
  const float kscale = 0.08838834764831845f;
  const int tid = otid(), lane = tid & 63, w = tid >> 6, l15 = lane & 15, kg = lane >> 4;
  bool sample; int b, head, dir, slice, L, seq_row0;
  if (item < 160) { sample = true; const int s5 = item / 5; slice = item % 5; b = s5 >> 3; head = (s5 >> 1) & 3; dir = s5 & 1; L = 2048; seq_row0 = NPR + b * 2048; }
  else { const int it = item - 160; sample = false; const int s5 = it / 5; slice = it % 5; b = s5 >> 3; head = (s5 >> 1) & 3; dir = s5 & 1; L = 256; seq_row0 = b * 256; }
  const bool nsl = (slice == 4);
  const int nch = L >> 6;
  float m = 0.f;
  f32x4 cacc[2][2];
#pragma unroll
  for (int rb = 0; rb < 2; ++rb)
#pragma unroll
    for (int nb = 0; nb < 2; ++nb)
#pragma unroll
      for (int r = 0; r < 4; ++r) cacc[rb][nb][r] = 0.f;
  if (sample) {
    const size_t sidx = (size_t)((b * 2 + dir) * 4 + head);
    m = p.state_b_m[sidx];
#pragma unroll
    for (int rb = 0; rb < 2; ++rb)
#pragma unroll
      for (int nb = 0; nb < 2; ++nb)
#pragma unroll
        for (int r = 0; r < 4; ++r) {
          const int d = 32 * w + rb * 16 + 4 * kg + r, e = nb * 16 + l15;
          float v;
          if (!nsl) v = p.state_b_C[(sidx * 128 + d) * 128 + slice * 32 + e];
          else v = (e == 0) ? p.state_b_n[sidx * 128 + d] : 0.f;
          cacc[rb][nb][r] = v;
        }
  }
#pragma unroll
  for (int rb = 0; rb < 2; ++rb)
#pragma unroll
    for (int nb = 0; nb < 2; ++nb) {
      uint2 o; o.x = pk2(cacc[rb][nb][0], cacc[rb][nb][1]); o.y = pk2(cacc[rb][nb][2], cacc[rb][nb][3]);
      *(uint2*)(sCt + (nb * 16 + l15) * 136 + 32 * w + rb * 16 + 4 * kg) = o;
    }
  const float bias_i = p.b_gate_bias[(2 * dir) * 4 + head], bias_f = p.b_gate_bias[(2 * dir + 1) * 4 + head];
  float* NUM = p.Z + (size_t)dir * NT * 512;
  u32x4 pq[4], pk[4], pv;
  unsigned pgi, pgf;
#define ML_ISSUE(cc_)                                                                                         \
  {                                                                                                           \
    const int c__ = (cc_);                                                                                    \
    {                                                                                                         \
      const int pos_ = dir ? (L - 1 - (c__ * 64 + lane)) : (c__ * 64 + lane);                                 \
      const bf16_t* gp_ = P + (size_t)(seq_row0 + pos_) * ldp + 2304;                                         \
      pgi = gload2(gp_ + (2 * dir) * 4 + head);                                                               \
      pgf = gload2(gp_ + (2 * dir + 1) * 4 + head);                                                           \
    }                                                                                                         \
    _Pragma("unroll") for (int i = 0; i < 4; ++i) {                                                           \
      const int r_ = tid & 63, ch_ = (tid >> 6) + 4 * i;                                                      \
      const int pos_ = dir ? (L - 1 - (c__ * 64 + r_)) : (c__ * 64 + r_);                                     \
      const bf16_t* rp_ = P + (size_t)(seq_row0 + pos_) * ldp + head * 128 + ch_ * 8;                         \
      pq[i] = gload16(rp_ + 768);                                                                             \
      pk[i] = gload16(rp_ + 1280);                                                                            \
    }                                                                                                         \
    if (!nsl) {                                                                                               \
      const int r_ = tid & 63, ch_ = tid >> 6;                                                                \
      const int pos_ = dir ? (L - 1 - (c__ * 64 + r_)) : (c__ * 64 + r_);                                     \
      pv = gload16(P + (size_t)(seq_row0 + pos_) * ldp + 1792 + head * 128 + slice * 32 + ch_ * 8);          \
    }                                                                                                         \
  }
  pv = (u32x4){0u, 0u, 0u, 0u};
  ML_ISSUE(0);
  for (int c = 0; c < nch; ++c) {
    asm volatile("s_waitcnt vmcnt(0)" : "+v"(pgi), "+v"(pgf), "+v"(pq[0]), "+v"(pq[1]), "+v"(pq[2]), "+v"(pq[3]), "+v"(pk[0]), "+v"(pk[1]), "+v"(pk[2]), "+v"(pk[3]), "+v"(pv) : : "memory");
    {
      const float ig = bf2f((bf16_t)pgi) + bias_i;
      const float fr = bf2f((bf16_t)pgf) + bias_f;
      const float lf = fminf(fr, 0.f) - __logf(1.f + __expf(-fabsf(fr)));
      float bc = lf;
#pragma unroll
      for (int o = 1; o < 64; o <<= 1) { const float y = __shfl_up(bc, o); if (lane >= o) bc += y; }
      const float u = ig - bc;
      float pm = u;
#pragma unroll
      for (int o = 1; o < 64; o <<= 1) { const float y = __shfl_up(pm, o); if (lane >= o) pm = fmaxf(pm, y); }
      const float M = fmaxf(m, pm);
      const float Mlast = __shfl(M, 63), bclast = __shfl(bc, 63);
      if (w == 0) {
        sU[lane] = u; sM[lane] = M; sA[lane] = __expf(m - M);
        sWs[lane] = __expf(u - Mlast) * kscale;
        sCl[lane] = __expf(-(bc + M));
        if (lane == 0) { sMisc[0] = bclast + Mlast; sMisc[1] = __expf(m - Mlast); }
      }
    }
    __syncthreads();
#pragma unroll
    for (int i = 0; i < 4; ++i) {
      const int r = tid & 63, ch = (tid >> 6) + 4 * i;
      *(u32x4*)(sQ + r * 136 + ch * 8) = pq[i];
      *(u32x4*)(sK + r * 136 + ch * 8) = pk[i];
      const float ws = sWs[r];
#pragma unroll
      for (int j = 0; j < 4; ++j) {
        const unsigned pr2 = pk2(bf2f((bf16_t)(pk[i][j] & 0xffffu)) * ws, bf2f((bf16_t)(pk[i][j] >> 16)) * ws);
        sKt[(ch * 8 + 2 * j) * 72 + r] = (bf16_t)(pr2 & 0xffffu);
        sKt[(ch * 8 + 2 * j + 1) * 72 + r] = (bf16_t)(pr2 >> 16);
      }
    }
    {
      const int r = tid & 63, ch = tid >> 6;
      if (!nsl) {
#pragma unroll
        for (int j = 0; j < 4; ++j) {
          sVt[(ch * 8 + 2 * j) * 72 + r] = (bf16_t)(pv[j] & 0xffffu);
          sVt[(ch * 8 + 2 * j + 1) * 72 + r] = (bf16_t)(pv[j] >> 16);
        }
      } else {
#pragma unroll
        for (int j = 0; j < 8; ++j) sVt[(ch * 8 + j) * 72 + r] = (ch == 0 && j == 0) ? (bf16_t)0x3F80 : (bf16_t)0;
      }
    }
    __builtin_amdgcn_sched_barrier(0);
    if (c + 1 < nch) ML_ISSUE(c + 1);
    __builtin_amdgcn_sched_barrier(0);
    __syncthreads();
    {
      const int wr = w >> 1, wc = w & 1, h = lane >> 5, l31 = lane & 31;
      f32x16 sacc;
#pragma unroll
      for (int r = 0; r < 16; ++r) sacc[r] = 0.f;
      if (!(wr == 0 && wc == 1)) {
#pragma unroll
        for (int kk = 0; kk < 8; ++kk) {
          const s16x8 a = *(const s16x8*)(sQ + (wr * 32 + l31) * 136 + kk * 16 + h * 8);
          const s16x8 bb = *(const s16x8*)(sK + (wc * 32 + l31) * 136 + kk * 16 + h * 8);
          sacc = __builtin_amdgcn_mfma_f32_32x32x16_bf16(a, bb, sacc, 0, 0, 0);
        }
      }
      const int s = wc * 32 + l31;
      const float us = sU[s];
#pragma unroll
      for (int r = 0; r < 16; r += 2) {
        const int t = wr * 32 + (r & 3) + 8 * (r >> 2) + 4 * h;
        const float w0 = (s <= t) ? __expf(us - sM[t]) * sacc[r] * kscale : 0.f;
        const float w1 = (s <= t + 1) ? __expf(us - sM[t + 1]) * sacc[r + 1] * kscale : 0.f;
        const unsigned pr2 = pk2(w0, w1);
        sW[t * 72 + s] = (bf16_t)(pr2 & 0xffffu);
        sW[(t + 1) * 72 + s] = (bf16_t)(pr2 >> 16);
      }
    }
    __syncthreads();
    {
      f32x4 a1[2], a2[2];
#pragma unroll
      for (int nb = 0; nb < 2; ++nb)
#pragma unroll
        for (int r = 0; r < 4; ++r) { a1[nb][r] = 0.f; a2[nb][r] = 0.f; }
#pragma unroll
      for (int kk = 0; kk < 4; ++kk) {
        const s16x8 a = *(const s16x8*)(sQ + (16 * w + l15) * 136 + kk * 32 + kg * 8);
#pragma unroll
        for (int nb = 0; nb < 2; ++nb) {
          const s16x8 bb = *(const s16x8*)(sCt + (nb * 16 + l15) * 136 + kk * 32 + kg * 8);
          a1[nb] = mfma16_safe(a, bb, a1[nb]);
        }
      }
#pragma unroll
      for (int kk = 0; kk < 2; ++kk) {
        const s16x8 a = *(const s16x8*)(sW + (16 * w + l15) * 72 + kk * 32 + kg * 8);
#pragma unroll
        for (int nb = 0; nb < 2; ++nb) {
          const s16x8 bb = *(const s16x8*)(sVt + (nb * 16 + l15) * 72 + kk * 32 + kg * 8);
          a2[nb] = mfma16_safe(a, bb, a2[nb]);
        }
      }
#pragma unroll
      for (int r = 0; r < 4; ++r) {
        const int t = 16 * w + 4 * kg + r;
        const int pos = dir ? (L - 1 - (c * 64 + t)) : (c * 64 + t);
        const size_t row = (size_t)(seq_row0 + pos);
        const float at = sA[t];
#pragma unroll
        for (int nb = 0; nb < 2; ++nb) {
          const float val = at * a1[nb][r] + a2[nb][r];
          const int e = nb * 16 + l15;
          if (!nsl) NUM[row * 512 + head * 128 + slice * 32 + e] = val;
          else if (e == 0) { p.DEN[((size_t)dir * NT + row) * 4 + head] = val; p.CL[((size_t)dir * NT + row) * 4 + head] = sCl[t]; }
        }
      }
      const float decay = sMisc[1];
#pragma unroll
      for (int rb = 0; rb < 2; ++rb)
#pragma unroll
        for (int nb = 0; nb < 2; ++nb)
#pragma unroll
          for (int r = 0; r < 4; ++r) cacc[rb][nb][r] *= decay;
#pragma unroll
      for (int kk = 0; kk < 2; ++kk)
#pragma unroll
        for (int rb = 0; rb < 2; ++rb) {
          const s16x8 a = *(const s16x8*)(sKt + (32 * w + rb * 16 + l15) * 72 + kk * 32 + kg * 8);
#pragma unroll
          for (int nb = 0; nb < 2; ++nb) {
            const s16x8 bb = *(const s16x8*)(sVt + (nb * 16 + l15) * 72 + kk * 32 + kg * 8);
            cacc[rb][nb] = mfma16_safe(a, bb, cacc[rb][nb]);
          }
        }
      m = sMisc[0];
    }
    __syncthreads();
#pragma unroll
    for (int rb = 0; rb < 2; ++rb)
#pragma unroll
      for (int nb = 0; nb < 2; ++nb) {
        uint2 o; o.x = pk2(cacc[rb][nb][0], cacc[rb][nb][1]); o.y = pk2(cacc[rb][nb][2], cacc[rb][nb][3]);
        *(uint2*)(sCt + (nb * 16 + l15) * 136 + 32 * w + rb * 16 + 4 * kg) = o;
      }
  }
  if (!sample) {
    float* oC = p.out + (size_t)NT * DM + 524288 * 2;
    float* oN = oC + 2097152;
    float* oM = oN + 16384;
    const size_t sidx = (size_t)((b * 2 + dir) * 4 + head);
#pragma unroll
    for (int rb = 0; rb < 2; ++rb)
#pragma unroll
      for (int nb = 0; nb < 2; ++nb)
#pragma unroll
        for (int r = 0; r < 4; ++r) {
          const int d = 32 * w + rb * 16 + 4 * kg + r, e = nb * 16 + l15;
          if (!nsl) oC[(sidx * 128 + d) * 128 + slice * 32 + e] = cacc[rb][nb][r];
          else if (e == 0) oN[sidx * 128 + d] = cacc[rb][nb][r];
        }
    if (nsl && tid == 0) oM[sidx] = m;
  }
  __syncthreads();
}

__device__ __forceinline__ void hgrn_pre(const Params& p, char* smem) {
  float* sTot = (float*)smem;
  const bf16_t* P = p.R1;
  const int ldp = LDPO;
  const int tid = otid(), d = tid & 127, half = tid >> 7;
  for (int it = obid(); it < 3072; it += gridDim.x) {
    const int dir = it / 1536, rem = it % 1536, gc = rem >> 2, head = rem & 3;
    const float lbv = __builtin_amdgcn_rcpf(1.f + __expf(p.c_lb_logits[head * 128 + d] - p.c_lb_logits[512 + head * 128 + d]));
    const int fcol = (dir ? 1024 : 512) + head * 128 + d;
    float Al[16], qv[16], kvv[16];
    float run = 0.f;
#pragma unroll
    for (int tt = 0; tt < 16; ++tt) {
      const int t = half * 16 + tt;
      const bf16_t* rp = P + (size_t)(gc * 32 + (dir ? 31 - t : t)) * ldp;
      const float fp = bf2f(rp[fcol]);
      const float cq = bf2f(rp[head * 128 + d]);
      const float f = lbv + (1.f - lbv) * sigmoidf_(fp);
      run += __logf(f);
      Al[tt] = run; kvv[tt] = 1.f - f; qv[tt] = cq * sigmoidf_(cq);
    }
    sTot[half * 128 + d] = run;
    __syncthreads();
    const float tot0 = sTot[d], tot1 = sTot[128 + d];
    const float Atot = tot0 + tot1, off = half ? tot0 : 0.f;
    const size_t base = (size_t)((dir * 384 + gc) * 4 + head) * 4096;
    bf16_t* hk = (dir ? p.HK1 : p.HK0) + (size_t)(gc * 4 + head) * 4096;
    unsigned kt[8];
#pragma unroll
    for (int tt = 0; tt < 16; ++tt) {
      const int t = half * 16 + tt;
      const float A = Al[tt] + off;
      p.HQ[base + t * 128 + d] = f2bf(qv[tt] * __expf(A - tot0));
      const bf16_t kb = f2bf(kvv[tt] * __expf(tot0 - A));
      hk[t * 128 + d] = kb;
      if (tt & 1) kt[tt >> 1] |= ((unsigned)kb << 16); else kt[tt >> 1] = (unsigned)kb;
    }
    {
      u32x4 w0 = {kt[0], kt[1], kt[2], kt[3]}, w1 = {kt[4], kt[5], kt[6], kt[7]};
      *(u32x4*)(p.HKt + base + d * 32 + half * 16) = w0;
      *(u32x4*)(p.HKt + base + d * 32 + half * 16 + 8) = w1;
    }
    if (half == 0) {
      float* ev = p.EV + (size_t)((dir * 384 + gc) * 4 + head) * 384;
      ev[d] = __expf(tot0); ev[128 + d] = __expf(Atot - tot0); ev[256 + d] = __expf(Atot);
    }
    __syncthreads();
  }
}

__device__ __forceinline__ void hgrn_item(const Params& p, int item, char* smem) {
  bf16_t* sQt = (bf16_t*)smem;
  bf16_t* sKt_ = sQt + 32 * 136;
  bf16_t* sK2t = sKt_ + 32 * 136;
  bf16_t* sVt = sK2t + 128 * 40;
  bf16_t* sAtt = sVt + 32 * 40;
  bf16_t* sSt = sAtt + 32 * 40;
  const bf16_t* P = p.R1;
  const int ldp = LDPO;
  const int tid = otid(), lane = tid & 63, w = tid >> 6, l15 = lane & 15, kg = lane >> 4;
  bool sample; int b, head, dir, slice, L, seq_row0;
  if (item < 128) { sample = true; const int s4 = item >> 2; slice = item & 3; b = s4 >> 3; head = (s4 >> 1) & 3; dir = s4 & 1; L = 2048; seq_row0 = NPR + b * 2048; }
  else { const int it = item - 128; sample = false; const int s4 = it >> 2; slice = it & 3; b = s4 >> 3; head = (s4 >> 1) & 3; dir = s4 & 1; L = 256; seq_row0 = b * 256; }
  const int nch = L >> 5, gc0 = seq_row0 >> 5;
  const bf16_t* HKd = dir ? p.HK1 : p.HK0;
  f32x4 sacc[2][2];
#pragma unroll
  for (int rb = 0; rb < 2; ++rb)
#pragma unroll
    for (int nb = 0; nb < 2; ++nb)
#pragma unroll
      for (int r = 0; r < 4; ++r) {
        float v = 0.f;
        if (sample) {
          const int dd = 32 * w + rb * 16 + 4 * kg + r, e = nb * 16 + l15;
          v = p.state_c_S[(((size_t)((b * 2 + dir) * 4 + head)) * 128 + dd) * 128 + slice * 32 + e];
        }
        sacc[rb][nb][r] = v;
      }
  float* O = p.Z + (size_t)dir * NT * 512;
  u32x4 rq[2], rk[2], rkt[2], rv, ev[3][2];
  rv = (u32x4){0u, 0u, 0u, 0u};
#define HG_ISSUE(cc_)                                                                                          \
  {                                                                                                            \
    const int gc_ = gc0 + (dir ? nch - 1 - (cc_) : (cc_));                                                     \
    const size_t base_ = (size_t)((dir * 384 + gc_) * 4 + head) * 4096;                                        \
    const size_t kb_ = (size_t)(gc_ * 4 + head) * 4096;                                                        \
    _Pragma("unroll") for (int i = 0; i < 2; ++i) {                                                            \
      const int id_ = tid + i * 256;                                                                           \
      rq[i] = gload16(p.HQ + base_ + id_ * 8);                                                                 \
      rk[i] = gload16(HKd + kb_ + id_ * 8);                                                                    \
      rkt[i] = gload16(p.HKt + base_ + id_ * 8);                                                               \
    }                                                                                                          \
    if (tid < 128) {                                                                                           \
      const int r_ = tid & 31, ch_ = tid >> 5;                                                                 \
      rv = gload16(P + (size_t)(gc_ * 32 + (dir ? 31 - r_ : r_)) * ldp + 1536 + head * 128 + slice * 32 + ch_ * 8); \
    }                                                                                                          \
    const float* evb_ = p.EV + (size_t)((dir * 384 + gc_) * 4 + head) * 384 + 32 * w + 4 * kg;                 \
    _Pragma("unroll") for (int x = 0; x < 3; ++x) {                                                            \
      ev[x][0] = gload16(evb_ + x * 128);                                                                      \
      ev[x][1] = gload16(evb_ + x * 128 + 16);                                                                 \
    }                                                                                                          \
  }
#define HG_WAIT() asm volatile("s_waitcnt vmcnt(0)" : "+v"(rq[0]), "+v"(rq[1]), "+v"(rk[0]), "+v"(rk[1]), "+v"(rkt[0]), "+v"(rkt[1]), "+v"(rv), "+v"(ev[0][0]), "+v"(ev[0][1]), "+v"(ev[1][0]), "+v"(ev[1][1]), "+v"(ev[2][0]), "+v"(ev[2][1]) : : "memory")
  f32x4 curE[2], cure2[2];
#define HG_STAGE()                                                                                             \
  {                                                                                                            \
    _Pragma("unroll") for (int i = 0; i < 2; ++i) {                                                            \
      const int id_ = tid + i * 256;                                                                           \
      *(u32x4*)(sQt + (id_ >> 4) * 136 + (id_ & 15) * 8) = rq[i];                                              \
      *(u32x4*)(sKt_ + (id_ >> 4) * 136 + (id_ & 15) * 8) = rk[i];                                             \
      *(u32x4*)(sK2t + (id_ >> 2) * 40 + (id_ & 3) * 8) = rkt[i];                                              \
    }                                                                                                          \
    if (tid < 128) {                                                                                           \
      const int r_ = tid & 31, ch_ = tid >> 5;                                                                 \
      _Pragma("unroll") for (int j = 0; j < 4; ++j) {                                                          \
        sVt[(ch_ * 8 + 2 * j) * 40 + r_] = (bf16_t)(rv[j] & 0xffffu);                                          \
        sVt[(ch_ * 8 + 2 * j + 1) * 40 + r_] = (bf16_t)(rv[j] >> 16);                                          \
      }                                                                                                        \
    }                                                                                                          \
    _Pragma("unroll") for (int rb = 0; rb < 2; ++rb) {                                                         \
      f32x4 e1_;                                                                                               \
      _Pragma("unroll") for (int r = 0; r < 4; ++r) {                                                          \
        e1_[r] = __uint_as_float(ev[0][rb][r]);                                                                \
        cure2[rb][r] = __uint_as_float(ev[1][rb][r]);                                                          \
        curE[rb][r] = __uint_as_float(ev[2][rb][r]);                                                           \
      }                                                                                                        \
      _Pragma("unroll") for (int nb = 0; nb < 2; ++nb) {                                                       \
        uint2 o_;                                                                                              \
        o_.x = pk2(sacc[rb][nb][0] * e1_[0], sacc[rb][nb][1] * e1_[1]);                                        \
        o_.y = pk2(sacc[rb][nb][2] * e1_[2], sacc[rb][nb][3] * e1_[3]);                                        \
        *(uint2*)(sSt + (nb * 16 + l15) * 136 + 32 * w + rb * 16 + 4 * kg) = o_;                               \
      }                                                                                                        \
    }                                                                                                          \
  }
  HG_ISSUE(0);
  HG_WAIT();
  HG_STAGE();
  __syncthreads();
  const int br = w >> 1, bcn = w & 1;
  for (int c = 0; c < nch; ++c) {
    if (c + 1 < nch) HG_ISSUE(c + 1);
    __builtin_amdgcn_sched_barrier(0);
    {
      f32x4 acc;
#pragma unroll
      for (int r = 0; r < 4; ++r) acc[r] = 0.f;
      if (!(br == 0 && bcn == 1)) {
#pragma unroll
        for (int kk = 0; kk < 4; ++kk) {
          const s16x8 a = *(const s16x8*)(sQt + (br * 16 + l15) * 136 + kk * 32 + kg * 8);
          const s16x8 bb = *(const s16x8*)(sKt_ + (bcn * 16 + l15) * 136 + kk * 32 + kg * 8);
          acc = mfma16_safe(a, bb, acc);
        }
      }
#pragma unroll
      for (int r = 0; r < 4; ++r) {
        const int t = br * 16 + 4 * kg + r, sidx = bcn * 16 + l15;
        sAtt[t * 40 + sidx] = (sidx <= t) ? f2bf(acc[r]) : (bf16_t)0;
      }
    }
    __syncthreads();
    {
      f32x4 oacc;
#pragma unroll
      for (int r = 0; r < 4; ++r) oacc[r] = 0.f;
#pragma unroll
      for (int kk = 0; kk < 4; ++kk) {
        const s16x8 a = *(const s16x8*)(sQt + (br * 16 + l15) * 136 + kk * 32 + kg * 8);
        const s16x8 bb = *(const s16x8*)(sSt + (bcn * 16 + l15) * 136 + kk * 32 + kg * 8);
        oacc = mfma16_safe(a, bb, oacc);
      }
      {
        const s16x8 a = *(const s16x8*)(sAtt + (br * 16 + l15) * 40 + kg * 8);
        const s16x8 bb = *(const s16x8*)(sVt + (bcn * 16 + l15) * 40 + kg * 8);
        oacc = mfma16_safe(a, bb, oacc);
      }
      const int gc = gc0 + (dir ? nch - 1 - c : c);
#pragma unroll
      for (int r = 0; r < 4; ++r) {
        const int t = br * 16 + 4 * kg + r, e = bcn * 16 + l15;
        O[(size_t)(gc * 32 + (dir ? 31 - t : t)) * 512 + head * 128 + slice * 32 + e] = oacc[r];
      }
#pragma unroll
      for (int rb = 0; rb < 2; ++rb) {
        const s16x8 a = *(const s16x8*)(sK2t + (32 * w + rb * 16 + l15) * 40 + kg * 8);
#pragma unroll
        for (int nb = 0; nb < 2; ++nb) {
          const s16x8 bb = *(const s16x8*)(sVt + (nb * 16 + l15) * 40 + kg * 8);
          f32x4 ds;
#pragma unroll
          for (int r = 0; r < 4; ++r) ds[r] = 0.f;
          ds = mfma16_safe(a, bb, ds);
#pragma unroll
          for (int r = 0; r < 4; ++r) sacc[rb][nb][r] = curE[rb][r] * sacc[rb][nb][r] + cure2[rb][r] * ds[r];
        }
      }
    }
    __syncthreads();
    if (c + 1 < nch) {
      HG_WAIT();
      HG_STAGE();
    }
    __syncthreads();
  }
  if (!sample) {
    float* oS = p.out + (size_t)NT * DM + 524288 * 2 + 2097152 + 16384 + 128;
#pragma unroll
    for (int rb = 0; rb < 2; ++rb)
#pragma unroll
      for (int nb = 0; nb < 2; ++nb)
#pragma unroll
        for (int r = 0; r < 4; ++r) {
          const int dd = 32 * w + rb * 16 + 4 * kg + r, e = nb * 16 + l15;
          oS[(((size_t)((b * 2 + dir) * 4 + head)) * 128 + dd) * 128 + slice * 32 + e] = sacc[rb][nb][r];
        }
  }
  __syncthreads();
}

__device__ __forceinline__ void combine_phase(const Params& p, int odd) {
  const int tid_ = otid(); const int lane = tid_ & 63, w = tid_ >> 6;
  const bf16_t* P = p.R1;
  const float* N0 = p.Z;
  const float* N1 = p.Z + (size_t)NT * 512;
  const float* gp = odd ? p.c_norm_g : p.b_norm_g;
  float g0[4], g1[4];
#pragma unroll
  for (int hd = 0; hd < 4; ++hd) { g0[hd] = gp[hd * 128 + lane]; g1[hd] = gp[hd * 128 + 64 + lane]; }
  const int ldp = odd ? LDPO : LDPE, gcol = odd ? 2048 : 2320, ocol = odd ? 0 : 512;
  for (int row = obid() * 4 + w; row < NT; row += gridDim.x * 4) {
    float a0[4], a1[4], b0[4], b1[4], gt0[4], gt1[4], i0[4], i1[4];
#pragma unroll
    for (int hd = 0; hd < 4; ++hd) {
      const size_t o = (size_t)row * 512 + hd * 128;
      a0[hd] = N0[o + lane]; a1[hd] = N0[o + 64 + lane]; b0[hd] = N1[o + lane]; b1[hd] = N1[o + 64 + lane];
      gt0[hd] = bf2f(P[(size_t)row * ldp + gcol + hd * 128 + lane]);
      gt1[hd] = bf2f(P[(size_t)row * ldp + gcol + hd * 128 + 64 + lane]);
      i0[hd] = 1.f; i1[hd] = 1.f;
      if (!odd) {
        const float d0 = p.DEN[((size_t)row) * 4 + hd], c0 = p.CL[((size_t)row) * 4 + hd];
        const float d1 = p.DEN[((size_t)NT + row) * 4 + hd], c1 = p.CL[((size_t)NT + row) * 4 + hd];
        i0[hd] = __builtin_amdgcn_rcpf(fmaxf(fabsf(d0), c0)); i1[hd] = __builtin_amdgcn_rcpf(fmaxf(fabsf(d1), c1));
      }
    }
#pragma unroll
    for (int hd = 0; hd < 4; ++hd) {
      const float h0 = a0[hd] * i0[hd] + b0[hd] * i1[hd];
      const float h1 = a1[hd] * i0[hd] + b1[hd] * i1[hd];
      const float ms = wave_sum(h0 * h0 + h1 * h1) * (1.f / 128.f);
      const float rs = rsqrtf(ms + 1e-6f);
      const float m0 = odd ? gt0[hd] * sigmoidf_(gt0[hd]) : sigmoidf_(gt0[hd]);
      const float m1 = odd ? gt1[hd] * sigmoidf_(gt1[hd]) : sigmoidf_(gt1[hd]);
      p.Hb[(size_t)row * DM + ocol + hd * 128 + lane] = f2bf(m0 * h0 * rs * g0[hd]);
      p.Hb[(size_t)row * DM + ocol + hd * 128 + 64 + lane] = f2bf(m1 * h1 * rs * g1[hd]);
    }
  }
}

__device__ __forceinline__ void my_gsync(unsigned* bar, unsigned& epoch, unsigned nblocks) {
  asm volatile("s_waitcnt vmcnt(0) lgkmcnt(0)" ::: "memory");
  __syncthreads();
  epoch += 1;
  if (threadIdx.x == 0) {
    __builtin_amdgcn_fence(__ATOMIC_RELEASE, "agent");
    asm volatile("s_waitcnt vmcnt(0) lgkmcnt(0)" ::: "memory");
    const unsigned g = blockIdx.x & 31u;
    const unsigned gsize = (nblocks >> 5) + ((g < (nblocks & 31u)) ? 1u : 0u);
    const unsigned old = __hip_atomic_fetch_add(&bar[g * 64], 1u, __ATOMIC_RELAXED, __HIP_MEMORY_SCOPE_AGENT);
    if (old + 1 == epoch * gsize) {
      const unsigned ngroups = nblocks < 32u ? nblocks : 32u;
      const unsigned old2 = __hip_atomic_fetch_add(&bar[32 * 64], 1u, __ATOMIC_RELAXED, __HIP_MEMORY_SCOPE_AGENT);
      if (old2 + 1 == epoch * ngroups) __hip_atomic_store(&bar[33 * 64], epoch, __ATOMIC_RELAXED, __HIP_MEMORY_SCOPE_AGENT);
    }
    while (__hip_atomic_load(&bar[33 * 64], __ATOMIC_RELAXED, __HIP_MEMORY_SCOPE_AGENT) < epoch) __builtin_amdgcn_s_sleep(1);
    __builtin_amdgcn_fence(__ATOMIC_ACQUIRE, "agent");
  }
  __syncthreads();
  __builtin_amdgcn_fence(__ATOMIC_ACQUIRE, "agent");
}
#define XB_XCNT(j) (4096 + 64 * (j))
#define XB_XSUB(j) (5120 + 64 * (j))
#define XB_XGEN(j) (6144 + 64 * (j))
#define XB_TOP 7168
#define XB_TOPGEN 7232
__device__ __forceinline__ unsigned xb_ld(unsigned* q) { return __hip_atomic_load(q, __ATOMIC_RELAXED, __HIP_MEMORY_SCOPE_AGENT); }
__device__ __forceinline__ unsigned xb_add(unsigned* q) { return __hip_atomic_fetch_add(q, 1u, __ATOMIC_RELAXED, __HIP_MEMORY_SCOPE_AGENT); }
__device__ __forceinline__ void xb_st(unsigned* q, unsigned v) { __hip_atomic_store(q, v, __ATOMIC_RELAXED, __HIP_MEMORY_SCOPE_AGENT); }
__device__ __forceinline__ void xsync(unsigned* bar, unsigned& epoch, unsigned xcc, unsigned cntx, unsigned nxcc) {
  asm volatile("s_waitcnt vmcnt(0) lgkmcnt(0)" ::: "memory");
  __syncthreads();
  epoch += 1;
  if (threadIdx.x == 0) {
    const unsigned old = xb_add(&bar[XB_XSUB(xcc)]);
    if (old + 1 == epoch * cntx) {
      __builtin_amdgcn_fence(__ATOMIC_RELEASE, "agent");
      asm volatile("s_waitcnt vmcnt(0) lgkmcnt(0)" ::: "memory");
      const unsigned old2 = xb_add(&bar[XB_TOP]);
      if (old2 + 1 == epoch * nxcc) xb_st(&bar[XB_TOPGEN], epoch);
      else while (xb_ld(&bar[XB_TOPGEN]) < epoch) __builtin_amdgcn_s_sleep(1);
      xb_st(&bar[XB_XGEN(xcc)], epoch);
    } else {
      while (xb_ld(&bar[XB_XGEN(xcc)]) < epoch) __builtin_amdgcn_s_sleep(1);
    }
    __builtin_amdgcn_fence(__ATOMIC_ACQUIRE, "agent");
    asm volatile("s_waitcnt vmcnt(0) lgkmcnt(0)" ::: "memory");
  }
  __syncthreads();
}
#define GSYNC() xsync(p.bar, xepoch, xcc, cntx, nxcc)
__global__ void __launch_bounds__(256, 2) fwd_megakernel(Params p) {
  cg::grid_group grid = cg::this_grid();
  __shared__ __attribute__((aligned(16))) char smem[LDS_BYTES];
  const int G = gridDim.x;
  unsigned epoch = 0, xepoch = 0;
  if (p.njobs < 0) grid.sync();
  const unsigned xcc = (unsigned)__builtin_amdgcn_s_getreg((3 << 11) | 20) & 0xFu;
  if (threadIdx.x == 0) xb_add(&p.bar[XB_XCNT(xcc)]);
  my_gsync(p.bar, epoch, (unsigned)gridDim.x);
  const unsigned cntx = xb_ld(&p.bar[XB_XCNT(xcc)]);
  unsigned nxcc = 0;
#pragma unroll
  for (int jx = 0; jx < 16; ++jx) nxcc += (xb_ld(&p.bar[XB_XCNT(jx)]) != 0u) ? 1u : 0u;

  {
    const int nmod = 72, b_ = obid();
    if (G > 2 * nmod) {
      if (b_ < nmod) mod_item(p, b_, smem);
      else {
        for (int t = b_ - nmod; t < p.conv_tiles_l0; t += G - nmod) {
          int j = 0;
#pragma unroll 1
          for (int q = 1; q < p.njobs; ++q) if (t >= p.jobs[q].tile0) j = q;
          conv_tile(p.jobs[j], t - p.jobs[j].tile0, smem);
        }
      }
    } else {
      for (int it = b_; it < nmod + p.total_conv_tiles; it += G) {
        if (it < nmod) mod_item(p, it, smem);
        else {
          const int t = it - nmod;
          int j = 0;
#pragma unroll 1
          for (int q = 1; q < p.njobs; ++q) if (t >= p.jobs[q].tile0) j = q;
          conv_tile(p.jobs[j], t - p.jobs[j].tile0, smem);
        }
      }
    }
  }
  GSYNC();
  modulate_input_phase(p);
  GSYNC();

#pragma unroll 1
  for (int l = 0; l < 2; ++l) {
    const int odd = l;
#pragma unroll 1
    for (int j = 0; j < 2; ++j) {
      if (j == 1) {
        {
          EpiStoreBf16 epi{p.R1, odd ? LDPO : LDPE};
          gemm_phase<2, EpiStoreBf16>(p.Hb, DM, odd ? p.WtInO : p.WtInE, DM, odd ? LDPO : LDPE, DM, epi, smem);
        }
        GSYNC();
        prep_vectors(p, odd);
        prep_v(p, odd, smem);
        if (odd) hgrn_pre(p, smem);
        GSYNC();
        {
          const int nlong = odd ? 128 : 160, nshort = odd ? 512 : 640, natt = 768;
          const int b_ = obid();
          if (b_ < nlong && G > nlong) {
            if (!odd) mlstm_item(p, b_, smem); else hgrn_item(p, b_, smem);
          } else {
            const int first = (G > nlong) ? b_ - nlong : b_, stride = (G > nlong) ? G - nlong : G;
            const int lo_it = (G > nlong) ? 0 : -nlong;
            for (int it = first + lo_it; it < natt + nshort; it += stride) {
              if (it < 0) { if (!odd) mlstm_item(p, it + nlong, smem); else hgrn_item(p, it + nlong, smem); }
              else if (it < natt) attn_item(p, odd, it, smem);
              else if (!odd) mlstm_item(p, nlong + (it - natt), smem);
              else hgrn_item(p, nlong + (it - natt), smem);
            }
            if (!odd) {
              const int nx = p.total_conv_tiles - p.conv_tiles_l0;
              for (int x = first; x < nx; x += stride) {
                const int t = p.conv_tiles_l0 + x;
                int jj = 0;
#pragma unroll 1
                for (int q = 1; q < p.njobs; ++q) if (t >= p.jobs[q].tile0) jj = q;
                conv_tile(p.jobs[jj], t - p.jobs[jj].tile0, smem);
              }
            }
          }
        }
        GSYNC();
        combine_phase(p, odd);
        GSYNC();
        {
          EpiResid<2> epi{p.Z, p.out, p.out + (size_t)NPR * DM, modp(p, l, 0, 5), 1.f};
          gemm_phase<2, EpiResid<2>>(p.Hb, DM, odd ? p.WtOutO : p.WtOutE, DM, DM, DM, epi, smem);
        }
        GSYNC();
        ln_phase(p, p.ln_g + (size_t)(l * 3 + 1) * DM, p.ln_b + (size_t)(l * 3 + 1) * DM, true, l, 2);
        GSYNC();
      }
      const int j2 = j * 2;
      {
        EpiSwiglu epi{p.R1};
        gemm_phase<2, EpiSwiglu>(p.Hb, DM, p.Wt13p[l * 2 + j], DM, 5632, DM, epi, smem);
      }
      GSYNC();
      {
        const bool first = (l == 0 && j == 0);
        EpiResid<2> epi{p.Z, first ? p.x_prompt : p.out, first ? p.x_sample : p.out + (size_t)NPR * DM, modp(p, l, 0, 3 * j2 + 2), 0.5f};
        gemm_phase<2, EpiResid<2>>(p.R1, DFF, p.Wt2p[l * 2 + j], DFF, DM, DFF, epi, smem);
      }
      GSYNC();
      {
        const bool last = (l == 1 && j == 1);
        const int nl = (j == 0) ? l : l + 1, nj = (j == 0) ? 1 : 0;
        ln_phase(p, p.ln_g + (size_t)(l * 3 + j2) * DM, p.ln_b + (size_t)(l * 3 + j2) * DM, !last, last ? 0 : nl, last ? 0 : nj);
      }
      GSYNC();
    }
  }
}


template <int PH>
__global__ void __launch_bounds__(256, 2) k_phase(Params p, int l, int j) {
  __shared__ __attribute__((aligned(16))) char smem[LDS_BYTES];
  const int G = gridDim.x;
  const int odd = l;
  if (PH == 0) {
    const int nmod = 72;
    for (int it = obid(); it < nmod + p.total_conv_tiles; it += G) {
      if (it < nmod) mod_item(p, it, smem);
      else {
        const int t = it - nmod;
        int jj = 0;
#pragma unroll 1
        for (int q = 1; q < p.njobs; ++q) if (t >= p.jobs[q].tile0) jj = q;
        conv_tile(p.jobs[jj], t - p.jobs[jj].tile0, smem);
      }
    }
  } else if (PH == 1) {
    modulate_input_phase(p);
  } else if (PH == 2) {
    EpiStoreBf16 epi{p.R1, odd ? LDPO : LDPE};
    gemm_phase<2, EpiStoreBf16>(p.Hb, DM, odd ? p.WtInO : p.WtInE, DM, odd ? LDPO : LDPE, DM, epi, smem);
  } else if (PH == 3) {
    prep_vectors(p, odd);
    prep_v(p, odd, smem);
    if (odd) hgrn_pre(p, smem);
  } else if (PH == 4) {
    for (int it = obid(); it < 160 + 640 + 768; it += G) {
      if (it < 160) mlstm_item(p, it, smem);
      else if (it < 160 + 768) attn_item(p, 0, it - 160, smem);
      else mlstm_item(p, it - 768, smem);
    }
  } else if (PH == 5) {
    for (int it = obid(); it < 128 + 512 + 768; it += G) {
      if (it < 128) hgrn_item(p, it, smem);
      else if (it < 128 + 768) attn_item(p, 1, it - 128, smem);
      else hgrn_item(p, it - 768, smem);
    }
  } else if (PH == 6) {
    combine_phase(p, odd);
  } else if (PH == 7) {
    EpiResid<1> epi{p.Z, p.out, p.out + (size_t)NPR * DM, modp(p, l, 0, 5), 1.f};
    gemm_phase<1, EpiResid<1>>(p.Hb, DM, odd ? p.WtOutO : p.WtOutE, DM, DM, DM, epi, smem);
  } else if (PH == 8) {
    ln_phase(p, p.ln_g + (size_t)(l * 3 + 1) * DM, p.ln_b + (size_t)(l * 3 + 1) * DM, true, l, 2);
  } else if (PH == 9) {
    EpiSwiglu epi{p.R1};
    gemm_phase<2, EpiSwiglu>(p.Hb, DM, p.Wt13p[l * 2 + j], DM, 5632, DM, epi, smem);
  } else if (PH == 10) {
    const int j2 = j * 2;
    const bool first = (l == 0 && j == 0);
    EpiResid<1> epi{p.Z, first ? p.x_prompt : p.out, first ? p.x_sample : p.out + (size_t)NPR * DM, modp(p, l, 0, 3 * j2 + 2), 0.5f};
    gemm_phase<1, EpiResid<1>>(p.R1, DFF, p.Wt2p[l * 2 + j], DFF, DM, DFF, epi, smem);
  } else if (PH == 13) {
    for (size_t i = (size_t)obid() * 256 + otid(); i < (size_t)8192 * 512; i += (size_t)G * 256) p.SAVE[i] = p.Z[i];
  } else if (PH == 14) {
    bool bad = false;
    for (size_t i = (size_t)obid() * 256 + otid(); i < (size_t)8192 * 512; i += (size_t)G * 256) if (__float_as_uint(p.SAVE[i]) != __float_as_uint(p.Z[i])) bad = true;
    if (bad) { volatile int* q = (volatile int*)p.SAVE; while (q[0] != 0x7fffffff) { __builtin_amdgcn_s_sleep(10); } }
  } else if (PH == 11) {
    const int j2 = j * 2;
    const bool last = (l == 1 && j == 1);
    const int nl = (j == 0) ? l : l + 1, nj = (j == 0) ? 1 : 0;
    ln_phase(p, p.ln_g + (size_t)(l * 3 + j2) * DM, p.ln_b + (size_t)(l * 3 + j2) * DM, !last, last ? 0 : nl, last ? 0 : nj);
  }
}
extern "C" void kernel_launch(void* const* d_in, const int* in_sizes, int n_in, void* d_out, int out_size, void* d_ws,
                              size_t ws_size, hipStream_t stream) {
  static Params p;
  memset(&p, 0, sizeof(p));
  const float** ip = (const float**)&p.x_prompt;
  for (int i = 0; i < 30; ++i) ip[i] = (const float*)d_in[i];
  p.out = (float*)d_out;
  char* ws = (char*)d_ws;
  size_t off = 0;
  auto take = [&](size_t bytes) { char* r = ws + off; off += (bytes + 255) & ~(size_t)255; return r; };
  p.bar = (unsigned*)take(32768);
  char* l0_begin = ws + off;
  p.Wt13p[0] = (bf16_t*)take((size_t)5632 * 1024 * 2);
  p.Wt13p[1] = (bf16_t*)take((size_t)5632 * 1024 * 2);
  p.Wt2p[0] = (bf16_t*)take((size_t)1024 * DFF * 2);
  p.Wt2p[1] = (bf16_t*)take((size_t)1024 * DFF * 2);
  p.WtInE = (bf16_t*)take((size_t)LDPE * 1024 * 2);
  p.WtOutE = (bf16_t*)take((size_t)1024 * 1024 * 2);
  char* l0_end = ws + off;
  p.HQ = (bf16_t*)l0_begin;
  p.EV = (float*)(l0_begin + 25165824);
  p.HK0 = (bf16_t*)(l0_begin + 25165824 + 4718592);
  if (l0_begin + 25165824 + 4718592 + 12582912 > l0_end) fprintf(stderr, "layer-0 weight region too small for the HGRN buffers\n");
  p.Wt13p[2] = (bf16_t*)take((size_t)5632 * 1024 * 2);
  p.Wt13p[3] = (bf16_t*)take((size_t)5632 * 1024 * 2);
  p.Wt2p[2] = (bf16_t*)take((size_t)1024 * DFF * 2);
  p.Wt2p[3] = (bf16_t*)take((size_t)1024 * DFF * 2);
  p.WtInO = (bf16_t*)take((size_t)LDPO * 1024 * 2);
  p.WtOutO = (bf16_t*)take((size_t)1024 * 1024 * 2);
  p.HK1 = (bf16_t*)take((size_t)12582912);
  p.HKt = (bf16_t*)take((size_t)25165824);
  p.MOD = (float*)take((size_t)2 * 5 * 9216 * 4);
  p.Hb = (bf16_t*)take((size_t)NT * DM * 2);
  p.R1 = (bf16_t*)take((size_t)NT * LDPO * 2);
  p.Z = (float*)take((size_t)NT * DM * 4);
  p.Qb = (bf16_t*)take((size_t)NT * 512 * 2);
  p.Kb = (bf16_t*)take((size_t)NT * 128 * 2);
  p.Vt = (bf16_t*)take((size_t)(524288 + 1048576) * 2);
  p.Kc = (bf16_t*)take((size_t)262144 * 2);
  p.Vct = (bf16_t*)take((size_t)262144 * 2);
  p.DEN = (float*)take((size_t)2 * NT * 4 * 4);
  p.CL = (float*)take((size_t)2 * NT * 4 * 4);
  if (off > ws_size) fprintf(stderr, "workspace too small: need %zu have %zu\n", off, ws_size);
  int nj = 0, tiles = 0;
  auto add = [&](const float* src, bf16_t* dst, int K, int N, int Npad, int mode) {
    ConvJob& jb = p.jobs[nj++];
    jb.src = src; jb.dst = dst; jb.K = K; jb.N = N; jb.Npad = Npad; jb.mode = mode; jb.tile0 = tiles; jb.pad0 = 0;
    tiles += (K / 64) * (Npad / 64);
  };
  for (int lj = 0; lj < 2; ++lj) {
    add(p.ffn_w1 + (size_t)lj * 1024 * DFF, p.Wt13p[lj], 1024, DFF, DFF, 1);
    add(p.ffn_w3 + (size_t)lj * 1024 * DFF, p.Wt13p[lj], 1024, DFF, DFF, 2);
    add(p.ffn_w2 + (size_t)lj * DFF * 1024, p.Wt2p[lj], DFF, 1024, 1024, 0);
  }
  add(p.w_in_even, p.WtInE, 1024, 2832, LDPE, 0);
  add(p.w_out_even, p.WtOutE, 1024, 1024, 1024, 0);
  p.conv_tiles_l0 = tiles;
  for (int lj = 2; lj < 4; ++lj) {
    add(p.ffn_w1 + (size_t)lj * 1024 * DFF, p.Wt13p[lj], 1024, DFF, DFF, 1);
    add(p.ffn_w3 + (size_t)lj * 1024 * DFF, p.Wt13p[lj], 1024, DFF, DFF, 2);
    add(p.ffn_w2 + (size_t)lj * DFF * 1024, p.Wt2p[lj], DFF, 1024, 1024, 0);
  }
  add(p.w_in_odd, p.WtInO, 1024, LDPO, LDPO, 0);
  add(p.w_out_odd, p.WtOutO, 1024, 1024, 1024, 0);
  p.njobs = nj; p.total_conv_tiles = tiles;
  static int grid_blocks = 0;
  if (!grid_blocks) {
    int dev = 0, cus = 0, per_cu = 0;
    hipGetDevice(&dev);
    hipDeviceGetAttribute(&cus, hipDeviceAttributeMultiprocessorCount, dev);
    hipOccupancyMaxActiveBlocksPerMultiprocessor(&per_cu, fwd_megakernel, 256, 0);
    per_cu = 2;
    grid_blocks = cus * per_cu;
  }
  hipMemsetAsync(p.bar, 0, 32768, stream);
#if MULTI_LAUNCH
  const dim3 g(512), b(256);
  k_phase<0><<<g, b, 0, stream>>>(p, 0, 0);
  k_phase<1><<<g, b, 0, stream>>>(p, 0, 0);
  for (int l = 0; l < 2; ++l)
    for (int j = 0; j < 2; ++j) {
      if (j == 1) {
        k_phase<2><<<g, b, 0, stream>>>(p, l, j);
        k_phase<3><<<g, b, 0, stream>>>(p, l, j);
        if (l == 0) k_phase<4><<<g, b, 0, stream>>>(p, l, j); else k_phase<5><<<g, b, 0, stream>>>(p, l, j);
        k_phase<6><<<g, b, 0, stream>>>(p, l, j);
        k_phase<7><<<g, b, 0, stream>>>(p, l, j);
        k_phase<8><<<g, b, 0, stream>>>(p, l, j);
      }
      k_phase<9><<<g, b, 0, stream>>>(p, l, j);
      k_phase<10><<<g, b, 0, stream>>>(p, l, j);
      k_phase<11><<<g, b, 0, stream>>>(p, l, j);
    }
#else
  void* args[] = {&p};
  hipError_t e = hipLaunchCooperativeKernel((void*)fwd_megakernel, dim3(grid_blocks), dim3(256), args, 0, stream);
  if (e != hipSuccess) fprintf(stderr, "cooperative launch failed: %s (grid %d)\n", hipGetErrorString(e), grid_blocks);
#endif
}
```
